# Optimizing an MI355X kernel written in HIP

```python
import math
import jax
import jax.numpy as jnp
from jax import lax
import numpy as np

D_MODEL = 1024
BATCH = 16
SEQ = 256
DEPTH = 4
DEC_BATCH = 4
DEC_SEQ = 1024
PAST_LEN = 512

GRID_W = 64
N_EVEN = (DEPTH + 1) // 2
N_ODD = DEPTH // 2
H_A = 4
DK_A = 128
DV_A = D_MODEL // 2 // H_A
F_A = H_A * DK_A
CHUNK = 64
H_B = 8
KV_B = 2
G_B = H_B // KV_B
HD_B = D_MODEL // 2 // H_B
WINDOW = 128
QBLK = 128
H_C = 8
HD_C = D_MODEL // (2 * H_C)
D_FF = 4 * D_MODEL
ROPE_BASE = 10000.0
EPS = 1e-6
D_MIX = D_MODEL
EVEN_SIZES = (F_A, F_A, F_A, H_A * DV_A, H_A * DV_A, H_B * HD_B, KV_B * HD_B, KV_B * HD_B)
EVEN_COLS = 3 * F_A + 2 * H_A * DV_A + (H_B + 2 * KV_B) * HD_B
ODD_W = H_C * 2 * HD_C
ODD_COLS = 3 * ODD_W

kernel_name = "hybrid_dit_hgrn2_swa_diffattn_step"

F32 = jnp.float32


def rms_norm(x, w):
    xf = x.astype(F32)
    y = xf * lax.rsqrt(jnp.mean(xf * xf, axis=-1, keepdims=True) + EPS)
    return (y * w.astype(F32)).astype(x.dtype)


def split_cols(a, sizes):
    out, start = [], 0
    for s in sizes:
        out.append(a[..., start:start + s])
        start += s
    return out


def ada_mods(cvec, w_ada, b_ada):
    m = jax.nn.silu(cvec) @ w_ada + b_ada
    return jnp.split(m[:, None, :], 6, axis=-1)


def rope_2d(x):
    L, d = x.shape[1], x.shape[-1]
    t = jnp.arange(L)
    row = (t // GRID_W).astype(F32)
    col = (t % GRID_W).astype(F32)
    half = d // 2
    inv = ROPE_BASE ** (-jnp.arange(0, half, 2, dtype=F32) / half)
    ang = jnp.concatenate([row[:, None] * inv, col[:, None] * inv], -1)[None, :, None, :]
    cos, sin = jnp.cos(ang), jnp.sin(ang)
    xf = x.astype(F32)
    x1, x2 = xf[..., 0::2], xf[..., 1::2]
    return jnp.stack([x1 * cos - x2 * sin, x1 * sin + x2 * cos], -1).reshape(x.shape).astype(x.dtype)


def map_query_blocks(fn, q):
    b, l = q.shape[:2]
    n = l // QBLK
    qb = jnp.moveaxis(q.reshape((b, n, QBLK) + q.shape[2:]), 1, 0)
    out = lax.map(lambda xs: fn(xs[0], xs[1]), (qb, jnp.arange(n)))
    return jnp.moveaxis(out, 0, 1).reshape((b, l) + out.shape[3:])


def hgrn_scan(q, k, v, g, s0):
    b, h, l, _ = q.shape
    n = l // CHUNK
    def chunks(a):
        return jnp.moveaxis(a.reshape(b, h, n, CHUNK, a.shape[-1]), 2, 0)
    tril = jnp.tril(jnp.ones((CHUNK, CHUNK), bool))[:, :, None]
    def step(s, xs):
        qc, kc, vc, gc = xs
        cum = jnp.cumsum(gc, axis=2)
        diff = cum[:, :, :, None, :] - cum[:, :, None, :, :]
        decay = jnp.exp(jnp.where(tril, diff, -jnp.inf))
        att = jnp.einsum('bhtk,bhsk,bhtsk->bhts', qc, kc, decay)
        o = jnp.einsum('bhts,bhsv->bhtv', att, vc) + jnp.einsum('bhtk,bhkv->bhtv', qc * jnp.exp(cum), s)
        last = cum[:, :, -1:, :]
        s_new = jnp.exp(last[:, :, 0, :])[..., None] * s + jnp.einsum('bhsk,bhsv->bhkv', kc * jnp.exp(last - cum), vc)
        return s_new, o
    s_fin, o = lax.scan(step, s0, (chunks(q), chunks(k), chunks(v), chunks(g)))
    return jnp.moveaxis(o, 0, 2).reshape(b, h, l, -1), s_fin


def hgrn_bidir(q, g_f, g_b, v, s_f0, s_b0):
    o_f, s_f = hgrn_scan(q, -jnp.expm1(g_f), v, g_f, s_f0)
    rev = lambda a: jnp.flip(a, axis=2)
    o_b, s_b = hgrn_scan(rev(q), rev(-jnp.expm1(g_b)), rev(v), rev(g_b), s_b0)
    return o_f + rev(o_b), jnp.stack([s_f, s_b], axis=1)


def hgrn_readout(o, gate, norm_w):
    o = rms_norm(o.transpose(0, 2, 1, 3), norm_w) * jax.nn.silu(gate.astype(F32))
    return o.reshape(o.shape[0], o.shape[1], -1).astype(gate.dtype)


def even_inputs(h, w_in, lb, qn_w, kn_w):
    b, l = h.shape[:2]
    qa, zf, zb, ia, ga, qb, kb, vb = split_cols(h @ w_in, EVEN_SIZES)
    def rec(a, d):
        return a.reshape(b, l, H_A, d).transpose(0, 2, 1, 3).astype(F32)
    q_r = rec(jax.nn.silu(qa), DK_A) * (DK_A ** -0.5)
    lbf = lb.astype(F32).reshape(2, H_A, 1, DK_A)
    g_f = jnp.log(lbf[0] + (1.0 - lbf[0]) * jax.nn.sigmoid(rec(zf, DK_A)))
    g_b = jnp.log(lbf[1] + (1.0 - lbf[1]) * jax.nn.sigmoid(rec(zb, DK_A)))
    v_r = rec(ia, DV_A)
    gate = ga.reshape(b, l, H_A, DV_A)
    q_a = rms_norm(qb.reshape(b, l, H_B, HD_B), qn_w)
    k_a = rms_norm(kb.reshape(b, l, KV_B, HD_B), kn_w)
    v_a = vb.reshape(b, l, KV_B, HD_B)
    return (q_r, g_f, g_b, v_r, gate), (q_a, k_a, v_a)


def swa_context_attention(q, k, v, sink):
    b, l = q.shape[:2]
    qg = q.reshape(b, l, KV_B, G_B, HD_B)
    sink_l = sink.astype(F32).reshape(KV_B, G_B, 1, 1)
    def blk(qb, _i):
        s = jnp.einsum('bqngd,bknd->bngqk', qb, k).astype(F32) * HD_B ** -0.5
        s = jnp.concatenate([s, jnp.broadcast_to(sink_l, s.shape[:-1] + (1,))], -1)
        pr = jax.nn.softmax(s, axis=-1)[..., :-1].astype(v.dtype)
        return jnp.einsum('bngqk,bknd->bqngd', pr, v)
    return map_query_blocks(blk, qg).reshape(b, l, H_B * HD_B)


def swa_latent_attention(q, k, v, k_ctx, v_ctx, sink):
    b, l = q.shape[:2]
    qg = q.reshape(b, l, KV_B, G_B, HD_B)
    pad = ((0, 0), (WINDOW, WINDOW), (0, 0), (0, 0))
    k_pad, v_pad = jnp.pad(k, pad), jnp.pad(v, pad)
    span = QBLK + 2 * WINDOW
    sink_l = sink.astype(F32).reshape(KV_B, G_B, 1, 1)
    def blk(qb, i):
        start = i * QBLK
        kw = lax.dynamic_slice_in_dim(k_pad, start, span, axis=1)
        vw = lax.dynamic_slice_in_dim(v_pad, start, span, axis=1)
        tq = start + jnp.arange(QBLK)
        tk = start - WINDOW + jnp.arange(span)
        valid = (jnp.abs(tq[:, None] - tk[None, :]) <= WINDOW) & (tk >= 0)[None, :] & (tk < l)[None, :]
        s_w = jnp.einsum('bqngd,bknd->bngqk', qb, kw).astype(F32) * HD_B ** -0.5
        s_w = jnp.where(valid, s_w, -jnp.inf)
        s_c = jnp.einsum('bqngd,bknd->bngqk', qb, k_ctx).astype(F32) * HD_B ** -0.5
        s = jnp.concatenate([s_w, s_c, jnp.broadcast_to(sink_l, s_w.shape[:-1] + (1,))], -1)
        pr = jax.nn.softmax(s, axis=-1).astype(v.dtype)
        return (jnp.einsum('bngqk,bknd->bqngd', pr[..., :span], vw)
                + jnp.einsum('bngqk,bknd->bqngd', pr[..., span:-1], v_ctx))
    return map_query_blocks(blk, qg).reshape(b, l, H_B * HD_B)


def odd_inputs(h, w_in, qn_w, kn_w):
    b, l = h.shape[:2]
    q, k, v = split_cols(h @ w_in, (ODD_W, ODD_W, ODD_W))
    q = rms_norm(q.reshape(b, l, H_C, 2, HD_C), qn_w)
    k = rms_norm(k.reshape(b, l, H_C, 2, HD_C), kn_w)
    return q, k, v.reshape(b, l, H_C, 2 * HD_C)


def rope_2d_pairs(x):
    b, l = x.shape[:2]
    return rope_2d(x.reshape(b, l, H_C * 2, HD_C)).reshape(x.shape)


def diff_lambda(lam_p, lam_init):
    lp = lam_p.astype(F32)
    return jnp.exp(jnp.sum(lp[0] * lp[1])) - jnp.exp(jnp.sum(lp[2] * lp[3])) + lam_init


def diff_attention(q, k_parts, v_parts, lam):
    sizes = [kp.shape[1] for kp in k_parts]
    def blk(qb, _i):
        s = jnp.concatenate([jnp.einsum('bqhcd,bkhcd->bhcqk', qb, kp) for kp in k_parts], -1)
        pr = jax.nn.softmax(s.astype(F32) * HD_C ** -0.5, axis=-1)
        w = (pr[:, :, 0] - lam * pr[:, :, 1]).astype(v_parts[0].dtype)
        terms, start = [], 0
        for vp, n in zip(v_parts, sizes):
            terms.append(jnp.einsum('bhqk,bkhe->bqhe', w[..., start:start + n], vp))
            start += n
        return sum(terms[1:], terms[0])
    return map_query_blocks(blk, q)


def diff_out(o, subln_w, lam_init, w_out):
    o = rms_norm(o, subln_w) * (1.0 - lam_init)
    return o.reshape(o.shape[0], o.shape[1], -1) @ w_out


def lambda_init_of(li):
    return 0.8 - 0.6 * math.exp(-0.3 * li)


def lower_bounds(lb_logits):
    sm = jax.nn.softmax(lb_logits.astype(F32), axis=0)
    return jnp.cumsum(sm, axis=0) - sm[0]


def even_layer_ctx(h, p, j, lbs):
    (q_r, g_f, g_b, v_r, gate), (q_a, k_a, v_a) = even_inputs(
        h, p['w_in_even'][j], lbs[j], p['swa_qnorm_w'][j], p['swa_knorm_w'][j])
    zeros = jnp.zeros((h.shape[0], H_A, DK_A, DV_A), F32)
    o_r, s_ctx = hgrn_bidir(q_r, g_f, g_b, v_r, zeros, zeros)
    out_a = hgrn_readout(o_r, gate, p['hgrn_norm_w'][j])
    out_b = swa_context_attention(q_a, k_a, v_a, p['swa_sink'][j])
    y = jnp.concatenate([out_a, out_b.astype(out_a.dtype)], -1) @ p['w_out_even'][j]
    return y, k_a, v_a, s_ctx.astype(h.dtype)


def even_layer_lat(h, p, j, lbs, k_ctx, v_ctx, s_ctx):
    (q_r, g_f, g_b, v_r, gate), (q_a, k_a, v_a) = even_inputs(
        h, p['w_in_even'][j], lbs[j], p['swa_qnorm_w'][j], p['swa_knorm_w'][j])
    s0 = s_ctx.astype(F32)
    o_r, _ = hgrn_bidir(q_r, g_f, g_b, v_r, s0[:, 0], s0[:, 1])
    out_a = hgrn_readout(o_r, gate, p['hgrn_norm_w'][j])
    out_b = swa_latent_attention(rope_2d(q_a), rope_2d(k_a), v_a, k_ctx, v_ctx, p['swa_sink'][j])
    return jnp.concatenate([out_a, out_b.astype(out_a.dtype)], -1) @ p['w_out_even'][j]


def odd_layer_ctx(h, p, j, li):
    q, k, v = odd_inputs(h, p['w_in_odd'][j], p['diff_qnorm_w'][j], p['diff_knorm_w'][j])
    lam_init = lambda_init_of(li)
    o = diff_attention(q, [k], [v], diff_lambda(p['diff_lambda_p'][j], lam_init))
    return diff_out(o, p['diff_subln_w'][j], lam_init, p['w_out_odd'][j]), k, v


def odd_layer_lat(h, p, j, li, k_ctx, v_ctx):
    q, k, v = odd_inputs(h, p['w_in_odd'][j], p['diff_qnorm_w'][j], p['diff_knorm_w'][j])
    lam_init = lambda_init_of(li)
    o = diff_attention(rope_2d_pairs(q), [rope_2d_pairs(k), k_ctx], [v, v_ctx],
                       diff_lambda(p['diff_lambda_p'][j], lam_init))
    return diff_out(o, p['diff_subln_w'][j], lam_init, p['w_out_odd'][j])


def sq_relu_mlp(h, w1, w2):
    return jnp.square(jax.nn.relu(h @ w1)) @ w2


def context_trunk(x, c_ctx, p):
    lbs = lower_bounds(p['hgrn_lb_logits'])
    cvec = c_ctx[None, :]
    ks, vs, ss, kd, vd = [], [], [], [], []
    for li in range(DEPTH):
        sh1, sc1, g1, sh2, sc2, g2 = ada_mods(cvec, p['w_ada'][li], p['b_ada'][li])
        h = rms_norm(x, p['norm_w'][li, 0]) * (1 + sc1) + sh1
        j = li // 2
        if li % 2 == 0:
            y, k, v, s = even_layer_ctx(h, p, j, lbs)
            ks.append(k); vs.append(v); ss.append(s)
        else:
            y, k, v = odd_layer_ctx(h, p, j, li)
            kd.append(k); vd.append(v)
        x = x + g1 * y
        h = rms_norm(x, p['norm_w'][li, 1]) * (1 + sc2) + sh2
        x = x + g2 * sq_relu_mlp(h, p['w_mlp1'][li], p['w_mlp2'][li])
    return (x, jnp.stack(ks, 1), jnp.stack(vs, 1), jnp.stack(ss, 1),
            jnp.stack(kd, 1), jnp.stack(vd, 1))


def latent_trunk(x, c, cache_k_swa, cache_v_swa, state_hgrn, cache_k_diff, cache_v_diff, p):
    lbs = lower_bounds(p['hgrn_lb_logits'])
    for li in range(DEPTH):
        sh1, sc1, g1, sh2, sc2, g2 = ada_mods(c, p['w_ada'][li], p['b_ada'][li])
        h = rms_norm(x, p['norm_w'][li, 0]) * (1 + sc1) + sh1
        j = li // 2
        if li % 2 == 0:
            y = even_layer_lat(h, p, j, lbs, cache_k_swa[:, j], cache_v_swa[:, j], state_hgrn[:, j])
        else:
            y = odd_layer_lat(h, p, j, li, cache_k_diff[:, j], cache_v_diff[:, j])
        x = x + g1 * y
        h = rms_norm(x, p['norm_w'][li, 1]) * (1 + sc2) + sh2
        x = x + g2 * sq_relu_mlp(h, p['w_mlp1'][li], p['w_mlp2'][li])
    return x


def setup_inputs(seed: int = 0) -> dict:
    key = jax.random.key(seed)
    ks = jax.random.split(key, 27)
    D = D_MODEL
    def nrm(k, shape, scale=1.0):
        return scale * jax.random.normal(k, shape, F32)
    return {
        'x_prompt': nrm(ks[0], (BATCH, SEQ, D)),
        'x_sample': nrm(ks[1], (DEC_BATCH, DEC_SEQ, D)),
        'cache_k_swa': nrm(ks[2], (DEC_BATCH, N_EVEN, PAST_LEN, KV_B, HD_B)),
        'cache_v_swa': nrm(ks[3], (DEC_BATCH, N_EVEN, PAST_LEN, KV_B, HD_B)),
        'state_hgrn': nrm(ks[4], (DEC_BATCH, N_EVEN, 2, H_A, DK_A, DV_A), 0.5),
        'cache_k_diff': nrm(ks[5], (DEC_BATCH, N_ODD, PAST_LEN, H_C, 2, HD_C)),
        'cache_v_diff': nrm(ks[6], (DEC_BATCH, N_ODD, PAST_LEN, H_C, 2 * HD_C)),
        'c': nrm(ks[7], (DEC_BATCH, D)),
        'c_ctx': nrm(ks[8], (D,)),
        'norm_w': 1.0 + nrm(ks[9], (DEPTH, 2, D), 0.02),
        'w_ada': nrm(ks[10], (DEPTH, D, 6 * D), 0.5 * D ** -0.5),
        'b_ada': nrm(ks[11], (DEPTH, 6 * D), 0.01),
        'w_in_even': nrm(ks[12], (N_EVEN, D, EVEN_COLS), D ** -0.5),
        'w_out_even': nrm(ks[13], (N_EVEN, D_MIX, D), D_MIX ** -0.5),
        'hgrn_lb_logits': nrm(ks[14], (N_EVEN, 2, F_A), 0.5),
        'hgrn_norm_w': 1.0 + nrm(ks[15], (N_EVEN, DV_A), 0.02),
        'swa_qnorm_w': 1.0 + nrm(ks[16], (N_EVEN, HD_B), 0.02),
        'swa_knorm_w': 1.0 + nrm(ks[17], (N_EVEN, HD_B), 0.02),
        'swa_sink': nrm(ks[18], (N_EVEN, H_B), 0.5),
        'w_in_odd': nrm(ks[19], (N_ODD, D, ODD_COLS), D ** -0.5),
        'w_out_odd': nrm(ks[20], (N_ODD, ODD_W, D), ODD_W ** -0.5),
        'diff_qnorm_w': 1.0 + nrm(ks[21], (N_ODD, HD_C), 0.02),
        'diff_knorm_w': 1.0 + nrm(ks[22], (N_ODD, HD_C), 0.02),
        'diff_lambda_p': nrm(ks[23], (N_ODD, 4, HD_C), 0.1),
        'diff_subln_w': 1.0 + nrm(ks[24], (N_ODD, 2 * HD_C), 0.02),
        'w_mlp1': nrm(ks[25], (DEPTH, D, D_FF), D ** -0.5),
        'w_mlp2': nrm(ks[26], (DEPTH, D_FF, D), D_FF ** -0.5),
    }


def reference(x_prompt, x_sample, cache_k_swa, cache_v_swa, state_hgrn, cache_k_diff, cache_v_diff,
              c, c_ctx, norm_w, w_ada, b_ada, w_in_even, w_out_even, hgrn_lb_logits, hgrn_norm_w,
              swa_qnorm_w, swa_knorm_w, swa_sink, w_in_odd, w_out_odd, diff_qnorm_w, diff_knorm_w,
              diff_lambda_p, diff_subln_w, w_mlp1, w_mlp2):
    p = dict(norm_w=norm_w, w_ada=w_ada, b_ada=b_ada, w_in_even=w_in_even, w_out_even=w_out_even,
             hgrn_lb_logits=hgrn_lb_logits, hgrn_norm_w=hgrn_norm_w, swa_qnorm_w=swa_qnorm_w,
             swa_knorm_w=swa_knorm_w, swa_sink=swa_sink, w_in_odd=w_in_odd, w_out_odd=w_out_odd,
             diff_qnorm_w=diff_qnorm_w, diff_knorm_w=diff_knorm_w, diff_lambda_p=diff_lambda_p,
             diff_subln_w=diff_subln_w, w_mlp1=w_mlp1, w_mlp2=w_mlp2)
    y_prompt, new_k_swa, new_v_swa, new_state_hgrn, new_k_diff, new_v_diff = context_trunk(x_prompt, c_ctx, p)
    y_sample = latent_trunk(x_sample, c, cache_k_swa, cache_v_swa, state_hgrn, cache_k_diff, cache_v_diff, p)
    return (y_prompt, y_sample, new_k_swa, new_v_swa, new_state_hgrn, new_k_diff, new_v_diff)
```

```cpp
#include <hip/hip_runtime.h>
#include <hip/hip_cooperative_groups.h>
#include <cstdio>
#include <cstdint>
namespace cg = cooperative_groups;
#ifndef DUP_MASK
#define DUP_MASK 0
#endif
#define GAS __attribute__((address_space(1)))
#define LDS_BARRIER() do { asm volatile("s_waitcnt lgkmcnt(0)" ::: "memory"); __builtin_amdgcn_s_barrier(); asm volatile("" ::: "memory"); } while (0)
__device__ __forceinline__ int tid_l() { int t = threadIdx.x; asm volatile("" : "+v"(t)); return t; }
namespace pg8 {
#define PG8_LAS __attribute__((address_space(3)))
typedef unsigned short bf16_t;
typedef short bf16x8 __attribute__((ext_vector_type(8)));
typedef float f32x4 __attribute__((ext_vector_type(4)));
typedef unsigned u32x4 __attribute__((ext_vector_type(4)));
constexpr int BM = 256, BK = 64, HALF = 128, HTB = HALF * BK * 2  , STAGE_BYTES = 8 * HTB, NXCD = 8, WGM = 8;

__host__ __device__ __forceinline__ int lds_byte(int r, int c) { const int st = (r >> 4) * 2 + (c >> 5), rr = r & 15, cc = c & 31, ob = rr * 64 + cc * 2; return st * 1024 + (ob ^ (((ob >> 9) & 1) << 5)); }
__host__ __device__ __forceinline__ void stage_rc(int b, int& R, int& C) { const int st = b / 1024, sb = b % 1024, swz = sb ^ (((sb >> 9) & 1) << 5); R = (st >> 1) * 16 + swz / 64; C = (st & 1) * 32 + (swz % 64) / 2; }
__host__ __device__ __forceinline__ int perm32(int rho) { const int n = rho >> 4, i = rho & 15; return 8 * (i >> 2) + 4 * n + (i & 3); }

struct Unit { int pm, pn, ks; };
struct Gemm { const bf16_t* A; const bf16_t* Bt; int M, N, K, ld, KS; };

struct StaticOrder {
    int nM, nN, nwg, G, c, nNr;
    __host__ __device__ void init(int M, int N, int G_, int c_, int KS = 1) { nM = M / BM; nNr = N / BM; nN = nNr * KS; nwg = nM * nN; G = G_; c = c_; }
    __host__ __device__ bool next(int i, Unit& u) const {
        const long L = (long)i * G + c; if (L >= nwg) return false;
        int wgid = (int)L; { const int q = nwg / NXCD, r = nwg % NXCD, xcd = wgid % NXCD, off = wgid / NXCD; wgid = (xcd < r ? xcd * (q + 1) : r * (q + 1) + (xcd - r) * q) + off; }
        const int nig = WGM * nN, gid = wgid / nig, fm = gid * WGM, gsz = (nM - fm) < WGM ? (nM - fm) : WGM;
        u.pm = fm + ((wgid % nig) % gsz); { const int pq = (wgid % nig) / gsz; u.pn = pq % nNr; u.ks = pq / nNr; } return true;
    }
    __device__ __forceinline__ void a_ready(const Unit&) const {}
    __device__ __forceinline__ void done(const Unit&) const {}
};

__device__ __forceinline__ unsigned cvt_pk_bf16(float lo, float hi) { unsigned r; asm volatile("v_cvt_pk_bf16_f32 %0, %1, %2" : "=v"(r) : "v"(lo), "v"(hi)); return r; }
typedef float f32x2 __attribute__((ext_vector_type(2)));
typedef unsigned u32x2 __attribute__((ext_vector_type(2)));

#define LDSP __attribute__((address_space(3)))
__device__ __forceinline__ unsigned long long ldq(const unsigned LDSP* pb, int i) { const unsigned lo = __builtin_amdgcn_readfirstlane(pb[2 * i]), hi = __builtin_amdgcn_readfirstlane(pb[2 * i + 1]); return ((unsigned long long)hi << 32) | lo; }
__device__ __forceinline__ float dpp_x1(float x) { return __builtin_bit_cast(float, __builtin_amdgcn_update_dpp(0, __builtin_bit_cast(int, x), 0xB1, 0xf, 0xf, true)); }
__device__ __forceinline__ float dpp_x2(float x) { return __builtin_bit_cast(float, __builtin_amdgcn_update_dpp(0, __builtin_bit_cast(int, x), 0x4E, 0xf, 0xf, true)); }
__device__ __forceinline__ void quad_transpose(float& v0, float& v1, float& v2, float& v3, int a) {
    { const bool hi = a & 1; const float r0 = dpp_x1(hi ? v0 : v1), r1 = dpp_x1(hi ? v2 : v3); if (hi) { v0 = r0; v2 = r1; } else { v1 = r0; v3 = r1; } }
    { const bool hi = a & 2; const float r0 = dpp_x2(hi ? v0 : v2), r1 = dpp_x2(hi ? v1 : v3); if (hi) { v0 = r0; v1 = r1; } else { v2 = r0; v3 = r1; } }
}
struct EpiRelu2 {
    static constexpr bool PERM = true, AFTER_DRAIN = false;
    bf16_t* O; int ldc;
    __device__ __forceinline__ void operator()(const f32x4 (&acc)[2][2][4][2], const Unit& u, int wr, int wc, int fr, int fq) const {
        const int row0 = u.pm * BM + wr * 64 + fr; const int col0 = u.pn * BM + wc * 32 + 8 * fq;
#pragma unroll
        for (int ai = 0; ai < 2; ++ai)
#pragma unroll
            for (int m = 0; m < 4; ++m) { bf16_t* rowp = O + (size_t)(row0 + ai * HALF + m * 16) * ldc + col0;
#pragma unroll
                for (int bj = 0; bj < 2; ++bj) { f32x4 v0 = acc[ai][bj][m][0], v1 = acc[ai][bj][m][1];
#pragma unroll
                    for (int i = 0; i < 4; ++i) { float a = fmaxf(v0[i], 0.f), b = fmaxf(v1[i], 0.f); v0[i] = a * a; v1[i] = b * b; }
                    u32x4 w; w.x = cvt_pk_bf16(v0[0], v0[1]); w.y = cvt_pk_bf16(v0[2], v0[3]); w.z = cvt_pk_bf16(v1[0], v1[1]); w.w = cvt_pk_bf16(v1[2], v1[3]);
                    *(u32x4*)(rowp + bj * HALF) = w; } }
    }
};
struct EpiPart {
    static constexpr bool PERM = true, AFTER_DRAIN = false;
    bf16_t* P0; bf16_t* P1;
    __device__ __forceinline__ void operator()(const f32x4 (&acc)[2][2][4][2], const Unit& u, int wr, int wc, int fr, int fq) const {
        bf16_t* P = u.ks ? P1 : P0;
        const int col0 = u.pn * BM + wc * 32 + 8 * fq;
#pragma unroll
        for (int ai = 0; ai < 2; ++ai)
#pragma unroll
            for (int m = 0; m < 4; ++m) { bf16_t* rowp = P + (size_t)(u.pm * BM + ai * HALF + wr * 64 + m * 16 + fr) * 1024 + col0;
#pragma unroll
                for (int bj = 0; bj < 2; ++bj) { const f32x4 v0 = acc[ai][bj][m][0], v1 = acc[ai][bj][m][1];
                    u32x4 w; w.x = cvt_pk_bf16(v0[0], v0[1]); w.y = cvt_pk_bf16(v0[2], v0[3]); w.z = cvt_pk_bf16(v1[0], v1[1]); w.w = cvt_pk_bf16(v1[2], v1[3]);
                    *(u32x4*)(rowp + bj * HALF) = w; } }
    }
};
struct EpiIn {
    static constexpr bool PERM = false, AFTER_DRAIN = false;
    int odd, j; const unsigned LDSP* pb;
    __device__ __forceinline__ void operator()(const f32x4 (&acc)[2][2][4][2], const Unit& u, int wr, int wc, int fr, int fq) const {
        unsigned char* ws = (unsigned char*)ldq(pb, 28); float* outp = (float*)ldq(pb, 27);
        bf16_t* proj = (bf16_t*)(ws + 150u * 1048576u); const int ldp = odd ? 3072 : 768; float* hg = (float*)(ws + 198u * 1048576u);
        const float* lbs = (const float*)(ws + 524288) + j * 1024; const float* rope = (const float*)(ws + 524288) + 4096;
        const float* qnw = (const float*)ldq(pb, odd ? 21 : 16) + j * 64; const float* knw = (const float*)ldq(pb, odd ? 22 : 17) + j * 64;
        float* outk = outp + (odd ? 14680064 : 8388608); float* outv = outp + (odd ? 23068672 : 9437184);
        const int unit = u.pn * 4 + wc;
        int type;
        if (!odd) type = unit < 8 ? 0 : unit < 24 ? 1 : unit < 40 ? 2 : unit < 48 ? 3 : unit < 50 ? 4 : 5;
        else type = unit < 16 ? 3 : unit < 32 ? 4 : 5;
        const int pu = odd ? unit : unit - 40;
        const bool lat = u.pm >= 16;
        f32x4 w4[2][2];
        if (type == 3 || type == 4) { const float* nw = (type == 3) ? qnw : knw;
#pragma unroll
            for (int bj = 0; bj < 2; ++bj)
#pragma unroll
                for (int n = 0; n < 2; ++n) w4[bj][n] = *(const f32x4*)(nw + 32 * bj + 16 * n + 4 * fq); }
        else if (type == 1) { const float* lb = lbs + ((unit - 8) >> 3) * 512 + ((unit - 8) & 7) * 64;
#pragma unroll
            for (int bj = 0; bj < 2; ++bj)
#pragma unroll
                for (int n = 0; n < 2; ++n) w4[bj][n] = *(const f32x4*)(lb + 32 * bj + 16 * n + 4 * fq); }
        else {
#pragma unroll
            for (int bj = 0; bj < 2; ++bj)
#pragma unroll
                for (int n = 0; n < 2; ++n) w4[bj][n] = (f32x4){0.f, 0.f, 0.f, 0.f}; }
#pragma unroll
        for (int ai = 0; ai < 2; ++ai)
#pragma unroll
            for (int m = 0; m < 4; ++m) {
                const int row = u.pm * BM + ai * HALF + wr * 64 + m * 16 + fr;
                f32x4 v[2][2];
#pragma unroll
                for (int bj = 0; bj < 2; ++bj)
#pragma unroll
                    for (int n = 0; n < 2; ++n) v[bj][n] = acc[ai][bj][m][n];
                if (type <= 2) {
                    float* hp = hg + (size_t)row * 2560 + unit * 64 + 4 * fq;
#pragma unroll
                    for (int bj = 0; bj < 2; ++bj)
#pragma unroll
                        for (int n = 0; n < 2; ++n) { f32x4 xv = v[bj][n];
                            if (type == 0) {
#pragma unroll
                                for (int i = 0; i < 4; ++i) xv[i] = xv[i] * __builtin_amdgcn_rcpf(1.f + __expf(-xv[i])) * 0.08838834764831845f; }
                            else if (type == 1) {
#pragma unroll
                                for (int i = 0; i < 4; ++i) { const float sg = __builtin_amdgcn_rcpf(1.f + __expf(-xv[i])); const float lb = w4[bj][n][i]; xv[i] = lb + (1.f - lb) * sg; } }
                            *(f32x4*)(hp + 32 * bj + 16 * n) = xv; }
                } else {
                    if (type != 5) {
                        float ss = 0.f;
#pragma unroll
                        for (int bj = 0; bj < 2; ++bj)
#pragma unroll
                            for (int n = 0; n < 2; ++n) { const f32x4 xv = v[bj][n]; ss += (xv[0] * xv[0] + xv[1] * xv[1]) + (xv[2] * xv[2] + xv[3] * xv[3]); }
                        ss += __shfl_xor(ss, 16); ss += __shfl_xor(ss, 32);
                        const float rs = rsqrtf(ss * (1.f / 64.f) + 1e-6f);
#pragma unroll
                        for (int bj = 0; bj < 2; ++bj)
#pragma unroll
                            for (int n = 0; n < 2; ++n) v[bj][n] = v[bj][n] * rs * w4[bj][n];
                    }
                    if (!lat && type >= 4) {
                        float* ob = (type == 4) ? outk : outv;
                        const int b = row >> 8, t = row & 255;
                        size_t off;
                        if (!odd) off = ((size_t)(b * 2 + j) * 256 + t) * 128 + (size_t)(unit - (type == 4 ? 48 : 50)) * 64;
                        else off = ((size_t)(b * 2 + j) * 256 + t) * 1024 + (size_t)(unit - (type == 4 ? 16 : 32)) * 64;
#pragma unroll
                        for (int bj = 0; bj < 2; ++bj)
#pragma unroll
                            for (int n = 0; n < 2; ++n) *(f32x4*)(ob + off + 32 * bj + 16 * n + 4 * fq) = v[bj][n];
                    }
                    if (lat && type != 5) {
                        const int t = (row - 4096) & 1023; const int rp = t >> 6, cp = t & 63;
#pragma unroll
                        for (int bj = 0; bj < 2; ++bj)
#pragma unroll
                            for (int n = 0; n < 2; ++n) { const f32x4 cs = *(const f32x4*)(rope + ((bj ? cp : rp) * 16 + 8 * n + 2 * fq) * 2);
                                const f32x4 xv = v[bj][n]; f32x4 o;
                                o[0] = xv[0] * cs[0] - xv[1] * cs[1]; o[1] = xv[0] * cs[1] + xv[1] * cs[0];
                                o[2] = xv[2] * cs[2] - xv[3] * cs[3]; o[3] = xv[2] * cs[3] + xv[3] * cs[2]; v[bj][n] = o; }
                    }
                    if (type == 5) {
                        const int t = lat ? ((row - 4096) & 1023) : (row & 255); const int L = lat ? 1024 : 256; const int C = odd ? 1024 : 128;
                        const int a = fr & 3;
                        unsigned short* vp = (unsigned short*)(ws + 310u * 1048576u) + (size_t)C * (row - t) + (size_t)((unit - (odd ? 32 : 50)) * 64 + 4 * fq + a) * L + (t - a);
#pragma unroll
                        for (int bj = 0; bj < 2; ++bj)
#pragma unroll
                            for (int n = 0; n < 2; ++n) { float x0 = v[bj][n][0], x1 = v[bj][n][1], x2 = v[bj][n][2], x3 = v[bj][n][3];
                                quad_transpose(x0, x1, x2, x3, a);
                                u32x2 w; w.x = cvt_pk_bf16(x0, x1); w.y = cvt_pk_bf16(x2, x3);
                                *(u32x2*)(vp + (size_t)(32 * bj + 16 * n) * L) = w; }
                    } else {
                    bf16_t* pp = proj + (size_t)row * ldp + pu * 64 + 4 * fq;
#pragma unroll
                    for (int bj = 0; bj < 2; ++bj)
#pragma unroll
                        for (int n = 0; n < 2; ++n) { u32x2 w; w.x = cvt_pk_bf16(v[bj][n][0], v[bj][n][1]); w.y = cvt_pk_bf16(v[bj][n][2], v[bj][n][3]); *(u32x2*)(pp + 32 * bj + 16 * n) = w; }
                    }
                }
            }
    }
};

template <class Epi, class Sched, bool ALIGN_EPI = false, bool SP2 = false>
__device__ __forceinline__ void gemm_phase(PG8_LAS unsigned char* lds, const Gemm g, const Sched& S, const Epi& E) {
    const int tid = tid_l(), wid = __builtin_amdgcn_readfirstlane(tid >> 6), lane = tid & 63, wr = wid >> 2, wc = wid & 3, fr = lane & 15, fq = lane >> 4;
    const int K = g.ld, nt = g.K / BK;
    unsigned voffA[2], voffB[2];
#pragma unroll
    for (int i = 0; i < 2; ++i) { int R, C; stage_rc(tid * 16 + i * 8192, R, C); const int Rb = Epi::PERM ? ((R & ~31) + perm32(R & 31)) : R;
        voffA[i] = (unsigned)(R * K + C) * 2u; voffB[i] = (unsigned)(Rb * K + C) * 2u; }
    const size_t kstep = (size_t)(BK * 2);
    const size_t hstep = (size_t)HALF * K * 2;
    const size_t tstep = 2 * hstep;
    const unsigned ldsw = (unsigned)wid * 1024u;
    const int aoff = lds_byte(wr * 64 + fr, fq * 8), boff = lds_byte(wc * 32 + fr, fq * 8);
#define PG8_SA(b, h) (((b) * 2 + (h)) * HTB)
#define PG8_SB(b, h) ((4 + (b) * 2 + (h)) * HTB)
#define PG8_STAGE(bufoff, gbase, voff) do { _Pragma("unroll") for (int _i = 0; _i < 2; ++_i) \
        __builtin_amdgcn_global_load_lds((const unsigned*)((const char*)(gbase) + (voff)[_i]), (PG8_LAS unsigned*)(lds + (bufoff) + ldsw + _i * 8192), 16, 0, 0); } while (0)
#define PG8_LDA(dst, b, h) do { _Pragma("unroll") for (int m = 0; m < 4; ++m) _Pragma("unroll") for (int k = 0; k < 2; ++k) dst[m][k] = *(const PG8_LAS bf16x8*)(lds + PG8_SA(b, h) + aoff + m * 2048 + k * 1024); } while (0)
#define PG8_LDB(dst, b, h) do { _Pragma("unroll") for (int n = 0; n < 2; ++n) _Pragma("unroll") for (int k = 0; k < 2; ++k) dst[n][k] = *(const PG8_LAS bf16x8*)(lds + PG8_SB(b, h) + boff + n * 2048 + k * 1024); } while (0)
#define PG8_MMA(ai, bj, At, Bt) do { __builtin_amdgcn_s_setprio(1); _Pragma("unroll") for (int m = 0; m < 4; ++m) _Pragma("unroll") for (int n = 0; n < 2; ++n) _Pragma("unroll") for (int k = 0; k < 2; ++k) \
        acc[ai][bj][m][n] = __builtin_amdgcn_mfma_f32_16x16x32_bf16(Bt[n][k], At[m][k], acc[ai][bj][m][n], 0, 0, 0); __builtin_amdgcn_s_setprio(0); } while (0)
#define PG8_WAIT_V(n) asm volatile("s_waitcnt vmcnt(" #n ")" ::: "memory")
#define PG8_WAIT_L(n) asm volatile("s_waitcnt lgkmcnt(" #n ")" ::: "memory")
#define PG8_BAR __builtin_amdgcn_s_barrier()
#define PG8_SCHED __builtin_amdgcn_sched_barrier(0)
    Unit cur, nxt; int ui = 0;
    if (!S.next(0, cur)) return;
    f32x4 acc[2][2][4][2];
#pragma unroll
    for (int a = 0; a < 2; ++a)
#pragma unroll
        for (int b = 0; b < 2; ++b)
#pragma unroll
            for (int m = 0; m < 4; ++m)
#pragma unroll
                for (int n = 0; n < 2; ++n) acc[a][b][m][n] = (f32x4){0.f, 0.f, 0.f, 0.f};
    bf16x8 At[4][2], B0[2][2], B1[2][2];
    const char* cA = (const char*)g.A + (size_t)cur.pm * tstep + (size_t)cur.ks * g.K * 2; const char* cB = (const char*)g.Bt + (size_t)cur.pn * tstep + (size_t)cur.ks * g.K * 2;
    S.a_ready(cur);
    if constexpr (SP2) {
        PG8_STAGE(PG8_SB(0, 0), cB, voffB); PG8_STAGE(PG8_SB(0, 1), cB + hstep, voffB); PG8_STAGE(PG8_SA(0, 0), cA, voffA); PG8_STAGE(PG8_SA(0, 1), cA + hstep, voffA);
        if (wr == 1) PG8_BAR;
        PG8_WAIT_V(2); PG8_BAR;
        PG8_STAGE(PG8_SB(1, 0), cB + kstep, voffB); PG8_STAGE(PG8_SA(1, 0), cA + kstep, voffA); PG8_STAGE(PG8_SB(1, 1), cB + hstep + kstep, voffB);
        PG8_WAIT_V(6); PG8_BAR;
    } else {
        PG8_STAGE(PG8_SB(0, 0), cB, voffB); PG8_STAGE(PG8_SA(0, 0), cA, voffA); PG8_STAGE(PG8_SB(0, 1), cB + hstep, voffB); PG8_STAGE(PG8_SA(0, 1), cA + hstep, voffA);
        if (wr == 1) PG8_BAR;
        PG8_WAIT_V(4); PG8_BAR;
        PG8_STAGE(PG8_SB(1, 0), cB + kstep, voffB); PG8_STAGE(PG8_SA(1, 0), cA + kstep, voffA); PG8_STAGE(PG8_SB(1, 1), cB + hstep + kstep, voffB);
        PG8_WAIT_V(6); PG8_BAR;
    }
    for (;;) {
        const bool has_next = S.next(ui + 1, nxt);
        const char* nA = has_next ? (const char*)g.A + (size_t)nxt.pm * tstep + (size_t)nxt.ks * g.K * 2 : cA; const char* nB = has_next ? (const char*)g.Bt + (size_t)nxt.pn * tstep + (size_t)nxt.ks * g.K * 2 : cB;
        for (int t = 0; t < nt; t += 2) {
            const bool last = (t == nt - 2);
            const char* a1 = cA + (size_t)(t + 1) * kstep;
            const char* a2 = last ? nA : cA + (size_t)(t + 2) * kstep; const char* b2 = last ? nB : cB + (size_t)(t + 2) * kstep;
            const char* a3 = a2 + kstep; const char* b3 = b2 + kstep;
            if (last && has_next) S.a_ready(nxt);
            if constexpr (SP2) {
            PG8_LDB(B0, 0, 0); PG8_LDB(B1, 0, 1); PG8_SCHED; PG8_LDA(At, 0, 0); PG8_STAGE(PG8_SA(1, 1), a1 + hstep, voffA);
            PG8_WAIT_V(8); PG8_WAIT_L(0); PG8_BAR; PG8_MMA(0, 0, At, B0); PG8_MMA(0, 1, At, B1); PG8_BAR; PG8_SCHED;
            PG8_LDA(At, 0, 1); PG8_STAGE(PG8_SB(0, 0), b2, voffB); PG8_STAGE(PG8_SB(0, 1), b2 + hstep, voffB); PG8_STAGE(PG8_SA(0, 0), a2, voffA);
            PG8_WAIT_V(8); PG8_WAIT_L(0); PG8_BAR; PG8_MMA(1, 0, At, B0); PG8_MMA(1, 1, At, B1); PG8_BAR; PG8_SCHED;
            PG8_LDB(B0, 1, 0); PG8_LDB(B1, 1, 1); PG8_SCHED; PG8_LDA(At, 1, 0); PG8_STAGE(PG8_SA(0, 1), a2 + hstep, voffA);
            PG8_WAIT_V(8); PG8_WAIT_L(0); PG8_BAR; PG8_MMA(0, 0, At, B0); PG8_MMA(0, 1, At, B1); PG8_BAR; PG8_SCHED;
            PG8_LDA(At, 1, 1); PG8_STAGE(PG8_SB(1, 0), b3, voffB); PG8_STAGE(PG8_SB(1, 1), b3 + hstep, voffB); PG8_STAGE(PG8_SA(1, 0), a3, voffA);
            PG8_WAIT_V(8); PG8_WAIT_L(0); PG8_BAR; PG8_MMA(1, 0, At, B0); PG8_MMA(1, 1, At, B1); PG8_BAR; PG8_SCHED;
            } else {
            PG8_LDB(B0, 0, 0); PG8_SCHED; PG8_LDA(At, 0, 0); PG8_STAGE(PG8_SA(1, 1), a1 + hstep, voffA);
            PG8_WAIT_L(8); PG8_BAR; PG8_WAIT_L(0); PG8_MMA(0, 0, At, B0); PG8_BAR; PG8_SCHED;
            PG8_LDB(B1, 0, 1); PG8_STAGE(PG8_SB(0, 0), b2, voffB);
            PG8_BAR; PG8_WAIT_L(0); PG8_MMA(0, 1, At, B1); PG8_BAR;
            PG8_LDA(At, 0, 1); PG8_STAGE(PG8_SA(0, 0), a2, voffA);
            PG8_BAR; PG8_WAIT_L(0); PG8_MMA(1, 0, At, B0); PG8_BAR; PG8_SCHED;
            PG8_STAGE(PG8_SB(0, 1), b2 + hstep, voffB);
            PG8_WAIT_V(6); PG8_BAR; PG8_MMA(1, 1, At, B1); PG8_BAR;
            PG8_LDB(B0, 1, 0); PG8_SCHED; PG8_LDA(At, 1, 0); PG8_STAGE(PG8_SA(0, 1), a2 + hstep, voffA);
            PG8_WAIT_L(8); PG8_BAR; PG8_WAIT_L(0); PG8_MMA(0, 0, At, B0); PG8_BAR; PG8_SCHED;
            PG8_LDB(B1, 1, 1); PG8_STAGE(PG8_SB(1, 0), b3, voffB);
            PG8_BAR; PG8_WAIT_L(0); PG8_MMA(0, 1, At, B1); PG8_BAR;
            PG8_LDA(At, 1, 1); PG8_STAGE(PG8_SA(1, 0), a3, voffA);
            PG8_BAR; PG8_WAIT_L(0); PG8_MMA(1, 0, At, B0); PG8_BAR; PG8_SCHED;
            PG8_STAGE(PG8_SB(1, 1), b3 + hstep, voffB);
            PG8_WAIT_V(6); PG8_BAR; PG8_MMA(1, 1, At, B1); PG8_BAR;
            }
        }
        if constexpr (ALIGN_EPI) { if (wr == 0) PG8_BAR; }
        if constexpr (!Epi::AFTER_DRAIN) { E(acc, cur, wr, wc, fr, fq); S.done(cur); }
        if (!has_next) break;
#pragma unroll
        for (int a = 0; a < 2; ++a)
#pragma unroll
            for (int b = 0; b < 2; ++b)
#pragma unroll
                for (int m = 0; m < 4; ++m)
#pragma unroll
                    for (int n = 0; n < 2; ++n) acc[a][b][m][n] = (f32x4){0.f, 0.f, 0.f, 0.f};
        cur = nxt; cA = nA; cB = nB; ++ui;
        if constexpr (ALIGN_EPI) { if (wr == 1) PG8_BAR; }
    }
    PG8_WAIT_V(0);
    if constexpr (!ALIGN_EPI) { if (wr == 0) PG8_BAR; }
    PG8_BAR;
    if constexpr (Epi::AFTER_DRAIN) { E.fused(acc, cur, wr, wc, fr, fq, lds, wid, lane); S.done(cur); }
#undef PG8_SA
#undef PG8_SB
#undef PG8_STAGE
#undef PG8_LDA
#undef PG8_LDB
#undef PG8_MMA
#undef PG8_WAIT_V
#undef PG8_WAIT_L
#undef PG8_BAR
#undef PG8_SCHED
}
}
#define LAS __attribute__((address_space(3)))
typedef unsigned short bf16_t;
typedef short bf16x8 __attribute__((ext_vector_type(8)));
typedef float f32x4 __attribute__((ext_vector_type(4)));
typedef float f32x2 __attribute__((ext_vector_type(2)));
typedef unsigned u32x4 __attribute__((ext_vector_type(4)));
typedef unsigned u32x2 __attribute__((ext_vector_type(2)));
using pg8::cvt_pk_bf16;

constexpr int NTOK = 8192, DM = 1024, NEV = 3328, NOD = 3072, FF = 4096;
constexpr int LDS_BYTES = 147456;
constexpr size_t MiB = 1u << 20;
constexpr size_t WS_MODS = 0;
constexpr size_t WS_BAR = 492 * 1024;
constexpr size_t WS_TAB = 512 * 1024;
constexpr size_t WS_WINE = 2 * MiB, WS_WOUTE = 16 * MiB, WS_WINO = 20 * MiB, WS_WOUTO = 32 * MiB, WS_W1 = 36 * MiB, WS_W2 = 68 * MiB;
constexpr size_t WS_XN = 100 * MiB, WS_MIX = 116 * MiB;
constexpr size_t WS_CKS = 132 * MiB, WS_CVS = 133 * MiB, WS_CKD = 134 * MiB, WS_CVD = 142 * MiB;
constexpr size_t WS_P0 = 150 * MiB, WS_P1 = 278 * MiB;
constexpr size_t WS_PROJ = 150 * MiB, WS_HG = 198 * MiB, WS_OF = 278 * MiB, WS_OB = 294 * MiB, WS_H = 198 * MiB, WS_VT = 310 * MiB, WS_END = 326 * MiB;
constexpr size_t OUT_KS = 8388608, OUT_VS = 9437184, OUT_ST = 10485760, OUT_KD = 14680064, OUT_VD = 23068672;

struct Params { const float* in[27]; float* out; unsigned char* ws; int ph_lo, ph_hi; };
constexpr int PB_OFF = 143360;
struct PB {
    LAS unsigned char* l;
    __device__ __forceinline__ unsigned long long q(int i) const { const LAS unsigned* w = (const LAS unsigned*)(l + PB_OFF) + 2 * i; const unsigned lo = __builtin_amdgcn_readfirstlane(w[0]), hi = __builtin_amdgcn_readfirstlane(w[1]); return ((unsigned long long)hi << 32) | lo; }
    __device__ __forceinline__ const float* in(int i) const { return (const float*)q(i); }
    __device__ __forceinline__ float* out() const { return (float*)q(27); }
    __device__ __forceinline__ unsigned char* ws() const { return (unsigned char*)q(28); }
};

__device__ __forceinline__ float wave_sum(float v) {
#pragma unroll
    for (int o = 1; o < 64; o <<= 1) v += __shfl_xor(v, o);
    return v;
}

__device__ __forceinline__ void p0_transpose_item(const float* W, int K, int N, bf16_t* WT, bool hperm, LAS float* scr, int item, int lane) {
    const int nblk = N / 64, kb = item / nblk, nb = item % nblk, k0 = 64 * kb, n0 = 64 * nb;
    const float* wp = W + (size_t)(k0 + (lane >> 4)) * N + n0 + (lane & 15) * 4;
    f32x4 t4[16];
#pragma unroll
    for (int i = 0; i < 16; ++i) t4[i] = __builtin_nontemporal_load((const f32x4*)(wp + (size_t)(4 * i) * N));
#pragma unroll
    for (int i = 0; i < 16; ++i) { LAS float* d = scr + (4 * i + (lane >> 4)) * 65 + (lane & 15) * 4; d[0] = t4[i][0]; d[1] = t4[i][1]; d[2] = t4[i][2]; d[3] = t4[i][3]; }
    asm volatile("s_waitcnt lgkmcnt(0)" ::: "memory");
    const int c = lane & 7;
#pragma unroll
    for (int jj = 0; jj < 8; ++jj) { const int n = (lane >> 3) + 8 * jj; const LAS float* s = scr + (8 * c) * 65 + n;
        u32x4 o; o.x = cvt_pk_bf16(s[0 * 65], s[1 * 65]); o.y = cvt_pk_bf16(s[2 * 65], s[3 * 65]); o.z = cvt_pk_bf16(s[4 * 65], s[5 * 65]); o.w = cvt_pk_bf16(s[6 * 65], s[7 * 65]);
        const int col = n0 + n; int drow = col;
        if (hperm) { const int cc = col & 255; drow = (col & ~255) + ((cc >> 5) & 1) * 128 + (cc >> 6) * 32 + (cc & 31); }
        *(u32x4*)(WT + (size_t)drow * K + k0 + 8 * c) = o; }
    asm volatile("s_waitcnt lgkmcnt(0)" ::: "memory");
}

__device__ __forceinline__ void phase0(const PB p, LAS unsigned char* lds) {
    const int tid = tid_l(), lane = tid & 63, wave = __builtin_amdgcn_readfirstlane(tid >> 6);
    const int G = gridDim.x, bid = blockIdx.x;
    unsigned char* ws = p.ws();
    {
        LAS float* scr = (LAS float*)(lds + wave * 16640);
        const int gw = bid * 8 + wave, NGW = G * 8;
        constexpr int I_INE = 16 * (NEV / 64), I_SQ = 16 * 16, I_INO = 16 * (NOD / 64), I_W1 = 16 * (FF / 64), I_W2 = 64 * 16;
        constexpr int I_CVD = 8 * 16, I_CVS = 8 * 2;
        constexpr int NITEMS = 2 * I_INE + 2 * I_SQ + 2 * I_INO + 2 * I_SQ + 4 * I_W1 + 4 * I_W2 + 8 * I_CVD + 8 * I_CVS;
#ifdef PROBE_P0
        for (int rep_ = 0; rep_ < 2; ++rep_)
#endif
        for (int it = gw; it < NITEMS; it += NGW) {
            int r = it, jj, K = DM, N = DM, srci = 26; size_t dof; bool hp = false;
            if (r < 2 * I_INE) { jj = r / I_INE; r -= jj * I_INE; srci = 12; N = NEV; hp = true; dof = WS_WINE + (size_t)jj * NEV * DM * 2; }
            else if ((r -= 2 * I_INE) < 2 * I_SQ) { jj = r / I_SQ; r -= jj * I_SQ; srci = 13; dof = WS_WOUTE + (size_t)jj * DM * DM * 2; }
            else if ((r -= 2 * I_SQ) < 2 * I_INO) { jj = r / I_INO; r -= jj * I_INO; srci = 19; N = NOD; hp = true; dof = WS_WINO + (size_t)jj * NOD * DM * 2; }
            else if ((r -= 2 * I_INO) < 2 * I_SQ) { jj = r / I_SQ; r -= jj * I_SQ; srci = 20; dof = WS_WOUTO + (size_t)jj * DM * DM * 2; }
            else if ((r -= 2 * I_SQ) < 4 * I_W1) { jj = r / I_W1; r -= jj * I_W1; srci = 25; N = FF; dof = WS_W1 + (size_t)jj * FF * DM * 2; }
            else if ((r -= 4 * I_W1) < 4 * I_W2) { jj = r / I_W2; r -= jj * I_W2; srci = 26; K = FF; dof = WS_W2 + (size_t)jj * DM * FF * 2; }
            else if ((r -= 4 * I_W2) < 8 * I_CVD) { jj = r / I_CVD; r -= jj * I_CVD; srci = 6; K = 512; N = 1024; dof = WS_CVD + (size_t)jj * 1024 * 512 * 2; }
            else { r -= 8 * I_CVD; jj = r / I_CVS; r -= jj * I_CVS; srci = 3; K = 512; N = 128; dof = WS_CVS + (size_t)jj * 128 * 512 * 2; }
            p0_transpose_item(p.in(srci) + (size_t)jj * K * N, K, N, (bf16_t*)(ws + dof), hp, scr, r, lane);
        }
    }
    {
        float* mods = (float*)(ws + WS_MODS);
        LAS float* s = (LAS float*)lds; LAS float* red = (LAS float*)(lds + 20480);
        for (int u = bid; u < 192; u += G) {
            const int li = u / 48, nc = u % 48;
            __syncthreads();
            for (int e = tid; e < 5120; e += 512) { const int cnd = e >> 10, k = e & 1023; const float cv = (cnd == 0) ? p.in(8)[k] : p.in(7)[(cnd - 1) * 1024 + k]; s[e] = cv / (1.f + __expf(-cv)); }
            __syncthreads();
            const int kg = tid >> 7, col = tid & 127, n = nc * 128 + col;
            const float* w = p.in(10) + ((size_t)li * 1024 + kg * 256) * 6144 + n;
            const LAS float* sk = s + kg * 256;
            float a0 = 0.f, a1 = 0.f, a2 = 0.f, a3 = 0.f, a4 = 0.f;
#pragma unroll 8
            for (int k = 0; k < 256; ++k) { const float wv = w[(size_t)k * 6144]; a0 += sk[k] * wv; a1 += sk[1024 + k] * wv; a2 += sk[2048 + k] * wv; a3 += sk[3072 + k] * wv; a4 += sk[4096 + k] * wv; }
            red[(kg * 5 + 0) * 128 + col] = a0; red[(kg * 5 + 1) * 128 + col] = a1; red[(kg * 5 + 2) * 128 + col] = a2; red[(kg * 5 + 3) * 128 + col] = a3; red[(kg * 5 + 4) * 128 + col] = a4;
            __syncthreads();
            for (int e = tid; e < 640; e += 512) { const int c = e >> 7, cl = e & 127;
                const float sum = ((red[(0 * 5 + c) * 128 + cl] + red[(1 * 5 + c) * 128 + cl]) + red[(2 * 5 + c) * 128 + cl]) + red[(3 * 5 + c) * 128 + cl];
                mods[(size_t)(li * 5 + c) * 6144 + nc * 128 + cl] = sum + p.in(11)[li * 6144 + nc * 128 + cl]; }
        }
    }
    if (bid == G - 1) {
        float* tab = (float*)(ws + WS_TAB);
        for (int e = tid; e < 1024; e += 512) { const float l0 = p.in(14)[e], l1 = p.in(14)[1024 + e]; tab[e] = 0.f; tab[1024 + e] = 1.f / (1.f + __expf(l0 - l1)); }
        if (tid < 128) { const int jj = tid >> 6; const float* lp = p.in(23) + jj * 256;
            const float d1 = wave_sum(lp[lane] * lp[64 + lane]), d2 = wave_sum(lp[128 + lane] * lp[192 + lane]);
            const float li_ = (float)(2 * jj + 1); const float lam_init = 0.8f - 0.6f * expf(-0.3f * li_);
            if (lane == 0) { tab[2048 + jj] = expf(d1) - expf(d2) + lam_init; tab[2050 + jj] = lam_init; } }
        for (int e = tid; e < 1024; e += 512) { const int pos = e >> 4, f = e & 15;
            const float inv = exp2f(-(float)(2 * f) * (13.287712379549449f / 32.0f));
            const float a = (float)pos * inv;
            const float kk = rintf(a * 0.15915494309189535f); float rr = fmaf(-kk, 6.2831854820251465f, a); rr = fmaf(-kk, -1.7484555e-7f, rr);
            tab[4096 + e * 2] = __cosf(rr); tab[4096 + e * 2 + 1] = __sinf(rr); }
    }
    {
        const size_t gt = (size_t)bid * 512 + tid, GT = (size_t)G * 512;
#define CVT_ARR(SRC, DST, N4) for (size_t i = gt; i < (size_t)(N4); i += GT) { const f32x4 v = ((const f32x4*)(SRC))[i]; u32x2 w; w.x = cvt_pk_bf16(v[0], v[1]); w.y = cvt_pk_bf16(v[2], v[3]); ((u32x2*)(DST))[i] = w; }
        CVT_ARR(p.in(2), ws + WS_CKS, 131072) CVT_ARR(p.in(5), ws + WS_CKD, 1048576)
#undef CVT_ARR
    }
}

__device__ __forceinline__ f32x4 bf4(u32x2 w) { f32x4 r; r[0] = __builtin_bit_cast(float, w.x << 16); r[1] = __builtin_bit_cast(float, w.x & 0xffff0000u); r[2] = __builtin_bit_cast(float, w.y << 16); r[3] = __builtin_bit_cast(float, w.y & 0xffff0000u); return r; }
__device__ __forceinline__ void norm_phase(const PB p, int mode, int li, int which, int gate_off) {
    const int tid = tid_l(), lane = tid & 63, wave = tid >> 6;
    const int gw = blockIdx.x * 8 + wave, NGW = gridDim.x * 8;
    unsigned char* ws = p.ws();
    const float* mods = (const float*)(ws + WS_MODS);
    const bf16_t* P0 = (const bf16_t*)(ws + WS_P0); const bf16_t* P1 = (const bf16_t*)(ws + WS_P1);
    bf16_t* XN = (bf16_t*)(ws + WS_XN);
    float* xo = p.out();
    const float* nw = p.in(9) + (li * 2 + which) * 1024;
    const float* x0 = p.in(0); const float* x1 = p.in(1);
    for (int grp = gw; grp < NTOK / 4; grp += NGW) {
        const int row0 = grp * 4; const int cond = row0 < 4096 ? 0 : 1 + ((row0 - 4096) >> 10);
        const float* md = mods + (size_t)(li * 5 + cond) * 6144 + which * 3072;
        f32x4 g4[4], w4[4], sh4[4], sc4[4];
#pragma unroll
        for (int jj = 0; jj < 4; ++jj) { const int c = 4 * lane + 256 * jj;
            if (mode != 0) g4[jj] = *(const f32x4*)(mods + gate_off + cond * 6144 + c);
            if (mode != 2) { w4[jj] = *(const f32x4*)(nw + c); sh4[jj] = *(const f32x4*)(md + c); sc4[jj] = *(const f32x4*)(md + 1024 + c); } }
#pragma unroll
        for (int hh = 0; hh < 2; ++hh) {
            f32x4 x[2][4]; u32x2 a0[2][4], a1[2][4];
#pragma unroll
            for (int rr = 0; rr < 2; ++rr) { const int row = row0 + 2 * hh + rr;
                const float* xr = mode == 0 ? (row < 4096 ? x0 + (size_t)row * 1024 : x1 + (size_t)(row - 4096) * 1024) : xo + (size_t)row * 1024;
#pragma unroll
                for (int jj = 0; jj < 4; ++jj) { const int c = 4 * lane + 256 * jj; x[rr][jj] = __builtin_nontemporal_load((const f32x4*)(xr + c));
                    if (mode != 0) { a0[rr][jj] = __builtin_nontemporal_load((const u32x2*)(P0 + (size_t)row * 1024 + c)); a1[rr][jj] = __builtin_nontemporal_load((const u32x2*)(P1 + (size_t)row * 1024 + c)); } } }
#pragma unroll
            for (int rr = 0; rr < 2; ++rr) { const int row = row0 + 2 * hh + rr; float ss = 0.f;
#pragma unroll
                for (int jj = 0; jj < 4; ++jj) { const int c = 4 * lane + 256 * jj;
                    if (mode != 0) x[rr][jj] = x[rr][jj] + g4[jj] * (bf4(a0[rr][jj]) + bf4(a1[rr][jj]));
                    ss += (x[rr][jj][0] * x[rr][jj][0] + x[rr][jj][1] * x[rr][jj][1]) + (x[rr][jj][2] * x[rr][jj][2] + x[rr][jj][3] * x[rr][jj][3]);
                    __builtin_nontemporal_store(x[rr][jj], (f32x4*)(xo + (size_t)row * 1024 + c)); }
                if (mode != 2) {
                    const float rstd = rsqrtf(wave_sum(ss) * (1.f / 1024.f) + 1e-6f);
#pragma unroll
                    for (int jj = 0; jj < 4; ++jj) { const int c = 4 * lane + 256 * jj;
                        const f32x4 o = x[rr][jj] * rstd * w4[jj] * (1.f + sc4[jj]) + sh4[jj];
                        u32x2 pk; pk.x = cvt_pk_bf16(o[0], o[1]); pk.y = cvt_pk_bf16(o[2], o[3]);
                        *(u32x2*)(XN + (size_t)row * 1024 + c) = pk; } } }
        }
    }
}

constexpr int HC_QP = 0, HC_QPP = 17408, HC_KP = 34816, HC_KT = 52224, HC_VT = 70656, HC_ST = 89088, HC_P = 123904, HC_SC = 133120;
__device__ __forceinline__ float exp_c(float x) { return __builtin_amdgcn_exp2f(fminf(x, 115.f)); }
__device__ __forceinline__ unsigned short bf16r(float x) { return (unsigned short)(cvt_pk_bf16(x, 0.f) & 0xffffu); }
template <int BWD, int DIR> __device__ __forceinline__ void hc_load(float (&rq)[16], float (&rf)[16], float (&rv)[16], const GAS float* base) {
    constexpr int st = DIR ? -2560 : 2560, fo = 512 + DIR * 512;
    asm volatile("" : "+v"(base));
#pragma unroll
    for (int i = 0; i < 16; ++i) { const GAS float* rp = base + (BWD ? -i : i) * st; rq[i] = rp[0]; rf[i] = rp[fo]; rv[i] = rp[1536]; }
}
template <int BWD> __device__ __forceinline__ void hc_pass2(const float (&rq)[16], const float (&rf)[16], const float (&rv)[16], const float (&rel)[16], float off, float ecm, int ch, int anchor,
        LAS unsigned short* QP, LAS unsigned short* QPP, LAS unsigned short* KP, LAS unsigned short* KT, LAS unsigned short* VT, bool vmine) {
    LAS unsigned short* qp_ = QP + anchor * 136 + ch; LAS unsigned short* qpp_ = QPP + anchor * 136 + ch; LAS unsigned short* kp_ = KP + anchor * 136 + ch;
    unsigned kk[16];
#pragma unroll
    for (int i = 0; i < 16; ++i) { const int d = BWD ? -i : i; const float r = rel[i] + off;
        const float qp = rq[i] * exp_c(r); const float kp = (1.f - rf[i]) * exp_c(-r);
        qp_[d * 136] = bf16r(qp); qpp_[d * 136] = bf16r(qp * ecm); const unsigned short k16 = bf16r(kp); kp_[d * 136] = k16; kk[BWD ? 15 - i : i] = k16; }
    const int t0 = BWD ? anchor - 15 : anchor;
    u32x4 w0, w1, v0, v1;
    w0.x = kk[0] | (kk[1] << 16); w0.y = kk[2] | (kk[3] << 16); w0.z = kk[4] | (kk[5] << 16); w0.w = kk[6] | (kk[7] << 16);
    w1.x = kk[8] | (kk[9] << 16); w1.y = kk[10] | (kk[11] << 16); w1.z = kk[12] | (kk[13] << 16); w1.w = kk[14] | (kk[15] << 16);
#define RV(e_) rv[BWD ? 15 - (e_) : (e_)]
    v0.x = cvt_pk_bf16(RV(0), RV(1)); v0.y = cvt_pk_bf16(RV(2), RV(3)); v0.z = cvt_pk_bf16(RV(4), RV(5)); v0.w = cvt_pk_bf16(RV(6), RV(7));
    v1.x = cvt_pk_bf16(RV(8), RV(9)); v1.y = cvt_pk_bf16(RV(10), RV(11)); v1.z = cvt_pk_bf16(RV(12), RV(13)); v1.w = cvt_pk_bf16(RV(14), RV(15));
#undef RV
    *(LAS u32x4*)(KT + ch * 72 + t0) = w0; *(LAS u32x4*)(KT + ch * 72 + t0 + 8) = w1;
    if (vmine) { *(LAS u32x4*)(VT + (ch & 63) * 72 + t0) = v0; *(LAS u32x4*)(VT + (ch & 63) * 72 + t0 + 8) = v1; }
}
template <int DIR>
__device__ __forceinline__ void hgrn_chunked_item(const PB p, LAS unsigned char* lds, int j, int s, int h, int vh) {
    constexpr int dir = DIR;
    const int tid = tid_l(), lane = tid & 63, fr = lane & 15, fq = lane >> 4; const int w = __builtin_amdgcn_readfirstlane(tid >> 6);
    const int L = s < 16 ? 256 : 1024, R0 = s < 16 ? s * 256 : 4096 + (s - 16) * 1024;
    const GAS float* hg = (const GAS float*)(p.ws() + WS_HG);
    GAS float* og = (GAS float*)(p.ws() + (dir ? WS_OB : WS_OF));
    LAS unsigned short* QP = (LAS unsigned short*)(lds + HC_QP); LAS unsigned short* QPP = (LAS unsigned short*)(lds + HC_QPP); LAS unsigned short* KP = (LAS unsigned short*)(lds + HC_KP);
    LAS unsigned short* KT = (LAS unsigned short*)(lds + HC_KT); LAS unsigned short* VT = (LAS unsigned short*)(lds + HC_VT); LAS unsigned short* ST = (LAS unsigned short*)(lds + HC_ST);
    LAS unsigned short* PM = (LAS unsigned short*)(lds + HC_P); LAS float* scal = (LAS float*)(lds + HC_SC);
    const int vb = w & 3, kh = w >> 2;
    f32x4 S[4];
    if (s >= 16) { const GAS float* st = (const GAS float*)p.in(4) + ((((size_t)(s - 16) * 2 + j) * 2 + dir) * 4 + h) * 16384;
#pragma unroll
        for (int kb = 0; kb < 4; ++kb) S[kb] = *(const GAS f32x4*)(st + (size_t)(16 * (4 * kh + kb) + fr) * 128 + 64 * vh + 16 * vb + 4 * fq); }
    else {
#pragma unroll
        for (int kb = 0; kb < 4; ++kb) S[kb] = (f32x4){0.f, 0.f, 0.f, 0.f}; }
    const int quarter = __builtin_amdgcn_readfirstlane(tid >> 7); const bool bwd = quarter < 2; const int ch = tid & 127;
    const int anchor = quarter == 0 ? 15 : quarter == 1 ? 31 : quarter == 2 ? 32 : 48;
    constexpr int st = dir ? -2560 : 2560;
    const GAS float* row0 = hg + (size_t)(R0 + (dir ? L - 1 : 0)) * 2560 + h * 128;
    float rq[16], rf[16], rv[16];
    float nq[16], nf[16], nv[16];
#define HC_LOAD(cc_, Q_, F_, V_) do { const GAS float* rc_ = row0 + ((long)(cc_) * 64 + anchor) * st + ch; if (bwd) hc_load<1, DIR>(Q_, F_, V_, rc_); else hc_load<0, DIR>(Q_, F_, V_, rc_); } while (0)
    HC_LOAD(0, rq, rf, rv);
    LDS_BARRIER();
#pragma unroll
    for (int kb = 0; kb < 4; ++kb)
#pragma unroll
        for (int r = 0; r < 4; ++r) ST[(16 * vb + 4 * fq + r) * 136 + 16 * (4 * kh + kb) + fr] = bf16r(S[kb][r]);
    const int nchunk = L >> 6;
    for (int c = 0; c < nchunk; ++c) {
        float rel[16];
        if (c + 1 < nchunk) HC_LOAD(c + 1, nq, nf, nv);
        { float cc = 0.f;
#pragma unroll
            for (int i = 0; i < 16; ++i) { const float g = __builtin_amdgcn_logf(rf[i]);   if (!bwd) { cc += g; rel[i] = cc; } else { rel[i] = -cc; cc += g; } }
            scal[quarter * 128 + ch] = cc; }
        LDS_BARRIER();
        { const float t0 = scal[ch], t1 = scal[128 + ch], t2 = scal[256 + ch], t3 = scal[384 + ch];
            const float off = quarter == 0 ? -t1 : quarter == 3 ? t2 : 0.f; const float cm = t0 + t1;
            if (quarter == 1) scal[512 + ch] = cm; if (quarter == 2) scal[640 + ch] = t2 + t3;
            const float ecm = exp_c(cm);
            const bool vmine = (ch >> 6) == vh;
            if (bwd) hc_pass2<1>(rq, rf, rv, rel, off, ecm, ch, anchor, QP, QPP, KP, KT, VT, vmine); else hc_pass2<0>(rq, rf, rv, rel, off, ecm, ch, anchor, QP, QPP, KP, KT, VT, vmine); }
        LDS_BARRIER();
        { const int tb = w & 3, sh = w >> 2; const int t = 16 * tb + fr;
#pragma unroll
            for (int sbi = 0; sbi < 2; ++sbi) { const int sb = 2 * sh + sbi; f32x4 a = {0.f, 0.f, 0.f, 0.f};
                if (sb <= tb) {
#pragma unroll
                    for (int ks = 0; ks < 4; ++ks) { const bf16x8 A = *(const LAS bf16x8*)(KP + (16 * sb + fr) * 136 + 32 * ks + 8 * fq); const bf16x8 B = *(const LAS bf16x8*)(QP + (16 * tb + fr) * 136 + 32 * ks + 8 * fq);
                        a = __builtin_amdgcn_mfma_f32_16x16x32_bf16(A, B, a, 0, 0, 0); } }
#pragma unroll
                for (int r = 0; r < 4; ++r) if (16 * sb + 4 * fq + r > t) a[r] = 0.f;
                u32x2 wv; wv.x = cvt_pk_bf16(a[0], a[1]); wv.y = cvt_pk_bf16(a[2], a[3]);
                *(LAS u32x2*)(PM + t * 72 + 16 * sb + 4 * fq) = wv; } }
        LDS_BARRIER();
        { bf16x8 vt[2], stf[4];
#pragma unroll
            for (int sl = 0; sl < 2; ++sl) vt[sl] = *(const LAS bf16x8*)(VT + (16 * vb + fr) * 72 + 32 * sl + 8 * fq);
#pragma unroll
            for (int ks = 0; ks < 4; ++ks) stf[ks] = *(const LAS bf16x8*)(ST + (16 * vb + fr) * 136 + 32 * ks + 8 * fq);
            GAS float* ob = og + (size_t)(R0 + (dir ? L - 1 : 0)) * 512 + (long)c * 64 * (dir ? -512 : 512) + h * 128 + 64 * vh + 16 * vb + 4 * fq;
#pragma unroll
            for (int tbi = 0; tbi < 2; ++tbi) { const int tb = 2 * kh + tbi; f32x4 o = {0.f, 0.f, 0.f, 0.f};
#pragma unroll
                for (int sl = 0; sl < 2; ++sl) if (32 * sl <= 16 * tb + 15) { const bf16x8 B = *(const LAS bf16x8*)(PM + (16 * tb + fr) * 72 + 32 * sl + 8 * fq); o = __builtin_amdgcn_mfma_f32_16x16x32_bf16(vt[sl], B, o, 0, 0, 0); }
#pragma unroll
                for (int ks = 0; ks < 4; ++ks) { const bf16x8 B = *(const LAS bf16x8*)(QPP + (16 * tb + fr) * 136 + 32 * ks + 8 * fq); o = __builtin_amdgcn_mfma_f32_16x16x32_bf16(stf[ks], B, o, 0, 0, 0); }
                *(GAS f32x4*)(ob + (long)(16 * tb + fr) * (dir ? -512 : 512)) = o; }
#pragma unroll
            for (int kbi = 0; kbi < 4; ++kbi) { const int kb = 4 * kh + kbi; const float cmv = scal[512 + 16 * kb + fr], r63 = scal[640 + 16 * kb + fr]; const float dec = exp_c(cmv + r63), e63 = exp_c(r63);
                f32x4 tt = {0.f, 0.f, 0.f, 0.f};
#pragma unroll
                for (int sl = 0; sl < 2; ++sl) { const bf16x8 B = *(const LAS bf16x8*)(KT + (16 * kb + fr) * 72 + 32 * sl + 8 * fq); tt = __builtin_amdgcn_mfma_f32_16x16x32_bf16(vt[sl], B, tt, 0, 0, 0); }
                S[kbi] = S[kbi] * dec + tt * e63; } }
        LDS_BARRIER();
#pragma unroll
        for (int kb = 0; kb < 4; ++kb)
#pragma unroll
            for (int r = 0; r < 4; ++r) ST[(16 * vb + 4 * fq + r) * 136 + 16 * (4 * kh + kb) + fr] = bf16r(S[kb][r]);
#pragma unroll
        for (int i = 0; i < 16; ++i) { rq[i] = nq[i]; rf[i] = nf[i]; rv[i] = nv[i]; }
    }
#undef HC_LOAD
    if (s < 16) { GAS float* so = (GAS float*)p.out() + OUT_ST + ((((size_t)s * 2 + j) * 2 + dir) * 4 + h) * 16384;
#pragma unroll
        for (int kb = 0; kb < 4; ++kb) *(GAS f32x4*)(so + (size_t)(16 * (4 * kh + kb) + fr) * 128 + 64 * vh + 16 * vb + 4 * fq) = S[kb]; }
}
__device__ __forceinline__ void hgrn_chunked_dispatch(const PB p, LAS unsigned char* lds, int j, int it) {
    const int s = it >> 4, h = (it >> 2) & 3, vh = it & 1;
    if (it & 2) hgrn_chunked_item<1>(p, lds, j, s, h, vh); else hgrn_chunked_item<0>(p, lds, j, s, h, vh);
}
__device__ __forceinline__ void hgrn_readout(const PB p, int j) {
    const int tid = tid_l(), lane = tid & 63, wave = tid >> 6;
    const int gw = blockIdx.x * 8 + wave, NGW = gridDim.x * 8;
    const float* of = (const float*)(p.ws() + WS_OF); const float* ob = (const float*)(p.ws() + WS_OB); const float* hg = (const float*)(p.ws() + WS_HG);
    bf16_t* MIX = (bf16_t*)(p.ws() + WS_MIX);
    const int col = (lane >> 4) * 128 + (lane & 15) * 8;
    const float* nw = p.in(15) + j * 128 + (lane & 15) * 8;
    const f32x4 w0 = *(const f32x4*)nw, w1 = *(const f32x4*)(nw + 4);
    for (int row = gw; row < NTOK; row += NGW) {
        const f32x4 a0 = *(const f32x4*)(of + (size_t)row * 512 + col) + *(const f32x4*)(ob + (size_t)row * 512 + col);
        const f32x4 a1 = *(const f32x4*)(of + (size_t)row * 512 + col + 4) + *(const f32x4*)(ob + (size_t)row * 512 + col + 4);
        const f32x4 g0 = *(const f32x4*)(hg + (size_t)row * 2560 + 2048 + col), g1 = *(const f32x4*)(hg + (size_t)row * 2560 + 2048 + col + 4);
        float ss = (a0[0] * a0[0] + a0[1] * a0[1]) + (a0[2] * a0[2] + a0[3] * a0[3]) + (a1[0] * a1[0] + a1[1] * a1[1]) + (a1[2] * a1[2] + a1[3] * a1[3]);
        ss += __shfl_xor(ss, 1); ss += __shfl_xor(ss, 2); ss += __shfl_xor(ss, 4); ss += __shfl_xor(ss, 8);
        const float rs = rsqrtf(ss * (1.f / 128.f) + 1e-6f);
        f32x4 o0, o1;
#pragma unroll
        for (int i = 0; i < 4; ++i) { o0[i] = a0[i] * rs * w0[i] * g0[i] * __builtin_amdgcn_rcpf(1.f + __expf(-g0[i])); o1[i] = a1[i] * rs * w1[i] * g1[i] * __builtin_amdgcn_rcpf(1.f + __expf(-g1[i])); }
        u32x4 w; w.x = cvt_pk_bf16(o0[0], o0[1]); w.y = cvt_pk_bf16(o0[2], o0[3]); w.z = cvt_pk_bf16(o1[0], o1[1]); w.w = cvt_pk_bf16(o1[2], o1[3]);
        *(u32x4*)(MIX + (size_t)row * 1024 + col) = w;
    }
}

struct ASeg { const GAS bf16_t* K; const GAS bf16_t* V; int ldk, ldv, kpos0, ntiles, masked; };
template <int DV>
__device__ __forceinline__ void attn_tile(const LAS unsigned char* Ks, const LAS unsigned char* VT, bool msk, int kp0, int qpos, float c2, const bf16x8 qf0, const bf16x8 qf1, int fr, int fq, f32x4 (&o)[DV / 16], float& m, float& l) {
    f32x4 sc[4];
#pragma unroll
    for (int b = 0; b < 4; ++b) {
        const bf16x8 k0 = *(const LAS bf16x8*)(Ks + (16 * b + fr) * 144 + fq * 16), k1 = *(const LAS bf16x8*)(Ks + (16 * b + fr) * 144 + 64 + fq * 16);
        f32x4 a = {0.f, 0.f, 0.f, 0.f};
        a = __builtin_amdgcn_mfma_f32_16x16x32_bf16(k0, qf0, a, 0, 0, 0);
        a = __builtin_amdgcn_mfma_f32_16x16x32_bf16(k1, qf1, a, 0, 0, 0);
        sc[b] = a;
    }
    float mx = -1e30f; unsigned vmask = 0xffffu;
#pragma unroll
    for (int b = 0; b < 4; ++b)
#pragma unroll
        for (int r = 0; r < 4; ++r) { float v = sc[b][r];
            if (msk) { const int d = qpos - (kp0 + 32 * (b >> 1) + 4 * (b & 1) + r); if (d > 128 || d < -128) { v = -1e30f; vmask &= ~(1u << (b * 4 + r)); } }
            sc[b][r] = v; mx = fmaxf(mx, v); }
    mx *= c2;
    { auto r16 = __builtin_amdgcn_permlane16_swap(__float_as_uint(mx), __float_as_uint(mx), false, false); mx = fmaxf(__uint_as_float(r16[0]), __uint_as_float(r16[1]));
      auto r32 = __builtin_amdgcn_permlane32_swap(__float_as_uint(mx), __float_as_uint(mx), false, false); mx = fmaxf(__uint_as_float(r32[0]), __uint_as_float(r32[1])); }
    const float mn = fmaxf(m, mx); const float alpha = __builtin_amdgcn_exp2f(m - mn); m = mn;
    l *= alpha;
#pragma unroll
    for (int db = 0; db < DV / 16; ++db) o[db] = o[db] * alpha;
    float ls = 0.f;
#pragma unroll
    for (int b = 0; b < 4; ++b)
#pragma unroll
        for (int r = 0; r < 4; ++r) { float pr = __builtin_amdgcn_exp2f(fmaf(sc[b][r], c2, -mn)); if (msk && !((vmask >> (b * 4 + r)) & 1u)) pr = 0.f; sc[b][r] = pr; ls += pr; }
    l += ls;
    bf16x8 pf[2];
#pragma unroll
    for (int ks = 0; ks < 2; ++ks) { u32x4 w; w.x = cvt_pk_bf16(sc[2 * ks][0], sc[2 * ks][1]); w.y = cvt_pk_bf16(sc[2 * ks][2], sc[2 * ks][3]); w.z = cvt_pk_bf16(sc[2 * ks + 1][0], sc[2 * ks + 1][1]); w.w = cvt_pk_bf16(sc[2 * ks + 1][2], sc[2 * ks + 1][3]); pf[ks] = __builtin_bit_cast(bf16x8, w); }
#pragma unroll
    for (int db = 0; db < DV / 16; ++db)
#pragma unroll
        for (int ks = 0; ks < 2; ++ks) { const bf16x8 vv = *(const LAS bf16x8*)(VT + (16 * db + fr) * 144 + ks * 64 + fq * 16);
            o[db] = __builtin_amdgcn_mfma_f32_16x16x32_bf16(vv, pf[ks], o[db], 0, 0, 0); }
}
template <int DV>
__device__ __forceinline__ void attn_run(LAS unsigned char* lds, const GAS bf16_t* Qw, int qpos, const ASeg A, const ASeg B, float c2, f32x4 (&o)[DV / 16], float& m, float& l) {
    constexpr int BUF = 9216 + DV * 144;
    const int tid = tid_l(), lane = tid & 63, fr = lane & 15, fq = lane >> 4;
    const bf16x8 qf0 = *(const GAS bf16x8*)(Qw + fq * 8), qf1 = *(const GAS bf16x8*)(Qw + 32 + fq * 8);
    const int nt = A.ntiles + B.ntiles;
    const int kkey = tid >> 3, kch = tid & 7;
    const int krow = 32 * (kkey >> 5) + 16 * ((kkey >> 2) & 1) + 4 * ((kkey >> 3) & 3) + (kkey & 3);
    u32x4 kreg, vreg[DV / 64];
#define AT_LOAD(i_) do { const bool inA_ = (i_) < A.ntiles; const int ti_ = inA_ ? (i_) : (i_) - A.ntiles; const GAS bf16_t* kp_ = inA_ ? A.K : B.K; const GAS bf16_t* vp_ = inA_ ? A.V : B.V; const int ldk_ = inA_ ? A.ldk : B.ldk, ldv_ = inA_ ? A.ldv : B.ldv; \
        kreg = *(const GAS u32x4*)(kp_ + (size_t)(ti_ * 64 + kkey) * ldk_ + kch * 8); \
        _Pragma("unroll") for (int pp_ = 0; pp_ < DV / 64; ++pp_) vreg[pp_] = *(const GAS u32x4*)(vp_ + (size_t)(kkey + 64 * pp_) * ldv_ + ti_ * 64 + kch * 8); } while (0)
#define AT_STORE(b_) do { LAS unsigned char* kb_ = lds + (b_) * BUF; *(LAS u32x4*)(kb_ + krow * 144 + kch * 16) = kreg; \
        _Pragma("unroll") for (int pp_ = 0; pp_ < DV / 64; ++pp_) *(LAS u32x4*)(kb_ + 9216 + (kkey + 64 * pp_) * 144 + kch * 16) = vreg[pp_]; } while (0)
    AT_LOAD(0);
    LDS_BARRIER();
    AT_STORE(0);
    if (nt > 1) AT_LOAD(1);
    LDS_BARRIER();
    for (int it = 0; it < nt; ++it) {
        const LAS unsigned char* Ks = lds + (it & 1) * BUF;
        attn_tile<DV>(Ks, Ks + 9216, (it < A.ntiles) && A.masked, A.kpos0 + it * 64 + 8 * fq, qpos, c2, qf0, qf1, fr, fq, o, m, l);
        if (it + 1 < nt) { AT_STORE((it + 1) & 1); if (it + 2 < nt) AT_LOAD(it + 2); }
        LDS_BARRIER();
    }
#undef AT_LOAD
#undef AT_STORE
}
__device__ __forceinline__ void diff_attn_run(LAS unsigned char* lds, const GAS bf16_t* Qw, int nA, int nB, const GAS bf16_t* KA, int ldkA, const GAS bf16_t* VA, int ldvA, const GAS bf16_t* KB, int ldkB, const GAS bf16_t* VB, int ldvB,
        float c2, f32x4 (&o0)[8], f32x4 (&o1)[8], float& m0, float& l0, float& m1, float& l1) {
    constexpr int BUF = 36864;
    const int tid = tid_l(), lane = tid & 63, fr = lane & 15, fq = lane >> 4;
    const bf16x8 q00 = *(const GAS bf16x8*)(Qw + fq * 8), q01 = *(const GAS bf16x8*)(Qw + 32 + fq * 8), q10 = *(const GAS bf16x8*)(Qw + 64 + fq * 8), q11 = *(const GAS bf16x8*)(Qw + 96 + fq * 8);
    const int nt = nA + nB;
    const int kkey = tid >> 3, kch = tid & 7;
    const int krow = 32 * (kkey >> 5) + 16 * ((kkey >> 2) & 1) + 4 * ((kkey >> 3) & 3) + (kkey & 3);
    u32x4 k0r, k1r, vreg[2];
#define DA_LOAD(i_) do { const bool inA_ = (i_) < nA; const int ti_ = inA_ ? (i_) : (i_) - nA; const GAS bf16_t* kp_ = (inA_ ? KA : KB) + (size_t)(ti_ * 64 + kkey) * (inA_ ? ldkA : ldkB) + kch * 8; const GAS bf16_t* vp_ = inA_ ? VA : VB; const int ldv_ = inA_ ? ldvA : ldvB; \
        k0r = *(const GAS u32x4*)kp_; k1r = *(const GAS u32x4*)(kp_ + 64); \
        _Pragma("unroll") for (int pp_ = 0; pp_ < 2; ++pp_) vreg[pp_] = *(const GAS u32x4*)(vp_ + (size_t)(kkey + 64 * pp_) * ldv_ + ti_ * 64 + kch * 8); } while (0)
#define DA_STORE(b_) do { LAS unsigned char* kb_ = lds + (b_) * BUF; *(LAS u32x4*)(kb_ + krow * 144 + kch * 16) = k0r; *(LAS u32x4*)(kb_ + 9216 + krow * 144 + kch * 16) = k1r; \
        _Pragma("unroll") for (int pp_ = 0; pp_ < 2; ++pp_) *(LAS u32x4*)(kb_ + 18432 + (kkey + 64 * pp_) * 144 + kch * 16) = vreg[pp_]; } while (0)
    DA_LOAD(0);
    LDS_BARRIER();
    DA_STORE(0);
    if (nt > 1) DA_LOAD(1);
    LDS_BARRIER();
    for (int it = 0; it < nt; ++it) {
        const LAS unsigned char* Ks = lds + (it & 1) * BUF;
        attn_tile<128>(Ks, Ks + 18432, false, 0, 0, c2, q00, q01, fr, fq, o0, m0, l0);
        attn_tile<128>(Ks + 9216, Ks + 18432, false, 0, 0, c2, q10, q11, fr, fq, o1, m1, l1);
        if (it + 1 < nt) { DA_STORE((it + 1) & 1); if (it + 2 < nt) DA_LOAD(it + 2); }
        LDS_BARRIER();
    }
#undef DA_LOAD
#undef DA_STORE
}

__device__ __forceinline__ void swa_unit(const PB p, LAS unsigned char* lds, int j, int s, int hq, int qb) {
    const int tid = tid_l(), lane = tid & 63, fr = lane & 15, fq = lane >> 4, wave = tid >> 6;
    const bool lat = s >= 16; const int R0 = lat ? 4096 + (s - 16) * 1024 : s * 256; const int kvh = hq >> 2;
    const GAS bf16_t* PR = (const GAS bf16_t*)(p.ws() + WS_PROJ);
    const int q0 = qb * 128, qrow = q0 + wave * 16 + fr;
    const GAS bf16_t* Qw = PR + (size_t)(R0 + qrow) * 768 + hq * 64;
    ASeg A, B;
    const GAS bf16_t* VTo = (const GAS bf16_t*)(p.ws() + WS_VT) + (size_t)128 * R0 + (size_t)(kvh * 64) * (lat ? 1024 : 256);
    A.ldk = 768; A.ldv = lat ? 1024 : 256; B.ldk = 128; B.ldv = 512; B.kpos0 = 0; B.masked = 0;
    if (lat) { const int t0 = q0 - 128 < 0 ? 0 : q0 - 128; const int t1 = q0 + 256 > 1024 ? 1024 : q0 + 256;
        A.kpos0 = t0; A.ntiles = (t1 - t0) >> 6; A.masked = 1;
        A.K = PR + (size_t)(R0 + t0) * 768 + 512 + kvh * 64; A.V = VTo + t0;
        B.ntiles = 8; B.K = (const GAS bf16_t*)(p.ws() + WS_CKS) + ((size_t)((s - 16) * 2 + j) * 512) * 128 + kvh * 64; B.V = (const GAS bf16_t*)(p.ws() + WS_CVS) + ((size_t)((s - 16) * 2 + j) * 128 + kvh * 64) * 512; }
    else { A.kpos0 = 0; A.ntiles = 4; A.masked = 0; A.K = PR + (size_t)R0 * 768 + 512 + kvh * 64; A.V = VTo; B.ntiles = 0; B.K = A.K; B.V = A.V; }
    f32x4 o[4]; float m = -1e30f, l = 0.f;
#pragma unroll
    for (int db = 0; db < 4; ++db) o[db] = (f32x4){0.f, 0.f, 0.f, 0.f};
    attn_run<64>(lds, Qw, qrow, A, B, 0.125f * 1.4426950408889634f, o, m, l);
    l += __shfl_xor(l, 16); l += __shfl_xor(l, 32);
    const float sk = p.in(18)[j * 8 + hq] * 1.4426950408889634f;
    const float mf = fmaxf(m, sk); const float a = __builtin_amdgcn_exp2f(m - mf); const float lt = l * a + __builtin_amdgcn_exp2f(sk - mf);
    const float sc = a / lt;
    GAS bf16_t* op = (GAS bf16_t*)(p.ws() + WS_MIX) + (size_t)(R0 + qrow) * 1024 + 512 + hq * 64 + 4 * fq;
#pragma unroll
    for (int db = 0; db < 4; ++db) { const f32x4 v = o[db] * sc; u32x2 w; w.x = cvt_pk_bf16(v[0], v[1]); w.y = cvt_pk_bf16(v[2], v[3]); *(GAS u32x2*)(op + 16 * db) = w; }
}
__device__ __forceinline__ void diff_unit(const PB p, LAS unsigned char* lds, int j, int s, int h, int qb) {
    const int tid = tid_l(), lane = tid & 63, fr = lane & 15, fq = lane >> 4, wave = tid >> 6;
    const bool lat = s >= 16; const int R0 = lat ? 4096 + (s - 16) * 1024 : s * 256;
    const GAS bf16_t* PR = (const GAS bf16_t*)(p.ws() + WS_PROJ);
    const int q0 = qb * 128, qrow = q0 + wave * 16 + fr;
    const float* tab = (const float*)(p.ws() + WS_TAB);
    const float lam = tab[2048 + j], lam_init = tab[2050 + j];
    const GAS bf16_t* Qw = PR + (size_t)(R0 + qrow) * 3072 + h * 128;
    const GAS bf16_t* KA = PR + (size_t)R0 * 3072 + 1024 + h * 128;
    const GAS bf16_t* VA = (const GAS bf16_t*)(p.ws() + WS_VT) + (size_t)1024 * R0 + (size_t)(h * 128) * (lat ? 1024 : 256);
    const GAS bf16_t* KB = lat ? (const GAS bf16_t*)(p.ws() + WS_CKD) + ((size_t)((s - 16) * 2 + j) * 512) * 1024 + h * 128 : KA;
    const GAS bf16_t* VB = lat ? (const GAS bf16_t*)(p.ws() + WS_CVD) + ((size_t)((s - 16) * 2 + j) * 1024 + h * 128) * 512 : VA;
    f32x4 o0[8], o1[8]; float m0 = -1e30f, l0 = 0.f, m1 = -1e30f, l1 = 0.f;
#pragma unroll
    for (int db = 0; db < 8; ++db) { o0[db] = (f32x4){0.f, 0.f, 0.f, 0.f}; o1[db] = (f32x4){0.f, 0.f, 0.f, 0.f}; }
    diff_attn_run(lds, Qw, lat ? 16 : 4, lat ? 8 : 0, KA, 3072, VA, lat ? 1024 : 256, KB, 1024, VB, 512, 0.125f * 1.4426950408889634f, o0, o1, m0, l0, m1, l1);
    l0 += __shfl_xor(l0, 16); l0 += __shfl_xor(l0, 32); l1 += __shfl_xor(l1, 16); l1 += __shfl_xor(l1, 32);
    const float i0 = 1.f / l0, i1 = lam / l1; float ss = 0.f;
#pragma unroll
    for (int db = 0; db < 8; ++db) { const f32x4 r = o0[db] * i0 - o1[db] * i1; o0[db] = r; ss += (r[0] * r[0] + r[1] * r[1]) + (r[2] * r[2] + r[3] * r[3]); }
    ss += __shfl_xor(ss, 16); ss += __shfl_xor(ss, 32);
    const float rs = rsqrtf(ss * (1.f / 128.f) + 1e-6f) * (1.f - lam_init);
    const float* sw = p.in(24) + j * 128 + 4 * fq;
    GAS bf16_t* op = (GAS bf16_t*)(p.ws() + WS_MIX) + (size_t)(R0 + qrow) * 1024 + h * 128 + 4 * fq;
#pragma unroll
    for (int db = 0; db < 8; ++db) { const f32x4 w4 = *(const f32x4*)(sw + 16 * db); const f32x4 v = o0[db] * rs * w4; u32x2 w; w.x = cvt_pk_bf16(v[0], v[1]); w.y = cvt_pk_bf16(v[2], v[3]); *(GAS u32x2*)(op + 16 * db) = w; }
}
__device__ __forceinline__ void unit_decode(int u, int& s, int& h, int& qb) {
    if (u < 256) { s = 16 + (u >> 6); h = (u >> 3) & 7; qb = u & 7; } else { const int c = u - 256; s = c >> 4; h = (c >> 1) & 7; qb = c & 1; }
}

typedef __attribute__((address_space(1))) unsigned gu32;
#define XB_TMO      128
#define XB_XCNT(j)  (256  + 64 * (j))
#define XB_XSUB(j)  (1280 + 64 * (j))
#define XB_XGEN(j)  (2304 + 64 * (j))
#define XB_TOP      3328
#define XB_TOPGEN   3392
#define XCD_BAR_WORDS 3456
#define XB_SPIN_CAP (1u << 18)

__device__ __forceinline__ unsigned xb_ld(unsigned* p)              { return __hip_atomic_load(p, __ATOMIC_RELAXED, __HIP_MEMORY_SCOPE_AGENT); }
__device__ __forceinline__ unsigned xb_add(unsigned* p, unsigned v) { return __hip_atomic_fetch_add(p, v, __ATOMIC_RELAXED, __HIP_MEMORY_SCOPE_AGENT); }
__device__ __forceinline__ unsigned xb_xcc_id() { return (unsigned)__builtin_amdgcn_s_getreg((3 << 11) | 20) & 0xFu; }
#define XB_SPIN(cond, bar) do { unsigned _sp = 0; while (cond) { __builtin_amdgcn_s_sleep(1); \
    if ((++_sp & 255u) == 0u) { if (xb_ld(&(bar)[XB_TMO])) break; if (_sp > XB_SPIN_CAP) { atomicAdd(&(bar)[XB_TMO], 1u); break; } } } } while (0)

struct XcdBarrier {
    unsigned* bar; unsigned x;
    volatile LAS unsigned* st;
};

__device__ __forceinline__ XcdBarrier xcd_barrier_post(unsigned* bar, volatile LAS unsigned* st) {
    XcdBarrier b; b.bar = bar; b.x = xb_xcc_id(); b.st = st;
    if (threadIdx.x == 0) (void)xb_add(&bar[XB_XCNT(b.x)], 1u);
    return b;
}
__device__ __forceinline__ void xcd_barrier_complete(unsigned* bar, unsigned x, unsigned& nloc, unsigned& nx) {
    const unsigned G = gridDim.x * gridDim.y * gridDim.z;
    unsigned sum, cnt, mine, sp = 0u;
    for (;;) {
        sum = 0u; cnt = 0u; mine = 0u;
#pragma unroll
        for (unsigned j = 0; j < 16; ++j) { const unsigned c = xb_ld(&bar[XB_XCNT(j)]); sum += c; cnt += (c > 0u) ? 1u : 0u; mine = (j == x) ? c : mine; }
        if (sum == G) break;
        __builtin_amdgcn_s_sleep(1);
        if ((++sp & 255u) == 0u) { if (xb_ld(&bar[XB_TMO])) break; if (sp > XB_SPIN_CAP) { atomicAdd(&bar[XB_TMO], 1u); break; } }
    }
    nloc = mine > 0u ? mine : 1u; nx = cnt > 0u ? cnt : 1u;
}

__device__ __forceinline__ void xcd_barrier(const XcdBarrier& b) {
    asm volatile("s_waitcnt vmcnt(0)" ::: "memory");
    __syncthreads();
    if (threadIdx.x == 0) {
        unsigned* bar = b.bar;
        __builtin_amdgcn_s_waitcnt(0);
        unsigned nloc = b.st[0], nx = b.st[1];
        if (nloc == 0u) { xcd_barrier_complete(bar, b.x, nloc, nx); b.st[0] = nloc; b.st[1] = nx; }
        const unsigned old = xb_add(&bar[XB_XSUB(b.x)], 1u);
        const unsigned gen = old / nloc;
        if (old + 1u == (gen + 1u) * nloc) {
            __builtin_amdgcn_fence(__ATOMIC_RELEASE, "agent");
            asm volatile("s_waitcnt vmcnt(0)" ::: "memory");
            const unsigned og = xb_add(&bar[XB_TOP], 1u);
            const unsigned tg = og / nx;
            if (og + 1u == (tg + 1u) * nx) xb_add(&bar[XB_TOPGEN], 1u);
            else XB_SPIN(xb_ld(&bar[XB_TOPGEN]) == tg, bar);
            __builtin_amdgcn_fence(__ATOMIC_ACQUIRE, "agent");
            xb_add(&bar[XB_XGEN(b.x)], 1u);
            asm volatile("s_waitcnt vmcnt(0)" ::: "memory");
        } else {
            XB_SPIN(xb_ld(&bar[XB_XGEN(b.x)]) == gen, bar);
            __builtin_amdgcn_fence(__ATOMIC_ACQUIRE, "agent");
            asm volatile("s_waitcnt vmcnt(0)" ::: "memory");
        }
    }
    __syncthreads();
}

__global__ void __launch_bounds__(512, 2) hybrid_fwd(Params ka) {
    extern __shared__ __attribute__((aligned(16))) unsigned char lds_raw[];
    LAS unsigned char* lds = (LAS unsigned char*)lds_raw;
    cg::grid_group grid = cg::this_grid();
    if (threadIdx.x == 0) {
#pragma unroll
        for (int i = 0; i < 27; ++i) *(LAS unsigned long long*)(lds + PB_OFF + 8 * i) = (unsigned long long)ka.in[i];
        *(LAS unsigned long long*)(lds + PB_OFF + 8 * 27) = (unsigned long long)ka.out; *(LAS unsigned long long*)(lds + PB_OFF + 8 * 28) = (unsigned long long)ka.ws; }
    if (threadIdx.x == 1) { *(LAS unsigned*)(lds + PB_OFF + 256) = 0u; *(LAS unsigned*)(lds + PB_OFF + 260) = 0u; }
    __syncthreads();
    const PB p{lds};
    const XcdBarrier xbar = xcd_barrier_post((unsigned*)(ka.ws + WS_BAR), (volatile LAS unsigned*)(lds + PB_OFF + 256));
    const int ph_hi = ka.ph_hi;
    int rep = 0;
    for (int ph = ka.ph_lo; ph < ph_hi; ) {
        const int G = gridDim.x, bid = blockIdx.x;
        unsigned char* ws = p.ws();
        if (ph == 0) {
#ifndef SK_P0
            phase0(p, lds);
#endif
        }
        else if (ph == 33) { norm_phase(p, 2, 3, 1, (3 * 5) * 6144 + 5 * 1024); }
        else {
            const int li = (ph - 1) >> 3, sub = (ph - 1) & 7, j = li >> 1, odd = li & 1;
            if (sub == 3 && odd) { ++ph; continue; }
            if (sub == 0) { norm_phase(p, li == 0 ? 0 : 1, li, 0, ((li - 1) * 5) * 6144 + 5 * 1024); }
            else if (sub == 5) { norm_phase(p, 1, li, 1, (li * 5) * 6144 + 2 * 1024); }
            else if (sub == 1) {
                pg8::Gemm g{(const bf16_t*)(ws + WS_XN), odd ? (const bf16_t*)(ws + WS_WINO) + (size_t)j * NOD * DM : (const bf16_t*)(ws + WS_WINE) + (size_t)j * NEV * DM, NTOK, odd ? NOD : NEV, DM, DM, 1};
                pg8::StaticOrder S; S.init(NTOK, g.N, G, bid);
                pg8::EpiIn E; E.odd = odd; E.j = j; E.pb = (const LAS unsigned*)(lds + PB_OFF);

#ifndef SK_IN
                pg8::gemm_phase<pg8::EpiIn, pg8::StaticOrder, true, true>(lds, g, S, E);
#endif

            }
            else if (sub == 2) {
#ifndef SK_MIX
                const int vb = (G % 8 == 0) ? (bid & 7) * (G >> 3) + (bid >> 3) : bid;
                if (!odd) {
                    { const bool fast = (G == 256); const int k = vb - 64;
                        const int nh = fast ? (vb >= 192 ? 2 : 1) : (vb < 320 ? (320 - vb + G - 1) / G : 0);
                        for (int q = 0; q < nh; ++q) { int it;
                            if (fast) it = vb < 64 ? 256 + vb : (q == 0 ? k : 192 + (k - 128)); else { const int r = vb + q * G; it = r < 64 ? 256 + r : r - 64; }
#ifdef PROBE_HG2
                            hgrn_chunked_dispatch(p, lds, j, it);
#endif
                            hgrn_chunked_dispatch(p, lds, j, it); }
                        const int nu = fast ? (vb < 64 ? 0 : (k < 64 ? 2 : (k < 128 ? 4 : 2))) : (vb < 512 ? (512 - vb + G - 1) / G : 0);
#ifdef PROBE_SWA2
                        for (int rp_ = 0; rp_ < 2; ++rp_)
#endif
                        for (int q = 0; q < nu; ++q) { int u;
                            if (!fast) u = vb + q * G;
                            else if (k < 64) u = q == 0 ? k : 64 + k;
                            else if (k < 128) u = q == 0 ? 128 + (k - 64) : 256 + (k - 64) * 3 + (q - 1);
                            else u = q == 0 ? 192 + (k - 128) : 256 + 192 + (k - 128);
                            int s, h, qb; unit_decode(u, s, h, qb); swa_unit(p, lds, j, s, h, qb); } }
                } else {
                    for (int u = vb; u < 512; u += G) { int s, h, qb; unit_decode(u, s, h, qb); diff_unit(p, lds, j, s, h, qb); }
                }
#endif
            }
            else if (sub == 3) { hgrn_readout(p, j); }
            else if (sub == 4 || sub == 7) {
                const bool mlp = sub == 7;
                pg8::Gemm g{mlp ? (const bf16_t*)(ws + WS_H) : (const bf16_t*)(ws + WS_MIX),
                            mlp ? (const bf16_t*)(ws + WS_W2) + (size_t)li * DM * FF : (odd ? (const bf16_t*)(ws + WS_WOUTO) : (const bf16_t*)(ws + WS_WOUTE)) + (size_t)j * DM * DM, NTOK, DM, mlp ? FF / 2 : DM / 2, mlp ? FF : DM, 2};
                pg8::StaticOrder S; S.init(NTOK, DM, G, bid, 2);
                pg8::EpiPart E{(bf16_t*)(ws + WS_P0), (bf16_t*)(ws + WS_P1)};

#ifndef SK_RES
                pg8::gemm_phase<pg8::EpiPart, pg8::StaticOrder, true, true>(lds, g, S, E);
#endif

            }
            else {
                pg8::Gemm g{(const bf16_t*)(ws + WS_XN), (const bf16_t*)(ws + WS_W1) + (size_t)li * FF * DM, NTOK, FF, DM, DM, 1};
                pg8::StaticOrder S; S.init(NTOK, FF, G, bid);
                pg8::EpiRelu2 E{(bf16_t*)(ws + WS_H), FF};

#ifndef SK_MLP1
                pg8::gemm_phase<pg8::EpiRelu2, pg8::StaticOrder, true, true>(lds, g, S, E);
#endif

            }
        }
        { const bool again = DUP_MASK != 0 && rep == 0 && ph > 0 && ((DUP_MASK >> (((ph - 1) & 7) + 8 * (((ph - 1) >> 3) & 1))) & 1); rep = again ? 1 : 0; if (!again) ++ph; }
        if (ph < ph_hi) { if (ph_hi > 1000) grid.sync(); else xcd_barrier(xbar); }
    }
}

#ifndef DUP_MASK
#define DUP_MASK 0
#endif
#ifndef MK_PER_PHASE
#define MK_PER_PHASE 0
#endif
extern "C" void kernel_launch(void* const* d_in, const int* in_sizes, int n_in, void* d_out, int out_size, void* d_ws, size_t ws_size, hipStream_t stream) {
    static int grid = 0;
    if (grid == 0) {
        if (n_in != 27 || ws_size < WS_END) { fprintf(stderr, "kernel_launch: unexpected n_in %d / ws_size %zu\n", n_in, ws_size); grid = -1; return; }
        int dev = 0, cus = 0, per_cu = 0;
        hipGetDevice(&dev); hipDeviceGetAttribute(&cus, hipDeviceAttributeMultiprocessorCount, dev);
        if (hipFuncSetAttribute((const void*)hybrid_fwd, hipFuncAttributeMaxDynamicSharedMemorySize, LDS_BYTES) != hipSuccess) { fprintf(stderr, "kernel_launch: hipFuncSetAttribute failed\n"); grid = -1; return; }
        if (hipOccupancyMaxActiveBlocksPerMultiprocessor(&per_cu, (const void*)hybrid_fwd, 512, LDS_BYTES) != hipSuccess || per_cu < 1) { fprintf(stderr, "kernel_launch: occupancy query says %d blocks per CU\n", per_cu); grid = -1; (void)hipGetLastError(); return; }
        grid = cus;
    }
    if (grid < 0) return;
    hipMemsetAsync((char*)d_ws + WS_BAR, 0, 16 * 1024, stream);
    Params p{};
    for (int i = 0; i < 27; ++i) p.in[i] = (const float*)d_in[i];
    p.out = (float*)d_out; p.ws = (unsigned char*)d_ws;
#if MK_PER_PHASE
    for (int ph = 0; ph < 34; ++ph) { p.ph_lo = ph; p.ph_hi = ph + 1; hipLaunchKernelGGL(hybrid_fwd, dim3(grid), dim3(512), LDS_BYTES, stream, p); }
#else
    p.ph_lo = 0; p.ph_hi = 34;
    void* args[] = {&p};
    hipError_t e = hipLaunchCooperativeKernel((const void*)hybrid_fwd, dim3(grid), dim3(512), args, LDS_BYTES, stream);
    if (e != hipSuccess) fprintf(stderr, "cooperative launch failed: %s (grid %d)\n", hipGetErrorString(e), grid);
#endif
}
```

```cpp
#include <hip/hip_runtime.h>
#include <hip/hip_cooperative_groups.h>
#include <cstdio>
#include <cstdint>
namespace cg = cooperative_groups;
#ifndef DUP_MASK
#define DUP_MASK 0
#endif
#define GAS __attribute__((address_space(1)))
#define LDS_BARRIER() do { asm volatile("s_waitcnt lgkmcnt(0)" ::: "memory"); __builtin_amdgcn_s_barrier(); asm volatile("" ::: "memory"); } while (0)
__device__ __forceinline__ int tid_l() { int t = threadIdx.x; asm volatile("" : "+v"(t)); return t; }
namespace pg8 {
#define PG8_LAS __attribute__((address_space(3)))
typedef unsigned short bf16_t;
typedef short bf16x8 __attribute__((ext_vector_type(8)));
typedef float f32x4 __attribute__((ext_vector_type(4)));
typedef unsigned u32x4 __attribute__((ext_vector_type(4)));
constexpr int BM = 256, BK = 64, HALF = 128, HTB = HALF * BK * 2  , STAGE_BYTES = 8 * HTB, NXCD = 8, WGM = 8;

__host__ __device__ __forceinline__ int lds_byte(int r, int c) { const int st = (r >> 4) * 2 + (c >> 5), rr = r & 15, cc = c & 31, ob = rr * 64 + cc * 2; return st * 1024 + (ob ^ (((ob >> 9) & 1) << 5)); }
__host__ __device__ __forceinline__ void stage_rc(int b, int& R, int& C) { const int st = b / 1024, sb = b % 1024, swz = sb ^ (((sb >> 9) & 1) << 5); R = (st >> 1) * 16 + swz / 64; C = (st & 1) * 32 + (swz % 64) / 2; }
__host__ __device__ __forceinline__ int perm32(int rho) { const int n = rho >> 4, i = rho & 15; return 8 * (i >> 2) + 4 * n + (i & 3); }

struct Unit { int pm, pn, ks; };
struct Gemm { const bf16_t* A; const bf16_t* Bt; int M, N, K, ld, KS; };

struct StaticOrder {
    int nM, nN, nwg, G, c, nNr;
    __host__ __device__ void init(int M, int N, int G_, int c_, int KS = 1) { nM = M / BM; nNr = N / BM; nN = nNr * KS; nwg = nM * nN; G = G_; c = c_; }
    __host__ __device__ bool next(int i, Unit& u) const {
        const long L = (long)i * G + c; if (L >= nwg) return false;
        int wgid = (int)L; { const int q = nwg / NXCD, r = nwg % NXCD, xcd = wgid % NXCD, off = wgid / NXCD; wgid = (xcd < r ? xcd * (q + 1) : r * (q + 1) + (xcd - r) * q) + off; }
        const int nig = WGM * nN, gid = wgid / nig, fm = gid * WGM, gsz = (nM - fm) < WGM ? (nM - fm) : WGM;
        u.pm = fm + ((wgid % nig) % gsz); { const int pq = (wgid % nig) / gsz; u.pn = pq % nNr; u.ks = pq / nNr; } return true;
    }
    __device__ __forceinline__ void a_ready(const Unit&) const {}
    __device__ __forceinline__ void done(const Unit&) const {}
};

__device__ __forceinline__ unsigned cvt_pk_bf16(float lo, float hi) { unsigned r; asm volatile("v_cvt_pk_bf16_f32 %0, %1, %2" : "=v"(r) : "v"(lo), "v"(hi)); return r; }
typedef float f32x2 __attribute__((ext_vector_type(2)));
typedef unsigned u32x2 __attribute__((ext_vector_type(2)));

#define LDSP __attribute__((address_space(3)))
__device__ __forceinline__ unsigned long long ldq(const unsigned LDSP* pb, int i) { const unsigned lo = __builtin_amdgcn_readfirstlane(pb[2 * i]), hi = __builtin_amdgcn_readfirstlane(pb[2 * i + 1]); return ((unsigned long long)hi << 32) | lo; }
__device__ __forceinline__ float dpp_x1(float x) { return __builtin_bit_cast(float, __builtin_amdgcn_update_dpp(0, __builtin_bit_cast(int, x), 0xB1, 0xf, 0xf, true)); }
__device__ __forceinline__ float dpp_x2(float x) { return __builtin_bit_cast(float, __builtin_amdgcn_update_dpp(0, __builtin_bit_cast(int, x), 0x4E, 0xf, 0xf, true)); }
__device__ __forceinline__ void quad_transpose(float& v0, float& v1, float& v2, float& v3, int a) {
    { const bool hi = a & 1; const float r0 = dpp_x1(hi ? v0 : v1), r1 = dpp_x1(hi ? v2 : v3); if (hi) { v0 = r0; v2 = r1; } else { v1 = r0; v3 = r1; } }
    { const bool hi = a & 2; const float r0 = dpp_x2(hi ? v0 : v2), r1 = dpp_x2(hi ? v1 : v3); if (hi) { v0 = r0; v1 = r1; } else { v2 = r0; v3 = r1; } }
}
struct EpiRelu2 {
    static constexpr bool PERM = true, AFTER_DRAIN = false;
    bf16_t* O; int ldc;
    __device__ __forceinline__ void operator()(const f32x4 (&acc)[2][2][4][2], const Unit& u, int wr, int wc, int fr, int fq) const {
        const int row0 = u.pm * BM + wr * 64 + fr; const int col0 = u.pn * BM + wc * 32 + 8 * fq;
#pragma unroll
        for (int ai = 0; ai < 2; ++ai)
#pragma unroll
            for (int m = 0; m < 4; ++m) { bf16_t* rowp = O + (size_t)(row0 + ai * HALF + m * 16) * ldc + col0;
#pragma unroll
                for (int bj = 0; bj < 2; ++bj) { f32x4 v0 = acc[ai][bj][m][0], v1 = acc[ai][bj][m][1];
#pragma unroll
                    for (int i = 0; i < 4; ++i) { float a = fmaxf(v0[i], 0.f), b = fmaxf(v1[i], 0.f); v0[i] = a * a; v1[i] = b * b; }
                    u32x4 w; w.x = cvt_pk_bf16(v0[0], v0[1]); w.y = cvt_pk_bf16(v0[2], v0[3]); w.z = cvt_pk_bf16(v1[0], v1[1]); w.w = cvt_pk_bf16(v1[2], v1[3]);
                    *(u32x4*)(rowp + bj * HALF) = w; } }
    }
};
struct EpiPart {
    static constexpr bool PERM = true, AFTER_DRAIN = false;
    bf16_t* P0; bf16_t* P1;
    __device__ __forceinline__ void operator()(const f32x4 (&acc)[2][2][4][2], const Unit& u, int wr, int wc, int fr, int fq) const {
        bf16_t* P = u.ks ? P1 : P0;
        const int col0 = u.pn * BM + wc * 32 + 8 * fq;
#pragma unroll
        for (int ai = 0; ai < 2; ++ai)
#pragma unroll
            for (int m = 0; m < 4; ++m) { bf16_t* rowp = P + (size_t)(u.pm * BM + ai * HALF + wr * 64 + m * 16 + fr) * 1024 + col0;
#pragma unroll
                for (int bj = 0; bj < 2; ++bj) { const f32x4 v0 = acc[ai][bj][m][0], v1 = acc[ai][bj][m][1];
                    u32x4 w; w.x = cvt_pk_bf16(v0[0], v0[1]); w.y = cvt_pk_bf16(v0[2], v0[3]); w.z = cvt_pk_bf16(v1[0], v1[1]); w.w = cvt_pk_bf16(v1[2], v1[3]);
                    *(u32x4*)(rowp + bj * HALF) = w; } }
    }
};
struct EpiIn {
    static constexpr bool PERM = false, AFTER_DRAIN = false;
    int odd, j; const unsigned LDSP* pb;
    __device__ __forceinline__ void operator()(const f32x4 (&acc)[2][2][4][2], const Unit& u, int wr, int wc, int fr, int fq) const {
        unsigned char* ws = (unsigned char*)ldq(pb, 28); float* outp = (float*)ldq(pb, 27);
        bf16_t* proj = (bf16_t*)(ws + 150u * 1048576u); const int ldp = odd ? 3072 : 768; float* hg = (float*)(ws + 198u * 1048576u);
        const float* lbs = (const float*)(ws + 524288) + j * 1024; const float* rope = (const float*)(ws + 524288) + 4096;
        const float* qnw = (const float*)ldq(pb, odd ? 21 : 16) + j * 64; const float* knw = (const float*)ldq(pb, odd ? 22 : 17) + j * 64;
        float* outk = outp + (odd ? 14680064 : 8388608); float* outv = outp + (odd ? 23068672 : 9437184);
        const int unit = u.pn * 4 + wc;
        int type;
        if (!odd) type = unit < 8 ? 0 : unit < 24 ? 1 : unit < 40 ? 2 : unit < 48 ? 3 : unit < 50 ? 4 : 5;
        else type = unit < 16 ? 3 : unit < 32 ? 4 : 5;
        const int pu = odd ? unit : unit - 40;
        const bool lat = u.pm >= 16;
        f32x4 w4[2][2];
        if (type == 3 || type == 4) { const float* nw = (type == 3) ? qnw : knw;
#pragma unroll
            for (int bj = 0; bj < 2; ++bj)
#pragma unroll
                for (int n = 0; n < 2; ++n) w4[bj][n] = *(const f32x4*)(nw + 32 * bj + 16 * n + 4 * fq); }
        else if (type == 1) { const float* lb = lbs + ((unit - 8) >> 3) * 512 + ((unit - 8) & 7) * 64;
#pragma unroll
            for (int bj = 0; bj < 2; ++bj)
#pragma unroll
                for (int n = 0; n < 2; ++n) w4[bj][n] = *(const f32x4*)(lb + 32 * bj + 16 * n + 4 * fq); }
        else {
#pragma unroll
            for (int bj = 0; bj < 2; ++bj)
#pragma unroll
                for (int n = 0; n < 2; ++n) w4[bj][n] = (f32x4){0.f, 0.f, 0.f, 0.f}; }
#pragma unroll
        for (int ai = 0; ai < 2; ++ai)
#pragma unroll
            for (int m = 0; m < 4; ++m) {
                const int row = u.pm * BM + ai * HALF + wr * 64 + m * 16 + fr;
                f32x4 v[2][2];
#pragma unroll
                for (int bj = 0; bj < 2; ++bj)
#pragma unroll
                    for (int n = 0; n < 2; ++n) v[bj][n] = acc[ai][bj][m][n];
                if (type <= 2) {
                    float* hp = hg + (size_t)row * 2560 + unit * 64 + 4 * fq;
#pragma unroll
                    for (int bj = 0; bj < 2; ++bj)
#pragma unroll
                        for (int n = 0; n < 2; ++n) { f32x4 xv = v[bj][n];
                            if (type == 0) {
#pragma unroll
                                for (int i = 0; i < 4; ++i) xv[i] = xv[i] * __builtin_amdgcn_rcpf(1.f + __expf(-xv[i])) * 0.08838834764831845f; }
                            else if (type == 1) {
#pragma unroll
                                for (int i = 0; i < 4; ++i) { const float sg = __builtin_amdgcn_rcpf(1.f + __expf(-xv[i])); const float lb = w4[bj][n][i]; xv[i] = lb + (1.f - lb) * sg; } }
                            *(f32x4*)(hp + 32 * bj + 16 * n) = xv; }
                } else {
                    if (type != 5) {
                        float ss = 0.f;
#pragma unroll
                        for (int bj = 0; bj < 2; ++bj)
#pragma unroll
                            for (int n = 0; n < 2; ++n) { const f32x4 xv = v[bj][n]; ss += (xv[0] * xv[0] + xv[1] * xv[1]) + (xv[2] * xv[2] + xv[3] * xv[3]); }
                        ss += __shfl_xor(ss, 16); ss += __shfl_xor(ss, 32);
                        const float rs = rsqrtf(ss * (1.f / 64.f) + 1e-6f);
#pragma unroll
                        for (int bj = 0; bj < 2; ++bj)
#pragma unroll
                            for (int n = 0; n < 2; ++n) v[bj][n] = v[bj][n] * rs * w4[bj][n];
                    }
                    if (!lat && type >= 4) {
                        float* ob = (type == 4) ? outk : outv;
                        const int b = row >> 8, t = row & 255;
                        size_t off;
                        if (!odd) off = ((size_t)(b * 2 + j) * 256 + t) * 128 + (size_t)(unit - (type == 4 ? 48 : 50)) * 64;
                        else off = ((size_t)(b * 2 + j) * 256 + t) * 1024 + (size_t)(unit - (type == 4 ? 16 : 32)) * 64;
#pragma unroll
                        for (int bj = 0; bj < 2; ++bj)
#pragma unroll
                            for (int n = 0; n < 2; ++n) *(f32x4*)(ob + off + 32 * bj + 16 * n + 4 * fq) = v[bj][n];
                    }
                    if (lat && type != 5) {
                        const int t = (row - 4096) & 1023; const int rp = t >> 6, cp = t & 63;
#pragma unroll
                        for (int bj = 0; bj < 2; ++bj)
#pragma unroll
                            for (int n = 0; n < 2; ++n) { const f32x4 cs = *(const f32x4*)(rope + ((bj ? cp : rp) * 16 + 8 * n + 2 * fq) * 2);
                                const f32x4 xv = v[bj][n]; f32x4 o;
                                o[0] = xv[0] * cs[0] - xv[1] * cs[1]; o[1] = xv[0] * cs[1] + xv[1] * cs[0];
                                o[2] = xv[2] * cs[2] - xv[3] * cs[3]; o[3] = xv[2] * cs[3] + xv[3] * cs[2]; v[bj][n] = o; }
                    }
                    if (type == 5) {
                        const int t = lat ? ((row - 4096) & 1023) : (row & 255); const int L = lat ? 1024 : 256; const int C = odd ? 1024 : 128;
                        const int a = fr & 3;
                        unsigned short* vp = (unsigned short*)(ws + 310u * 1048576u) + (size_t)C * (row - t) + (size_t)((unit - (odd ? 32 : 50)) * 64 + 4 * fq + a) * L + (t - a);
#pragma unroll
                        for (int bj = 0; bj < 2; ++bj)
#pragma unroll
                            for (int n = 0; n < 2; ++n) { float x0 = v[bj][n][0], x1 = v[bj][n][1], x2 = v[bj][n][2], x3 = v[bj][n][3];
                                quad_transpose(x0, x1, x2, x3, a);
                                u32x2 w; w.x = cvt_pk_bf16(x0, x1); w.y = cvt_pk_bf16(x2, x3);
                                *(u32x2*)(vp + (size_t)(32 * bj + 16 * n) * L) = w; }
                    } else {
                    bf16_t* pp = proj + (size_t)row * ldp + pu * 64 + 4 * fq;
#pragma unroll
                    for (int bj = 0; bj < 2; ++bj)
#pragma unroll
                        for (int n = 0; n < 2; ++n) { u32x2 w; w.x = cvt_pk_bf16(v[bj][n][0], v[bj][n][1]); w.y = cvt_pk_bf16(v[bj][n][2], v[bj][n][3]); *(u32x2*)(pp + 32 * bj + 16 * n) = w; }
                    }
                }
            }
    }
};

template <class Epi, class Sched, bool ALIGN_EPI = false, bool SP2 = false>
__device__ __forceinline__ void gemm_phase(PG8_LAS unsigned char* lds, const Gemm g, const Sched& S, const Epi& E) {
    const int tid = tid_l(), wid = __builtin_amdgcn_readfirstlane(tid >> 6), lane = tid & 63, wr = wid >> 2, wc = wid & 3, fr = lane & 15, fq = lane >> 4;
    const int K = g.ld, nt = g.K / BK;
    unsigned voffA[2], voffB[2];
#pragma unroll
    for (int i = 0; i < 2; ++i) { int R, C; stage_rc(tid * 16 + i * 8192, R, C); const int Rb = Epi::PERM ? ((R & ~31) + perm32(R & 31)) : R;
        voffA[i] = (unsigned)(R * K + C) * 2u; voffB[i] = (unsigned)(Rb * K + C) * 2u; }
    const size_t kstep = (size_t)(BK * 2);
    const size_t hstep = (size_t)HALF * K * 2;
    const size_t tstep = 2 * hstep;
    const unsigned ldsw = (unsigned)wid * 1024u;
    const int aoff = lds_byte(wr * 64 + fr, fq * 8), boff = lds_byte(wc * 32 + fr, fq * 8);
#define PG8_SA(b, h) (((b) * 2 + (h)) * HTB)
#define PG8_SB(b, h) ((4 + (b) * 2 + (h)) * HTB)
#define PG8_STAGE(bufoff, gbase, voff) do { _Pragma("unroll") for (int _i = 0; _i < 2; ++_i) \
        __builtin_amdgcn_global_load_lds((const unsigned*)((const char*)(gbase) + (voff)[_i]), (PG8_LAS unsigned*)(lds + (bufoff) + ldsw + _i * 8192), 16, 0, 0); } while (0)
#define PG8_LDA(dst, b, h) do { _Pragma("unroll") for (int m = 0; m < 4; ++m) _Pragma("unroll") for (int k = 0; k < 2; ++k) dst[m][k] = *(const PG8_LAS bf16x8*)(lds + PG8_SA(b, h) + aoff + m * 2048 + k * 1024); } while (0)
#define PG8_LDB(dst, b, h) do { _Pragma("unroll") for (int n = 0; n < 2; ++n) _Pragma("unroll") for (int k = 0; k < 2; ++k) dst[n][k] = *(const PG8_LAS bf16x8*)(lds + PG8_SB(b, h) + boff + n * 2048 + k * 1024); } while (0)
#define PG8_MMA(ai, bj, At, Bt) do { __builtin_amdgcn_s_setprio(1); _Pragma("unroll") for (int m = 0; m < 4; ++m) _Pragma("unroll") for (int n = 0; n < 2; ++n) _Pragma("unroll") for (int k = 0; k < 2; ++k) \
        acc[ai][bj][m][n] = __builtin_amdgcn_mfma_f32_16x16x32_bf16(Bt[n][k], At[m][k], acc[ai][bj][m][n], 0, 0, 0); __builtin_amdgcn_s_setprio(0); } while (0)
#define PG8_WAIT_V(n) asm volatile("s_waitcnt vmcnt(" #n ")" ::: "memory")
#define PG8_WAIT_L(n) asm volatile("s_waitcnt lgkmcnt(" #n ")" ::: "memory")
#define PG8_BAR __builtin_amdgcn_s_barrier()
#define PG8_SCHED __builtin_amdgcn_sched_barrier(0)
    Unit cur, nxt; int ui = 0;
    if (!S.next(0, cur)) return;
    f32x4 acc[2][2][4][2];
#pragma unroll
    for (int a = 0; a < 2; ++a)
#pragma unroll
        for (int b = 0; b < 2; ++b)
#pragma unroll
            for (int m = 0; m < 4; ++m)
#pragma unroll
                for (int n = 0; n < 2; ++n) acc[a][b][m][n] = (f32x4){0.f, 0.f, 0.f, 0.f};
    bf16x8 At[4][2], B0[2][2], B1[2][2];
    const char* cA = (const char*)g.A + (size_t)cur.pm * tstep + (size_t)cur.ks * g.K * 2; const char* cB = (const char*)g.Bt + (size_t)cur.pn * tstep + (size_t)cur.ks * g.K * 2;
    S.a_ready(cur);
    if constexpr (SP2) {
        PG8_STAGE(PG8_SB(0, 0), cB, voffB); PG8_STAGE(PG8_SB(0, 1), cB + hstep, voffB); PG8_STAGE(PG8_SA(0, 0), cA, voffA); PG8_STAGE(PG8_SA(0, 1), cA + hstep, voffA);
        if (wr == 1) PG8_BAR;
        PG8_WAIT_V(2); PG8_BAR;
        PG8_STAGE(PG8_SB(1, 0), cB + kstep, voffB); PG8_STAGE(PG8_SA(1, 0), cA + kstep, voffA); PG8_STAGE(PG8_SB(1, 1), cB + hstep + kstep, voffB);
        PG8_WAIT_V(6); PG8_BAR;
    } else {
        PG8_STAGE(PG8_SB(0, 0), cB, voffB); PG8_STAGE(PG8_SA(0, 0), cA, voffA); PG8_STAGE(PG8_SB(0, 1), cB + hstep, voffB); PG8_STAGE(PG8_SA(0, 1), cA + hstep, voffA);
        if (wr == 1) PG8_BAR;
        PG8_WAIT_V(4); PG8_BAR;
        PG8_STAGE(PG8_SB(1, 0), cB + kstep, voffB); PG8_STAGE(PG8_SA(1, 0), cA + kstep, voffA); PG8_STAGE(PG8_SB(1, 1), cB + hstep + kstep, voffB);
        PG8_WAIT_V(6); PG8_BAR;
    }
    for (;;) {
        const bool has_next = S.next(ui + 1, nxt);
        const char* nA = has_next ? (const char*)g.A + (size_t)nxt.pm * tstep + (size_t)nxt.ks * g.K * 2 : cA; const char* nB = has_next ? (const char*)g.Bt + (size_t)nxt.pn * tstep + (size_t)nxt.ks * g.K * 2 : cB;
        for (int t = 0; t < nt; t += 2) {
            const bool last = (t == nt - 2);
            const char* a1 = cA + (size_t)(t + 1) * kstep;
            const char* a2 = last ? nA : cA + (size_t)(t + 2) * kstep; const char* b2 = last ? nB : cB + (size_t)(t + 2) * kstep;
            const char* a3 = a2 + kstep; const char* b3 = b2 + kstep;
            if (last && has_next) S.a_ready(nxt);
            if constexpr (SP2) {
            PG8_LDB(B0, 0, 0); PG8_LDB(B1, 0, 1); PG8_SCHED; PG8_LDA(At, 0, 0); PG8_STAGE(PG8_SA(1, 1), a1 + hstep, voffA);
            PG8_WAIT_V(8); PG8_WAIT_L(0); PG8_BAR; PG8_MMA(0, 0, At, B0); PG8_MMA(0, 1, At, B1); PG8_BAR; PG8_SCHED;
            PG8_LDA(At, 0, 1); PG8_STAGE(PG8_SB(0, 0), b2, voffB); PG8_STAGE(PG8_SB(0, 1), b2 + hstep, voffB); PG8_STAGE(PG8_SA(0, 0), a2, voffA);
            PG8_WAIT_V(8); PG8_WAIT_L(0); PG8_BAR; PG8_MMA(1, 0, At, B0); PG8_MMA(1, 1, At, B1); PG8_BAR; PG8_SCHED;
            PG8_LDB(B0, 1, 0); PG8_LDB(B1, 1, 1); PG8_SCHED; PG8_LDA(At, 1, 0); PG8_STAGE(PG8_SA(0, 1), a2 + hstep, voffA);
            PG8_WAIT_V(8); PG8_WAIT_L(0); PG8_BAR; PG8_MMA(0, 0, At, B0); PG8_MMA(0, 1, At, B1); PG8_BAR; PG8_SCHED;
            PG8_LDA(At, 1, 1); PG8_STAGE(PG8_SB(1, 0), b3, voffB); PG8_STAGE(PG8_SB(1, 1), b3 + hstep, voffB); PG8_STAGE(PG8_SA(1, 0), a3, voffA);
            PG8_WAIT_V(8); PG8_WAIT_L(0); PG8_BAR; PG8_MMA(1, 0, At, B0); PG8_MMA(1, 1, At, B1); PG8_BAR; PG8_SCHED;
            } else {
            PG8_LDB(B0, 0, 0); PG8_SCHED; PG8_LDA(At, 0, 0); PG8_STAGE(PG8_SA(1, 1), a1 + hstep, voffA);
            PG8_WAIT_L(8); PG8_BAR; PG8_WAIT_L(0); PG8_MMA(0, 0, At, B0); PG8_BAR; PG8_SCHED;
            PG8_LDB(B1, 0, 1); PG8_STAGE(PG8_SB(0, 0), b2, voffB);
            PG8_BAR; PG8_WAIT_L(0); PG8_MMA(0, 1, At, B1); PG8_BAR;
            PG8_LDA(At, 0, 1); PG8_STAGE(PG8_SA(0, 0), a2, voffA);
            PG8_BAR; PG8_WAIT_L(0); PG8_MMA(1, 0, At, B0); PG8_BAR; PG8_SCHED;
            PG8_STAGE(PG8_SB(0, 1), b2 + hstep, voffB);
            PG8_WAIT_V(6); PG8_BAR; PG8_MMA(1, 1, At, B1); PG8_BAR;
            PG8_LDB(B0, 1, 0); PG8_SCHED; PG8_LDA(At, 1, 0); PG8_STAGE(PG8_SA(0, 1), a2 + hstep, voffA);
            PG8_WAIT_L(8); PG8_BAR; PG8_WAIT_L(0); PG8_MMA(0, 0, At, B0); PG8_BAR; PG8_SCHED;
            PG8_LDB(B1, 1, 1); PG8_STAGE(PG8_SB(1, 0), b3, voffB);
            PG8_BAR; PG8_WAIT_L(0); PG8_MMA(0, 1, At, B1); PG8_BAR;
            PG8_LDA(At, 1, 1); PG8_STAGE(PG8_SA(1, 0), a3, voffA);
            PG8_BAR; PG8_WAIT_L(0); PG8_MMA(1, 0, At, B0); PG8_BAR; PG8_SCHED;
            PG8_STAGE(PG8_SB(1, 1), b3 + hstep, voffB);
            PG8_WAIT_V(6); PG8_BAR; PG8_MMA(1, 1, At, B1); PG8_BAR;
            }
        }
        if constexpr (ALIGN_EPI) { if (wr == 0) PG8_BAR; }
        if constexpr (!Epi::AFTER_DRAIN) { E(acc, cur, wr, wc, fr, fq); S.done(cur); }
        if (!has_next) break;
#pragma unroll
        for (int a = 0; a < 2; ++a)
#pragma unroll
            for (int b = 0; b < 2; ++b)
#pragma unroll
                for (int m = 0; m < 4; ++m)
#pragma unroll
                    for (int n = 0; n < 2; ++n) acc[a][b][m][n] = (f32x4){0.f, 0.f, 0.f, 0.f};
        cur = nxt; cA = nA; cB = nB; ++ui;
        if constexpr (ALIGN_EPI) { if (wr == 1) PG8_BAR; }
    }
    PG8_WAIT_V(0);
    if constexpr (!ALIGN_EPI) { if (wr == 0) PG8_BAR; }
    PG8_BAR;
    if constexpr (Epi::AFTER_DRAIN) { E.fused(acc, cur, wr, wc, fr, fq, lds, wid, lane); S.done(cur); }
#undef PG8_SA
#undef PG8_SB
#undef PG8_STAGE
#undef PG8_LDA
#undef PG8_LDB
#undef PG8_MMA
#undef PG8_WAIT_V
#undef PG8_WAIT_L
#undef PG8_BAR
#undef PG8_SCHED
}
}
#define LAS __attribute__((address_space(3)))
typedef unsigned short bf16_t;
typedef short bf16x8 __attribute__((ext_vector_type(8)));
typedef float f32x4 __attribute__((ext_vector_type(4)));
typedef float f32x2 __attribute__((ext_vector_type(2)));
typedef unsigned u32x4 __attribute__((ext_vector_type(4)));
typedef unsigned u32x2 __attribute__((ext_vector_type(2)));
using pg8::cvt_pk_bf16;

constexpr int NTOK = 8192, DM = 1024, NEV = 3328, NOD = 3072, FF = 4096;
constexpr int LDS_BYTES = 147456;
constexpr size_t MiB = 1u << 20;
constexpr size_t WS_MODS = 0;
constexpr size_t WS_BAR = 492 * 1024;
constexpr size_t WS_TAB = 512 * 1024;
constexpr size_t WS_WINE = 2 * MiB, WS_WOUTE = 16 * MiB, WS_WINO = 20 * MiB, WS_WOUTO = 32 * MiB, WS_W1 = 36 * MiB, WS_W2 = 68 * MiB;
constexpr size_t WS_XN = 100 * MiB, WS_MIX = 116 * MiB;
constexpr size_t WS_CKS = 132 * MiB, WS_CVS = 133 * MiB, WS_CKD = 134 * MiB, WS_CVD = 142 * MiB;
constexpr size_t WS_P0 = 150 * MiB, WS_P1 = 278 * MiB;
constexpr size_t WS_PROJ = 150 * MiB, WS_HG = 198 * MiB, WS_OF = 278 * MiB, WS_OB = 294 * MiB, WS_H = 198 * MiB, WS_VT = 310 * MiB, WS_END = 326 * MiB;
constexpr size_t OUT_KS = 8388608, OUT_VS = 9437184, OUT_ST = 10485760, OUT_KD = 14680064, OUT_VD = 23068672;

struct Params { const float* in[27]; float* out; unsigned char* ws; int ph_lo, ph_hi; };
constexpr int PB_OFF = 143360;
struct PB {
    LAS unsigned char* l;
    __device__ __forceinline__ unsigned long long q(int i) const { const LAS unsigned* w = (const LAS unsigned*)(l + PB_OFF) + 2 * i; const unsigned lo = __builtin_amdgcn_readfirstlane(w[0]), hi = __builtin_amdgcn_readfirstlane(w[1]); return ((unsigned long long)hi << 32) | lo; }
    __device__ __forceinline__ const float* in(int i) const { return (const float*)q(i); }
    __device__ __forceinline__ float* out() const { return (float*)q(27); }
    __device__ __forceinline__ unsigned char* ws() const { return (unsigned char*)q(28); }
};

__device__ __forceinline__ float wave_sum(float v) {
#pragma unroll
    for (int o = 1; o < 64; o <<= 1) v += __shfl_xor(v, o);
    return v;
}

__device__ __forceinline__ void p0_transpose_item(const float* W, int K, int N, bf16_t* WT, bool hperm, LAS float* scr, int item, int lane) {
    const int nblk = N / 64, kb = item / nblk, nb = item % nblk, k0 = 64 * kb, n0 = 64 * nb;
    const float* wp = W + (size_t)(k0 + (lane >> 4)) * N + n0 + (lane & 15) * 4;
    f32x4 t4[16];
#pragma unroll
    for (int i = 0; i < 16; ++i) t4[i] = __builtin_nontemporal_load((const f32x4*)(wp + (size_t)(4 * i) * N));
#pragma unroll
    for (int i = 0; i < 16; ++i) { LAS float* d = scr + (4 * i + (lane >> 4)) * 65 + (lane & 15) * 4; d[0] = t4[i][0]; d[1] = t4[i][1]; d[2] = t4[i][2]; d[3] = t4[i][3]; }
    asm volatile("s_waitcnt lgkmcnt(0)" ::: "memory");
    const int c = lane & 7;
#pragma unroll
    for (int jj = 0; jj < 8; ++jj) { const int n = (lane >> 3) + 8 * jj; const LAS float* s = scr + (8 * c) * 65 + n;
        u32x4 o; o.x = cvt_pk_bf16(s[0 * 65], s[1 * 65]); o.y = cvt_pk_bf16(s[2 * 65], s[3 * 65]); o.z = cvt_pk_bf16(s[4 * 65], s[5 * 65]); o.w = cvt_pk_bf16(s[6 * 65], s[7 * 65]);
        const int col = n0 + n; int drow = col;
        if (hperm) { const int cc = col & 255; drow = (col & ~255) + ((cc >> 5) & 1) * 128 + (cc >> 6) * 32 + (cc & 31); }
        *(u32x4*)(WT + (size_t)drow * K + k0 + 8 * c) = o; }
    asm volatile("s_waitcnt lgkmcnt(0)" ::: "memory");
}

__device__ __forceinline__ void convert_layer_a(const PB p, LAS unsigned char* lds, int L, int rank, int nw) {
    const int tid = tid_l(), lane = tid & 63, wave = __builtin_amdgcn_readfirstlane(tid >> 6);
    unsigned char* ws = p.ws();
    LAS float* scr = (LAS float*)(lds + wave * 16640);
    const int odd = L & 1, j = L >> 1;
    const int I_IN = odd ? 16 * (NOD / 64) : 16 * (NEV / 64), I_SQ = 256, I_W = 1024;
    const int nitems = I_IN + I_SQ + I_W;
    for (int it = rank; it < nitems; it += nw) {
        int r = it, jj, K = DM, N = DM, srci; size_t dof; bool hp = false;
        if (r < I_IN) { srci = odd ? 19 : 12; N = odd ? NOD : NEV; hp = true; jj = j; dof = (odd ? WS_WINO : WS_WINE) + (size_t)j * N * DM * 2; }
        else if ((r -= I_IN) < I_SQ) { srci = odd ? 20 : 13; jj = j; dof = (odd ? WS_WOUTO : WS_WOUTE) + (size_t)j * DM * DM * 2; }
        else { r -= I_SQ; srci = 25; N = FF; jj = L; dof = WS_W1 + (size_t)L * FF * DM * 2; }
        p0_transpose_item(p.in(srci) + (size_t)jj * K * N, K, N, (bf16_t*)(ws + dof), hp, scr, r, lane);
    }
}
__device__ __forceinline__ void phase0(const PB p, LAS unsigned char* lds) {
    const int tid = tid_l(), lane = tid & 63, wave = __builtin_amdgcn_readfirstlane(tid >> 6);
    const int G = gridDim.x, bid = blockIdx.x;
    unsigned char* ws = p.ws();
    {
        LAS float* scr = (LAS float*)(lds + wave * 16640);
        const int gw = bid * 8 + wave, NGW = G * 8;
        constexpr int I_INE = 16 * (NEV / 64), I_SQ = 16 * 16, I_INO = 16 * (NOD / 64), I_W1 = 16 * (FF / 64), I_W2 = 64 * 16;
        constexpr int I_CVD = 8 * 16, I_CVS = 8 * 2;
        constexpr int NITEMS = I_INE + I_SQ + I_W1 + 4 * I_W2 + 8 * I_CVD + 8 * I_CVS;
        for (int it = gw; it < NITEMS; it += NGW) {
            int r = it, jj = 0, K = DM, N = DM, srci = 26; size_t dof; bool hp = false;
            if (r < I_INE) { srci = 12; N = NEV; hp = true; dof = WS_WINE; }
            else if ((r -= I_INE) < I_SQ) { srci = 13; dof = WS_WOUTE; }
            else if ((r -= I_SQ) < I_W1) { srci = 25; N = FF; dof = WS_W1; }
            else if ((r -= I_W1) < 4 * I_W2) { jj = r / I_W2; r -= jj * I_W2; srci = 26; K = FF; dof = WS_W2 + (size_t)jj * DM * FF * 2; }
            else if ((r -= 4 * I_W2) < 8 * I_CVD) { jj = r / I_CVD; r -= jj * I_CVD; srci = 6; K = 512; N = 1024; dof = WS_CVD + (size_t)jj * 1024 * 512 * 2; }
            else { r -= 8 * I_CVD; jj = r / I_CVS; r -= jj * I_CVS; srci = 3; K = 512; N = 128; dof = WS_CVS + (size_t)jj * 128 * 512 * 2; }
            p0_transpose_item(p.in(srci) + (size_t)jj * K * N, K, N, (bf16_t*)(ws + dof), hp, scr, r, lane);
        }
    }
    {
        float* mods = (float*)(ws + WS_MODS);
        LAS float* s = (LAS float*)lds; LAS float* red = (LAS float*)(lds + 20480);
        for (int u = bid; u < 192; u += G) {
            const int li = u / 48, nc = u % 48;
            __syncthreads();
            for (int e = tid; e < 5120; e += 512) { const int cnd = e >> 10, k = e & 1023; const float cv = (cnd == 0) ? p.in(8)[k] : p.in(7)[(cnd - 1) * 1024 + k]; s[e] = cv / (1.f + __expf(-cv)); }
            __syncthreads();
            const int kg = tid >> 7, col = tid & 127, n = nc * 128 + col;
            const float* w = p.in(10) + ((size_t)li * 1024 + kg * 256) * 6144 + n;
            const LAS float* sk = s + kg * 256;
            float a0 = 0.f, a1 = 0.f, a2 = 0.f, a3 = 0.f, a4 = 0.f;
#pragma unroll 8
            for (int k = 0; k < 256; ++k) { const float wv = w[(size_t)k * 6144]; a0 += sk[k] * wv; a1 += sk[1024 + k] * wv; a2 += sk[2048 + k] * wv; a3 += sk[3072 + k] * wv; a4 += sk[4096 + k] * wv; }
            red[(kg * 5 + 0) * 128 + col] = a0; red[(kg * 5 + 1) * 128 + col] = a1; red[(kg * 5 + 2) * 128 + col] = a2; red[(kg * 5 + 3) * 128 + col] = a3; red[(kg * 5 + 4) * 128 + col] = a4;
            __syncthreads();
            for (int e = tid; e < 640; e += 512) { const int c = e >> 7, cl = e & 127;
                const float sum = ((red[(0 * 5 + c) * 128 + cl] + red[(1 * 5 + c) * 128 + cl]) + red[(2 * 5 + c) * 128 + cl]) + red[(3 * 5 + c) * 128 + cl];
                mods[(size_t)(li * 5 + c) * 6144 + nc * 128 + cl] = sum + p.in(11)[li * 6144 + nc * 128 + cl]; }
        }
    }
    if (bid == G - 1) {
        float* tab = (float*)(ws + WS_TAB);
        for (int e = tid; e < 1024; e += 512) { const float l0 = p.in(14)[e], l1 = p.in(14)[1024 + e]; tab[e] = 0.f; tab[1024 + e] = 1.f / (1.f + __expf(l0 - l1)); }
        if (tid < 2) { const int jj = tid; const float* lp = p.in(23) + jj * 256; float d1 = 0.f, d2 = 0.f;
            for (int i = 0; i < 64; ++i) { d1 += lp[i] * lp[64 + i]; d2 += lp[128 + i] * lp[192 + i]; }
            const float li_ = (float)(2 * jj + 1); const float lam_init = 0.8f - 0.6f * expf(-0.3f * li_);
            tab[2048 + jj] = expf(d1) - expf(d2) + lam_init; tab[2050 + jj] = lam_init; }
        for (int e = tid; e < 1024; e += 512) { const int pos = e >> 4, f = e & 15;
            const float inv = exp2f(-(float)(2 * f) * (13.287712379549449f / 32.0f));
            const float a = (float)pos * inv;
            const float kk = rintf(a * 0.15915494309189535f); float rr = fmaf(-kk, 6.2831854820251465f, a); rr = fmaf(-kk, -1.7484555e-7f, rr);
            tab[4096 + e * 2] = __cosf(rr); tab[4096 + e * 2 + 1] = __sinf(rr); }
    }
    {
        const size_t gt = (size_t)bid * 512 + tid, GT = (size_t)G * 512;
#define CVT_ARR(SRC, DST, N4) for (size_t i = gt; i < (size_t)(N4); i += GT) { const f32x4 v = ((const f32x4*)(SRC))[i]; u32x2 w; w.x = cvt_pk_bf16(v[0], v[1]); w.y = cvt_pk_bf16(v[2], v[3]); ((u32x2*)(DST))[i] = w; }
        CVT_ARR(p.in(2), ws + WS_CKS, 131072) CVT_ARR(p.in(5), ws + WS_CKD, 1048576)
#undef CVT_ARR
    }
}

__device__ __forceinline__ f32x4 bf4(u32x2 w) { f32x4 r; r[0] = __builtin_bit_cast(float, w.x << 16); r[1] = __builtin_bit_cast(float, w.x & 0xffff0000u); r[2] = __builtin_bit_cast(float, w.y << 16); r[3] = __builtin_bit_cast(float, w.y & 0xffff0000u); return r; }
__device__ __forceinline__ void norm_phase(const PB p, int mode, int li, int which, int gate_off) {
    const int tid = tid_l(), lane = tid & 63, wave = tid >> 6;
    const int gw = blockIdx.x * 8 + wave, NGW = gridDim.x * 8;
    unsigned char* ws = p.ws();
    const float* mods = (const float*)(ws + WS_MODS);
    const bf16_t* P0 = (const bf16_t*)(ws + WS_P0); const bf16_t* P1 = (const bf16_t*)(ws + WS_P1);
    bf16_t* XN = (bf16_t*)(ws + WS_XN);
    float* xo = p.out();
    const float* nw = p.in(9) + (li * 2 + which) * 1024;
    const float* x0 = p.in(0); const float* x1 = p.in(1);
    for (int grp = gw; grp < NTOK / 4; grp += NGW) {
        const int row0 = grp * 4; const int cond = row0 < 4096 ? 0 : 1 + ((row0 - 4096) >> 10);
        const float* md = mods + (size_t)(li * 5 + cond) * 6144 + which * 3072;
        f32x4 g4[4], w4[4], sh4[4], sc4[4];
#pragma unroll
        for (int jj = 0; jj < 4; ++jj) { const int c = 4 * lane + 256 * jj;
            if (mode != 0) g4[jj] = *(const f32x4*)(mods + gate_off + cond * 6144 + c);
            if (mode != 2) { w4[jj] = *(const f32x4*)(nw + c); sh4[jj] = *(const f32x4*)(md + c); sc4[jj] = *(const f32x4*)(md + 1024 + c); } }
#pragma unroll
        for (int hh = 0; hh < 2; ++hh) {
            f32x4 x[2][4]; u32x2 a0[2][4], a1[2][4];
#pragma unroll
            for (int rr = 0; rr < 2; ++rr) { const int row = row0 + 2 * hh + rr;
                const float* xr = mode == 0 ? (row < 4096 ? x0 + (size_t)row * 1024 : x1 + (size_t)(row - 4096) * 1024) : xo + (size_t)row * 1024;
#pragma unroll
                for (int jj = 0; jj < 4; ++jj) { const int c = 4 * lane + 256 * jj; x[rr][jj] = __builtin_nontemporal_load((const f32x4*)(xr + c));
                    if (mode != 0) { a0[rr][jj] = __builtin_nontemporal_load((const u32x2*)(P0 + (size_t)row * 1024 + c)); a1[rr][jj] = __builtin_nontemporal_load((const u32x2*)(P1 + (size_t)row * 1024 + c)); } } }
#pragma unroll
            for (int rr = 0; rr < 2; ++rr) { const int row = row0 + 2 * hh + rr; float ss = 0.f;
#pragma unroll
                for (int jj = 0; jj < 4; ++jj) { const int c = 4 * lane + 256 * jj;
                    if (mode != 0) x[rr][jj] = x[rr][jj] + g4[jj] * (bf4(a0[rr][jj]) + bf4(a1[rr][jj]));
                    ss += (x[rr][jj][0] * x[rr][jj][0] + x[rr][jj][1] * x[rr][jj][1]) + (x[rr][jj][2] * x[rr][jj][2] + x[rr][jj][3] * x[rr][jj][3]);
                    __builtin_nontemporal_store(x[rr][jj], (f32x4*)(xo + (size_t)row * 1024 + c)); }
                if (mode != 2) {
                    const float rstd = rsqrtf(wave_sum(ss) * (1.f / 1024.f) + 1e-6f);
#pragma unroll
                    for (int jj = 0; jj < 4; ++jj) { const int c = 4 * lane + 256 * jj;
                        const f32x4 o = x[rr][jj] * rstd * w4[jj] * (1.f + sc4[jj]) + sh4[jj];
                        u32x2 pk; pk.x = cvt_pk_bf16(o[0], o[1]); pk.y = cvt_pk_bf16(o[2], o[3]);
                        *(u32x2*)(XN + (size_t)row * 1024 + c) = pk; } } }
        }
    }
}

constexpr int HC_QP = 0, HC_QPP = 17408, HC_KP = 34816, HC_KT = 52224, HC_VT = 70656, HC_ST = 89088, HC_P = 123904, HC_SC = 133120;
__device__ __forceinline__ float exp_c(float x) { return __builtin_amdgcn_exp2f(fminf(x, 115.f)); }
__device__ __forceinline__ unsigned short bf16r(float x) { return (unsigned short)(cvt_pk_bf16(x, 0.f) & 0xffffu); }
template <int BWD, int DIR> __device__ __forceinline__ void hc_load(float (&rq)[16], float (&rf)[16], float (&rv)[16], const GAS float* base) {
    constexpr int st = DIR ? -2560 : 2560, fo = 512 + DIR * 512;
    asm volatile("" : "+v"(base));
#pragma unroll
    for (int i = 0; i < 16; ++i) { const GAS float* rp = base + (BWD ? -i : i) * st; rq[i] = rp[0]; rf[i] = rp[fo]; rv[i] = rp[1536]; }
}
template <int BWD> __device__ __forceinline__ void hc_pass2(const float (&rq)[16], const float (&rf)[16], const float (&rv)[16], const float (&rel)[16], float off, float ecm, int ch, int anchor,
        LAS unsigned short* QP, LAS unsigned short* QPP, LAS unsigned short* KP, LAS unsigned short* KT, LAS unsigned short* VT, bool vmine) {
    LAS unsigned short* qp_ = QP + anchor * 136 + ch; LAS unsigned short* qpp_ = QPP + anchor * 136 + ch; LAS unsigned short* kp_ = KP + anchor * 136 + ch;
    unsigned kk[16];
#pragma unroll
    for (int i = 0; i < 16; ++i) { const int d = BWD ? -i : i; const float r = rel[i] + off;
        const float qp = rq[i] * exp_c(r); const float kp = (1.f - rf[i]) * exp_c(-r);
        qp_[d * 136] = bf16r(qp); qpp_[d * 136] = bf16r(qp * ecm); const unsigned short k16 = bf16r(kp); kp_[d * 136] = k16; kk[BWD ? 15 - i : i] = k16; }
    const int t0 = BWD ? anchor - 15 : anchor;
    u32x4 w0, w1, v0, v1;
    w0.x = kk[0] | (kk[1] << 16); w0.y = kk[2] | (kk[3] << 16); w0.z = kk[4] | (kk[5] << 16); w0.w = kk[6] | (kk[7] << 16);
    w1.x = kk[8] | (kk[9] << 16); w1.y = kk[10] | (kk[11] << 16); w1.z = kk[12] | (kk[13] << 16); w1.w = kk[14] | (kk[15] << 16);
#define RV(e_) rv[BWD ? 15 - (e_) : (e_)]
    v0.x = cvt_pk_bf16(RV(0), RV(1)); v0.y = cvt_pk_bf16(RV(2), RV(3)); v0.z = cvt_pk_bf16(RV(4), RV(5)); v0.w = cvt_pk_bf16(RV(6), RV(7));
    v1.x = cvt_pk_bf16(RV(8), RV(9)); v1.y = cvt_pk_bf16(RV(10), RV(11)); v1.z = cvt_pk_bf16(RV(12), RV(13)); v1.w = cvt_pk_bf16(RV(14), RV(15));
#undef RV
    *(LAS u32x4*)(KT + ch * 72 + t0) = w0; *(LAS u32x4*)(KT + ch * 72 + t0 + 8) = w1;
    if (vmine) { *(LAS u32x4*)(VT + (ch & 63) * 72 + t0) = v0; *(LAS u32x4*)(VT + (ch & 63) * 72 + t0 + 8) = v1; }
}
template <int DIR>
__device__ __forceinline__ void hgrn_chunked_item(const PB p, LAS unsigned char* lds, int j, int s, int h, int vh) {
    constexpr int dir = DIR;
    const int tid = tid_l(), lane = tid & 63, fr = lane & 15, fq = lane >> 4; const int w = __builtin_amdgcn_readfirstlane(tid >> 6);
    const int L = s < 16 ? 256 : 1024, R0 = s < 16 ? s * 256 : 4096 + (s - 16) * 1024;
    const GAS float* hg = (const GAS float*)(p.ws() + WS_HG);
    GAS float* og = (GAS float*)(p.ws() + (dir ? WS_OB : WS_OF));
    LAS unsigned short* QP = (LAS unsigned short*)(lds + HC_QP); LAS unsigned short* QPP = (LAS unsigned short*)(lds + HC_QPP); LAS unsigned short* KP = (LAS unsigned short*)(lds + HC_KP);
    LAS unsigned short* KT = (LAS unsigned short*)(lds + HC_KT); LAS unsigned short* VT = (LAS unsigned short*)(lds + HC_VT); LAS unsigned short* ST = (LAS unsigned short*)(lds + HC_ST);
    LAS unsigned short* PM = (LAS unsigned short*)(lds + HC_P); LAS float* scal = (LAS float*)(lds + HC_SC);
    const int vb = w & 3, kh = w >> 2;
    f32x4 S[4];
    if (s >= 16) { const GAS float* st = (const GAS float*)p.in(4) + ((((size_t)(s - 16) * 2 + j) * 2 + dir) * 4 + h) * 16384;
#pragma unroll
        for (int kb = 0; kb < 4; ++kb) S[kb] = *(const GAS f32x4*)(st + (size_t)(16 * (4 * kh + kb) + fr) * 128 + 64 * vh + 16 * vb + 4 * fq); }
    else {
#pragma unroll
        for (int kb = 0; kb < 4; ++kb) S[kb] = (f32x4){0.f, 0.f, 0.f, 0.f}; }
    const int quarter = __builtin_amdgcn_readfirstlane(tid >> 7); const bool bwd = quarter < 2; const int ch = tid & 127;
    const int anchor = quarter == 0 ? 15 : quarter == 1 ? 31 : quarter == 2 ? 32 : 48;
    constexpr int st = dir ? -2560 : 2560;
    const GAS float* row0 = hg + (size_t)(R0 + (dir ? L - 1 : 0)) * 2560 + h * 128;
    float rq[16], rf[16], rv[16];
    float nq[16], nf[16], nv[16];
#define HC_LOAD(cc_, Q_, F_, V_) do { const GAS float* rc_ = row0 + ((long)(cc_) * 64 + anchor) * st + ch; if (bwd) hc_load<1, DIR>(Q_, F_, V_, rc_); else hc_load<0, DIR>(Q_, F_, V_, rc_); } while (0)
    HC_LOAD(0, rq, rf, rv);
    LDS_BARRIER();
#pragma unroll
    for (int kb = 0; kb < 4; ++kb)
#pragma unroll
        for (int r = 0; r < 4; ++r) ST[(16 * vb + 4 * fq + r) * 136 + 16 * (4 * kh + kb) + fr] = bf16r(S[kb][r]);
    const int nchunk = L >> 6;
    for (int c = 0; c < nchunk; ++c) {
        float rel[16];
        if (c + 1 < nchunk) HC_LOAD(c + 1, nq, nf, nv);
        { float cc = 0.f;
#pragma unroll
            for (int i = 0; i < 16; ++i) { const float g = __builtin_amdgcn_logf(rf[i]);   if (!bwd) { cc += g; rel[i] = cc; } else { rel[i] = -cc; cc += g; } }
            scal[quarter * 128 + ch] = cc; }
        LDS_BARRIER();
        { const float t0 = scal[ch], t1 = scal[128 + ch], t2 = scal[256 + ch], t3 = scal[384 + ch];
            const float off = quarter == 0 ? -t1 : quarter == 3 ? t2 : 0.f; const float cm = t0 + t1;
            if (quarter == 1) scal[512 + ch] = cm; if (quarter == 2) scal[640 + ch] = t2 + t3;
            const float ecm = exp_c(cm);
            const bool vmine = (ch >> 6) == vh;
            if (bwd) hc_pass2<1>(rq, rf, rv, rel, off, ecm, ch, anchor, QP, QPP, KP, KT, VT, vmine); else hc_pass2<0>(rq, rf, rv, rel, off, ecm, ch, anchor, QP, QPP, KP, KT, VT, vmine); }
        LDS_BARRIER();
        { const int tb = w & 3, sh = w >> 2; const int t = 16 * tb + fr;
#pragma unroll
            for (int sbi = 0; sbi < 2; ++sbi) { const int sb = 2 * sh + sbi; f32x4 a = {0.f, 0.f, 0.f, 0.f};
                if (sb <= tb) {
#pragma unroll
                    for (int ks = 0; ks < 4; ++ks) { const bf16x8 A = *(const LAS bf16x8*)(KP + (16 * sb + fr) * 136 + 32 * ks + 8 * fq); const bf16x8 B = *(const LAS bf16x8*)(QP + (16 * tb + fr) * 136 + 32 * ks + 8 * fq);
                        a = __builtin_amdgcn_mfma_f32_16x16x32_bf16(A, B, a, 0, 0, 0); } }
#pragma unroll
                for (int r = 0; r < 4; ++r) if (16 * sb + 4 * fq + r > t) a[r] = 0.f;
                u32x2 wv; wv.x = cvt_pk_bf16(a[0], a[1]); wv.y = cvt_pk_bf16(a[2], a[3]);
                *(LAS u32x2*)(PM + t * 72 + 16 * sb + 4 * fq) = wv; } }
        LDS_BARRIER();
        { bf16x8 vt[2], stf[4];
#pragma unroll
            for (int sl = 0; sl < 2; ++sl) vt[sl] = *(const LAS bf16x8*)(VT + (16 * vb + fr) * 72 + 32 * sl + 8 * fq);
#pragma unroll
            for (int ks = 0; ks < 4; ++ks) stf[ks] = *(const LAS bf16x8*)(ST + (16 * vb + fr) * 136 + 32 * ks + 8 * fq);
            GAS float* ob = og + (size_t)(R0 + (dir ? L - 1 : 0)) * 512 + (long)c * 64 * (dir ? -512 : 512) + h * 128 + 64 * vh + 16 * vb + 4 * fq;
#pragma unroll
            for (int tbi = 0; tbi < 2; ++tbi) { const int tb = 2 * kh + tbi; f32x4 o = {0.f, 0.f, 0.f, 0.f};
#pragma unroll
                for (int sl = 0; sl < 2; ++sl) if (32 * sl <= 16 * tb + 15) { const bf16x8 B = *(const LAS bf16x8*)(PM + (16 * tb + fr) * 72 + 32 * sl + 8 * fq); o = __builtin_amdgcn_mfma_f32_16x16x32_bf16(vt[sl], B, o, 0, 0, 0); }
#pragma unroll
                for (int ks = 0; ks < 4; ++ks) { const bf16x8 B = *(const LAS bf16x8*)(QPP + (16 * tb + fr) * 136 + 32 * ks + 8 * fq); o = __builtin_amdgcn_mfma_f32_16x16x32_bf16(stf[ks], B, o, 0, 0, 0); }
                *(GAS f32x4*)(ob + (long)(16 * tb + fr) * (dir ? -512 : 512)) = o; }
#pragma unroll
            for (int kbi = 0; kbi < 4; ++kbi) { const int kb = 4 * kh + kbi; const float cmv = scal[512 + 16 * kb + fr], r63 = scal[640 + 16 * kb + fr]; const float dec = exp_c(cmv + r63), e63 = exp_c(r63);
                f32x4 tt = {0.f, 0.f, 0.f, 0.f};
#pragma unroll
                for (int sl = 0; sl < 2; ++sl) { const bf16x8 B = *(const LAS bf16x8*)(KT + (16 * kb + fr) * 72 + 32 * sl + 8 * fq); tt = __builtin_amdgcn_mfma_f32_16x16x32_bf16(vt[sl], B, tt, 0, 0, 0); }
                S[kbi] = S[kbi] * dec + tt * e63; } }
        LDS_BARRIER();
#pragma unroll
        for (int kb = 0; kb < 4; ++kb)
#pragma unroll
            for (int r = 0; r < 4; ++r) ST[(16 * vb + 4 * fq + r) * 136 + 16 * (4 * kh + kb) + fr] = bf16r(S[kb][r]);
#pragma unroll
        for (int i = 0; i < 16; ++i) { rq[i] = nq[i]; rf[i] = nf[i]; rv[i] = nv[i]; }
    }
#undef HC_LOAD
    if (s < 16) { GAS float* so = (GAS float*)p.out() + OUT_ST + ((((size_t)s * 2 + j) * 2 + dir) * 4 + h) * 16384;
#pragma unroll
        for (int kb = 0; kb < 4; ++kb) *(GAS f32x4*)(so + (size_t)(16 * (4 * kh + kb) + fr) * 128 + 64 * vh + 16 * vb + 4 * fq) = S[kb]; }
}
__device__ __forceinline__ void hgrn_chunked_dispatch(const PB p, LAS unsigned char* lds, int j, int it) {
    const int s = it >> 4, h = (it >> 2) & 3, vh = it & 1;
    if (it & 2) hgrn_chunked_item<1>(p, lds, j, s, h, vh); else hgrn_chunked_item<0>(p, lds, j, s, h, vh);
}
__device__ __forceinline__ void hgrn_readout(const PB p, int j) {
    const int tid = tid_l(), lane = tid & 63, wave = tid >> 6;
    const int gw = blockIdx.x * 8 + wave, NGW = gridDim.x * 8;
    const float* of = (const float*)(p.ws() + WS_OF); const float* ob = (const float*)(p.ws() + WS_OB); const float* hg = (const float*)(p.ws() + WS_HG);
    bf16_t* MIX = (bf16_t*)(p.ws() + WS_MIX);
    const int col = (lane >> 4) * 128 + (lane & 15) * 8;
    const float* nw = p.in(15) + j * 128 + (lane & 15) * 8;
    const f32x4 w0 = *(const f32x4*)nw, w1 = *(const f32x4*)(nw + 4);
    for (int row = gw; row < NTOK; row += NGW) {
        const f32x4 a0 = *(const f32x4*)(of + (size_t)row * 512 + col) + *(const f32x4*)(ob + (size_t)row * 512 + col);
        const f32x4 a1 = *(const f32x4*)(of + (size_t)row * 512 + col + 4) + *(const f32x4*)(ob + (size_t)row * 512 + col + 4);
        const f32x4 g0 = *(const f32x4*)(hg + (size_t)row * 2560 + 2048 + col), g1 = *(const f32x4*)(hg + (size_t)row * 2560 + 2048 + col + 4);
        float ss = (a0[0] * a0[0] + a0[1] * a0[1]) + (a0[2] * a0[2] + a0[3] * a0[3]) + (a1[0] * a1[0] + a1[1] * a1[1]) + (a1[2] * a1[2] + a1[3] * a1[3]);
        ss += __shfl_xor(ss, 1); ss += __shfl_xor(ss, 2); ss += __shfl_xor(ss, 4); ss += __shfl_xor(ss, 8);
        const float rs = rsqrtf(ss * (1.f / 128.f) + 1e-6f);
        f32x4 o0, o1;
#pragma unroll
        for (int i = 0; i < 4; ++i) { o0[i] = a0[i] * rs * w0[i] * g0[i] * __builtin_amdgcn_rcpf(1.f + __expf(-g0[i])); o1[i] = a1[i] * rs * w1[i] * g1[i] * __builtin_amdgcn_rcpf(1.f + __expf(-g1[i])); }
        u32x4 w; w.x = cvt_pk_bf16(o0[0], o0[1]); w.y = cvt_pk_bf16(o0[2], o0[3]); w.z = cvt_pk_bf16(o1[0], o1[1]); w.w = cvt_pk_bf16(o1[2], o1[3]);
        *(u32x4*)(MIX + (size_t)row * 1024 + col) = w;
    }
}

struct ASeg { const GAS bf16_t* K; const GAS bf16_t* V; int ldk, ldv, kpos0, ntiles, masked; };
template <int DV>
__device__ __forceinline__ void attn_tile(const LAS unsigned char* Ks, const LAS unsigned char* VT, bool msk, int kp0, int qpos, float c2, const bf16x8 qf0, const bf16x8 qf1, int fr, int fq, f32x4 (&o)[DV / 16], float& m, float& l) {
    f32x4 sc[4];
#pragma unroll
    for (int b = 0; b < 4; ++b) {
        const bf16x8 k0 = *(const LAS bf16x8*)(Ks + (16 * b + fr) * 144 + fq * 16), k1 = *(const LAS bf16x8*)(Ks + (16 * b + fr) * 144 + 64 + fq * 16);
        f32x4 a = {0.f, 0.f, 0.f, 0.f};
        a = __builtin_amdgcn_mfma_f32_16x16x32_bf16(k0, qf0, a, 0, 0, 0);
        a = __builtin_amdgcn_mfma_f32_16x16x32_bf16(k1, qf1, a, 0, 0, 0);
        sc[b] = a;
    }
    float mx = -1e30f; unsigned vmask = 0xffffu;
#pragma unroll
    for (int b = 0; b < 4; ++b)
#pragma unroll
        for (int r = 0; r < 4; ++r) { float v = sc[b][r];
            if (msk) { const int d = qpos - (kp0 + 32 * (b >> 1) + 4 * (b & 1) + r); if (d > 128 || d < -128) { v = -1e30f; vmask &= ~(1u << (b * 4 + r)); } }
            sc[b][r] = v; mx = fmaxf(mx, v); }
    mx *= c2;
    { auto r16 = __builtin_amdgcn_permlane16_swap(__float_as_uint(mx), __float_as_uint(mx), false, false); mx = fmaxf(__uint_as_float(r16[0]), __uint_as_float(r16[1]));
      auto r32 = __builtin_amdgcn_permlane32_swap(__float_as_uint(mx), __float_as_uint(mx), false, false); mx = fmaxf(__uint_as_float(r32[0]), __uint_as_float(r32[1])); }
    const float mn = fmaxf(m, mx); const float alpha = __builtin_amdgcn_exp2f(m - mn); m = mn;
    l *= alpha;
#pragma unroll
    for (int db = 0; db < DV / 16; ++db) o[db] = o[db] * alpha;
    float ls = 0.f;
#pragma unroll
    for (int b = 0; b < 4; ++b)
#pragma unroll
        for (int r = 0; r < 4; ++r) { float pr = __builtin_amdgcn_exp2f(fmaf(sc[b][r], c2, -mn)); if (msk && !((vmask >> (b * 4 + r)) & 1u)) pr = 0.f; sc[b][r] = pr; ls += pr; }
    l += ls;
    bf16x8 pf[2];
#pragma unroll
    for (int ks = 0; ks < 2; ++ks) { u32x4 w; w.x = cvt_pk_bf16(sc[2 * ks][0], sc[2 * ks][1]); w.y = cvt_pk_bf16(sc[2 * ks][2], sc[2 * ks][3]); w.z = cvt_pk_bf16(sc[2 * ks + 1][0], sc[2 * ks + 1][1]); w.w = cvt_pk_bf16(sc[2 * ks + 1][2], sc[2 * ks + 1][3]); pf[ks] = __builtin_bit_cast(bf16x8, w); }
#pragma unroll
    for (int db = 0; db < DV / 16; ++db)
#pragma unroll
        for (int ks = 0; ks < 2; ++ks) { const bf16x8 vv = *(const LAS bf16x8*)(VT + (16 * db + fr) * 144 + ks * 64 + fq * 16);
            o[db] = __builtin_amdgcn_mfma_f32_16x16x32_bf16(vv, pf[ks], o[db], 0, 0, 0); }
}
template <int DV>
__device__ __forceinline__ void attn_run(LAS unsigned char* lds, const GAS bf16_t* Qw, int qpos, const ASeg A, const ASeg B, float c2, f32x4 (&o)[DV / 16], float& m, float& l) {
    constexpr int BUF = 9216 + DV * 144;
    const int tid = tid_l(), lane = tid & 63, fr = lane & 15, fq = lane >> 4;
    const bf16x8 qf0 = *(const GAS bf16x8*)(Qw + fq * 8), qf1 = *(const GAS bf16x8*)(Qw + 32 + fq * 8);
    const int nt = A.ntiles + B.ntiles;
    const int kkey = tid >> 3, kch = tid & 7;
    const int krow = 32 * (kkey >> 5) + 16 * ((kkey >> 2) & 1) + 4 * ((kkey >> 3) & 3) + (kkey & 3);
    u32x4 kreg, vreg[DV / 64];
#define AT_LOAD(i_) do { const bool inA_ = (i_) < A.ntiles; const int ti_ = inA_ ? (i_) : (i_) - A.ntiles; const GAS bf16_t* kp_ = inA_ ? A.K : B.K; const GAS bf16_t* vp_ = inA_ ? A.V : B.V; const int ldk_ = inA_ ? A.ldk : B.ldk, ldv_ = inA_ ? A.ldv : B.ldv; \
        kreg = *(const GAS u32x4*)(kp_ + (size_t)(ti_ * 64 + kkey) * ldk_ + kch * 8); \
        _Pragma("unroll") for (int pp_ = 0; pp_ < DV / 64; ++pp_) vreg[pp_] = *(const GAS u32x4*)(vp_ + (size_t)(kkey + 64 * pp_) * ldv_ + ti_ * 64 + kch * 8); } while (0)
#define AT_STORE(b_) do { LAS unsigned char* kb_ = lds + (b_) * BUF; *(LAS u32x4*)(kb_ + krow * 144 + kch * 16) = kreg; \
        _Pragma("unroll") for (int pp_ = 0; pp_ < DV / 64; ++pp_) *(LAS u32x4*)(kb_ + 9216 + (kkey + 64 * pp_) * 144 + kch * 16) = vreg[pp_]; } while (0)
    AT_LOAD(0);
    LDS_BARRIER();
    AT_STORE(0);
    if (nt > 1) AT_LOAD(1);
    LDS_BARRIER();
    for (int it = 0; it < nt; ++it) {
        const LAS unsigned char* Ks = lds + (it & 1) * BUF;
        attn_tile<DV>(Ks, Ks + 9216, (it < A.ntiles) && A.masked, A.kpos0 + it * 64 + 8 * fq, qpos, c2, qf0, qf1, fr, fq, o, m, l);
        if (it + 1 < nt) { AT_STORE((it + 1) & 1); if (it + 2 < nt) AT_LOAD(it + 2); }
        LDS_BARRIER();
    }
#undef AT_LOAD
#undef AT_STORE
}
__device__ __forceinline__ void diff_attn_run(LAS unsigned char* lds, const GAS bf16_t* Qw, int nA, int nB, const GAS bf16_t* KA, int ldkA, const GAS bf16_t* VA, int ldvA, const GAS bf16_t* KB, int ldkB, const GAS bf16_t* VB, int ldvB,
        float c2, f32x4 (&o0)[8], f32x4 (&o1)[8], float& m0, float& l0, float& m1, float& l1) {
    constexpr int BUF = 36864;
    const int tid = tid_l(), lane = tid & 63, fr = lane & 15, fq = lane >> 4;
    const bf16x8 q00 = *(const GAS bf16x8*)(Qw + fq * 8), q01 = *(const GAS bf16x8*)(Qw + 32 + fq * 8), q10 = *(const GAS bf16x8*)(Qw + 64 + fq * 8), q11 = *(const GAS bf16x8*)(Qw + 96 + fq * 8);
    const int nt = nA + nB;
    const int kkey = tid >> 3, kch = tid & 7;
    const int krow = 32 * (kkey >> 5) + 16 * ((kkey >> 2) & 1) + 4 * ((kkey >> 3) & 3) + (kkey & 3);
    u32x4 k0r, k1r, vreg[2];
#define DA_LOAD(i_) do { const bool inA_ = (i_) < nA; const int ti_ = inA_ ? (i_) : (i_) - nA; const GAS bf16_t* kp_ = (inA_ ? KA : KB) + (size_t)(ti_ * 64 + kkey) * (inA_ ? ldkA : ldkB) + kch * 8; const GAS bf16_t* vp_ = inA_ ? VA : VB; const int ldv_ = inA_ ? ldvA : ldvB; \
        k0r = *(const GAS u32x4*)kp_; k1r = *(const GAS u32x4*)(kp_ + 64); \
        _Pragma("unroll") for (int pp_ = 0; pp_ < 2; ++pp_) vreg[pp_] = *(const GAS u32x4*)(vp_ + (size_t)(kkey + 64 * pp_) * ldv_ + ti_ * 64 + kch * 8); } while (0)
#define DA_STORE(b_) do { LAS unsigned char* kb_ = lds + (b_) * BUF; *(LAS u32x4*)(kb_ + krow * 144 + kch * 16) = k0r; *(LAS u32x4*)(kb_ + 9216 + krow * 144 + kch * 16) = k1r; \
        _Pragma("unroll") for (int pp_ = 0; pp_ < 2; ++pp_) *(LAS u32x4*)(kb_ + 18432 + (kkey + 64 * pp_) * 144 + kch * 16) = vreg[pp_]; } while (0)
    DA_LOAD(0);
    LDS_BARRIER();
    DA_STORE(0);
    if (nt > 1) DA_LOAD(1);
    LDS_BARRIER();
    for (int it = 0; it < nt; ++it) {
        const LAS unsigned char* Ks = lds + (it & 1) * BUF;
        attn_tile<128>(Ks, Ks + 18432, false, 0, 0, c2, q00, q01, fr, fq, o0, m0, l0);
        attn_tile<128>(Ks + 9216, Ks + 18432, false, 0, 0, c2, q10, q11, fr, fq, o1, m1, l1);
        if (it + 1 < nt) { DA_STORE((it + 1) & 1); if (it + 2 < nt) DA_LOAD(it + 2); }
        LDS_BARRIER();
    }
#undef DA_LOAD
#undef DA_STORE
}

__device__ __forceinline__ void swa_unit(const PB p, LAS unsigned char* lds, int j, int s, int hq, int qb) {
    const int tid = tid_l(), lane = tid & 63, fr = lane & 15, fq = lane >> 4, wave = tid >> 6;
    const bool lat = s >= 16; const int R0 = lat ? 4096 + (s - 16) * 1024 : s * 256; const int kvh = hq >> 2;
    const GAS bf16_t* PR = (const GAS bf16_t*)(p.ws() + WS_PROJ);
    const int q0 = qb * 128, qrow = q0 + wave * 16 + fr;
    const GAS bf16_t* Qw = PR + (size_t)(R0 + qrow) * 768 + hq * 64;
    ASeg A, B;
    const GAS bf16_t* VTo = (const GAS bf16_t*)(p.ws() + WS_VT) + (size_t)128 * R0 + (size_t)(kvh * 64) * (lat ? 1024 : 256);
    A.ldk = 768; A.ldv = lat ? 1024 : 256; B.ldk = 128; B.ldv = 512; B.kpos0 = 0; B.masked = 0;
    if (lat) { const int t0 = q0 - 128 < 0 ? 0 : q0 - 128; const int t1 = q0 + 256 > 1024 ? 1024 : q0 + 256;
        A.kpos0 = t0; A.ntiles = (t1 - t0) >> 6; A.masked = 1;
        A.K = PR + (size_t)(R0 + t0) * 768 + 512 + kvh * 64; A.V = VTo + t0;
        B.ntiles = 8; B.K = (const GAS bf16_t*)(p.ws() + WS_CKS) + ((size_t)((s - 16) * 2 + j) * 512) * 128 + kvh * 64; B.V = (const GAS bf16_t*)(p.ws() + WS_CVS) + ((size_t)((s - 16) * 2 + j) * 128 + kvh * 64) * 512; }
    else { A.kpos0 = 0; A.ntiles = 4; A.masked = 0; A.K = PR + (size_t)R0 * 768 + 512 + kvh * 64; A.V = VTo; B.ntiles = 0; B.K = A.K; B.V = A.V; }
    f32x4 o[4]; float m = -1e30f, l = 0.f;
#pragma unroll
    for (int db = 0; db < 4; ++db) o[db] = (f32x4){0.f, 0.f, 0.f, 0.f};
    attn_run<64>(lds, Qw, qrow, A, B, 0.125f * 1.4426950408889634f, o, m, l);
    l += __shfl_xor(l, 16); l += __shfl_xor(l, 32);
    const float sk = p.in(18)[j * 8 + hq] * 1.4426950408889634f;
    const float mf = fmaxf(m, sk); const float a = __builtin_amdgcn_exp2f(m - mf); const float lt = l * a + __builtin_amdgcn_exp2f(sk - mf);
    const float sc = a / lt;
    GAS bf16_t* op = (GAS bf16_t*)(p.ws() + WS_MIX) + (size_t)(R0 + qrow) * 1024 + 512 + hq * 64 + 4 * fq;
#pragma unroll
    for (int db = 0; db < 4; ++db) { const f32x4 v = o[db] * sc; u32x2 w; w.x = cvt_pk_bf16(v[0], v[1]); w.y = cvt_pk_bf16(v[2], v[3]); *(GAS u32x2*)(op + 16 * db) = w; }
}
__device__ __forceinline__ void diff_unit(const PB p, LAS unsigned char* lds, int j, int s, int h, int qb) {
    const int tid = tid_l(), lane = tid & 63, fr = lane & 15, fq = lane >> 4, wave = tid >> 6;
    const bool lat = s >= 16; const int R0 = lat ? 4096 + (s - 16) * 1024 : s * 256;
    const GAS bf16_t* PR = (const GAS bf16_t*)(p.ws() + WS_PROJ);
    const int q0 = qb * 128, qrow = q0 + wave * 16 + fr;
    const float* tab = (const float*)(p.ws() + WS_TAB);
    const float lam = tab[2048 + j], lam_init = tab[2050 + j];
    const GAS bf16_t* Qw = PR + (size_t)(R0 + qrow) * 3072 + h * 128;
    const GAS bf16_t* KA = PR + (size_t)R0 * 3072 + 1024 + h * 128;
    const GAS bf16_t* VA = (const GAS bf16_t*)(p.ws() + WS_VT) + (size_t)1024 * R0 + (size_t)(h * 128) * (lat ? 1024 : 256);
    const GAS bf16_t* KB = lat ? (const GAS bf16_t*)(p.ws() + WS_CKD) + ((size_t)((s - 16) * 2 + j) * 512) * 1024 + h * 128 : KA;
    const GAS bf16_t* VB = lat ? (const GAS bf16_t*)(p.ws() + WS_CVD) + ((size_t)((s - 16) * 2 + j) * 1024 + h * 128) * 512 : VA;
    f32x4 o0[8], o1[8]; float m0 = -1e30f, l0 = 0.f, m1 = -1e30f, l1 = 0.f;
#pragma unroll
    for (int db = 0; db < 8; ++db) { o0[db] = (f32x4){0.f, 0.f, 0.f, 0.f}; o1[db] = (f32x4){0.f, 0.f, 0.f, 0.f}; }
    diff_attn_run(lds, Qw, lat ? 16 : 4, lat ? 8 : 0, KA, 3072, VA, lat ? 1024 : 256, KB, 1024, VB, 512, 0.125f * 1.4426950408889634f, o0, o1, m0, l0, m1, l1);
    l0 += __shfl_xor(l0, 16); l0 += __shfl_xor(l0, 32); l1 += __shfl_xor(l1, 16); l1 += __shfl_xor(l1, 32);
    const float i0 = 1.f / l0, i1 = lam / l1; float ss = 0.f;
#pragma unroll
    for (int db = 0; db < 8; ++db) { const f32x4 r = o0[db] * i0 - o1[db] * i1; o0[db] = r; ss += (r[0] * r[0] + r[1] * r[1]) + (r[2] * r[2] + r[3] * r[3]); }
    ss += __shfl_xor(ss, 16); ss += __shfl_xor(ss, 32);
    const float rs = rsqrtf(ss * (1.f / 128.f) + 1e-6f) * (1.f - lam_init);
    const float* sw = p.in(24) + j * 128 + 4 * fq;
    GAS bf16_t* op = (GAS bf16_t*)(p.ws() + WS_MIX) + (size_t)(R0 + qrow) * 1024 + h * 128 + 4 * fq;
#pragma unroll
    for (int db = 0; db < 8; ++db) { const f32x4 w4 = *(const f32x4*)(sw + 16 * db); const f32x4 v = o0[db] * rs * w4; u32x2 w; w.x = cvt_pk_bf16(v[0], v[1]); w.y = cvt_pk_bf16(v[2], v[3]); *(GAS u32x2*)(op + 16 * db) = w; }
}
__device__ __forceinline__ void unit_decode(int u, int& s, int& h, int& qb) {
    if (u < 256) { s = 16 + (u >> 6); h = (u >> 3) & 7; qb = u & 7; } else { const int c = u - 256; s = c >> 4; h = (c >> 1) & 7; qb = c & 1; }
}

typedef __attribute__((address_space(1))) unsigned gu32;
#define XB_TMO      128
#define XB_XCNT(j)  (256  + 64 * (j))
#define XB_XSUB(j)  (1280 + 64 * (j))
#define XB_XGEN(j)  (2304 + 64 * (j))
#define XB_TOP      3328
#define XB_TOPGEN   3392
#define XCD_BAR_WORDS 3456
#define XB_SPIN_CAP (1u << 18)

__device__ __forceinline__ unsigned xb_ld(unsigned* p)              { return __hip_atomic_load(p, __ATOMIC_RELAXED, __HIP_MEMORY_SCOPE_AGENT); }
__device__ __forceinline__ unsigned xb_add(unsigned* p, unsigned v) { return __hip_atomic_fetch_add(p, v, __ATOMIC_RELAXED, __HIP_MEMORY_SCOPE_AGENT); }
__device__ __forceinline__ unsigned xb_xcc_id() { return (unsigned)__builtin_amdgcn_s_getreg((3 << 11) | 20) & 0xFu; }
#define XB_SPIN(cond, bar) do { unsigned _sp = 0; while (cond) { __builtin_amdgcn_s_sleep(1); \
    if ((++_sp & 255u) == 0u) { if (xb_ld(&(bar)[XB_TMO])) break; if (_sp > XB_SPIN_CAP) { atomicAdd(&(bar)[XB_TMO], 1u); break; } } } } while (0)

struct XcdBarrier {
    unsigned* bar; unsigned x;
    volatile LAS unsigned* st;
};

__device__ __forceinline__ XcdBarrier xcd_barrier_post(unsigned* bar, volatile LAS unsigned* st) {
    XcdBarrier b; b.bar = bar; b.x = xb_xcc_id(); b.st = st;
    if (threadIdx.x == 0) (void)xb_add(&bar[XB_XCNT(b.x)], 1u);
    return b;
}
__device__ __forceinline__ void xcd_barrier_complete(unsigned* bar, unsigned x, unsigned& nloc, unsigned& nx) {
    const unsigned G = gridDim.x * gridDim.y * gridDim.z;
    unsigned sum, cnt, mine, sp = 0u;
    for (;;) {
        sum = 0u; cnt = 0u; mine = 0u;
#pragma unroll
        for (unsigned j = 0; j < 16; ++j) { const unsigned c = xb_ld(&bar[XB_XCNT(j)]); sum += c; cnt += (c > 0u) ? 1u : 0u; mine = (j == x) ? c : mine; }
        if (sum == G) break;
        __builtin_amdgcn_s_sleep(1);
        if ((++sp & 255u) == 0u) { if (xb_ld(&bar[XB_TMO])) break; if (sp > XB_SPIN_CAP) { atomicAdd(&bar[XB_TMO], 1u); break; } }
    }
    nloc = mine > 0u ? mine : 1u; nx = cnt > 0u ? cnt : 1u;
}

__device__ __forceinline__ void xcd_barrier(const XcdBarrier& b) {
    asm volatile("s_waitcnt vmcnt(0)" ::: "memory");
    __syncthreads();
    if (threadIdx.x == 0) {
        unsigned* bar = b.bar;
        __builtin_amdgcn_s_waitcnt(0);
        unsigned nloc = b.st[0], nx = b.st[1];
        if (nloc == 0u) { xcd_barrier_complete(bar, b.x, nloc, nx); b.st[0] = nloc; b.st[1] = nx; }
        const unsigned old = xb_add(&bar[XB_XSUB(b.x)], 1u);
        const unsigned gen = old / nloc;
        if (old + 1u == (gen + 1u) * nloc) {
            __builtin_amdgcn_fence(__ATOMIC_RELEASE, "agent");
            asm volatile("s_waitcnt vmcnt(0)" ::: "memory");
            const unsigned og = xb_add(&bar[XB_TOP], 1u);
            const unsigned tg = og / nx;
            if (og + 1u == (tg + 1u) * nx) xb_add(&bar[XB_TOPGEN], 1u);
            else XB_SPIN(xb_ld(&bar[XB_TOPGEN]) == tg, bar);
            __builtin_amdgcn_fence(__ATOMIC_ACQUIRE, "agent");
            xb_add(&bar[XB_XGEN(b.x)], 1u);
            asm volatile("s_waitcnt vmcnt(0)" ::: "memory");
        } else {
            XB_SPIN(xb_ld(&bar[XB_XGEN(b.x)]) == gen, bar);
            __builtin_amdgcn_fence(__ATOMIC_ACQUIRE, "agent");
            asm volatile("s_waitcnt vmcnt(0)" ::: "memory");
        }
    }
    __syncthreads();
}

__global__ void __launch_bounds__(512, 2) hybrid_fwd(Params ka) {
    extern __shared__ __attribute__((aligned(16))) unsigned char lds_raw[];
    LAS unsigned char* lds = (LAS unsigned char*)lds_raw;
    cg::grid_group grid = cg::this_grid();
    if (threadIdx.x == 0) {
#pragma unroll
        for (int i = 0; i < 27; ++i) *(LAS unsigned long long*)(lds + PB_OFF + 8 * i) = (unsigned long long)ka.in[i];
        *(LAS unsigned long long*)(lds + PB_OFF + 8 * 27) = (unsigned long long)ka.out; *(LAS unsigned long long*)(lds + PB_OFF + 8 * 28) = (unsigned long long)ka.ws; }
    if (threadIdx.x == 1) { *(LAS unsigned*)(lds + PB_OFF + 256) = 0u; *(LAS unsigned*)(lds + PB_OFF + 260) = 0u; }
    __syncthreads();
    const PB p{lds};
    const XcdBarrier xbar = xcd_barrier_post((unsigned*)(ka.ws + WS_BAR), (volatile LAS unsigned*)(lds + PB_OFF + 256));
    const int ph_hi = ka.ph_hi;
    int rep = 0;
    for (int ph = ka.ph_lo; ph < ph_hi; ) {
        const int G = gridDim.x, bid = blockIdx.x;
        unsigned char* ws = p.ws();
        if (ph == 0) {
#ifndef SK_P0
            phase0(p, lds);
#endif
        }
        else if (ph == 33) { norm_phase(p, 2, 3, 1, (3 * 5) * 6144 + 5 * 1024); }
        else {
            const int li = (ph - 1) >> 3, sub = (ph - 1) & 7, j = li >> 1, odd = li & 1;
            if (sub == 3 && odd) { ++ph; continue; }
            if (sub == 0) { norm_phase(p, li == 0 ? 0 : 1, li, 0, ((li - 1) * 5) * 6144 + 5 * 1024); }
            else if (sub == 5) { norm_phase(p, 1, li, 1, (li * 5) * 6144 + 2 * 1024); }
            else if (sub == 1) {
                pg8::Gemm g{(const bf16_t*)(ws + WS_XN), odd ? (const bf16_t*)(ws + WS_WINO) + (size_t)j * NOD * DM : (const bf16_t*)(ws + WS_WINE) + (size_t)j * NEV * DM, NTOK, odd ? NOD : NEV, DM, DM, 1};
                pg8::StaticOrder S; S.init(NTOK, g.N, G, bid);
                pg8::EpiIn E; E.odd = odd; E.j = j; E.pb = (const LAS unsigned*)(lds + PB_OFF);

#ifndef SK_IN
                pg8::gemm_phase<pg8::EpiIn, pg8::StaticOrder, true, true>(lds, g, S, E);
#endif
                if (li < 3) {
                    const int nun = (NTOK / 256) * (g.N / 256);
                    const bool part = (nun > G && nun < 2 * G);
                    const int first = part ? nun - G : 0, cnt = part ? 2 * G - nun : G;
                    __syncthreads();
                    if (bid >= first) convert_layer_a(p, lds, li + 1, (bid - first) * 8 + __builtin_amdgcn_readfirstlane(tid_l() >> 6), cnt * 8);
                }

            }
            else if (sub == 2) {
#ifndef SK_MIX
                const int vb = (G % 8 == 0) ? (bid & 7) * (G >> 3) + (bid >> 3) : bid;
                if (!odd) {
                    { const bool fast = (G == 256); const int k = vb - 64;
                        const int nh = fast ? (vb >= 192 ? 2 : 1) : (vb < 320 ? (320 - vb + G - 1) / G : 0);
                        for (int q = 0; q < nh; ++q) { int it;
                            if (fast) it = vb < 64 ? 256 + vb : (q == 0 ? k : 192 + (k - 128)); else { const int r = vb + q * G; it = r < 64 ? 256 + r : r - 64; }
#ifdef PROBE_HG2
                            hgrn_chunked_dispatch(p, lds, j, it);
#endif
                            hgrn_chunked_dispatch(p, lds, j, it); }
                        const int nu = fast ? (vb < 64 ? 0 : (k < 64 ? 2 : (k < 128 ? 4 : 2))) : (vb < 512 ? (512 - vb + G - 1) / G : 0);
#ifdef PROBE_SWA2
                        for (int rp_ = 0; rp_ < 2; ++rp_)
#endif
                        for (int q = 0; q < nu; ++q) { int u;
                            if (!fast) u = vb + q * G;
                            else if (k < 64) u = q == 0 ? k : 64 + k;
                            else if (k < 128) u = q == 0 ? 128 + (k - 64) : 256 + (k - 64) * 3 + (q - 1);
                            else u = q == 0 ? 192 + (k - 128) : 256 + 192 + (k - 128);
                            int s, h, qb; unit_decode(u, s, h, qb); swa_unit(p, lds, j, s, h, qb); } }
                } else {
                    for (int u = vb; u < 512; u += G) { int s, h, qb; unit_decode(u, s, h, qb); diff_unit(p, lds, j, s, h, qb); }
                }
#endif
            }
            else if (sub == 3) { hgrn_readout(p, j); }
            else if (sub == 4 || sub == 7) {
                const bool mlp = sub == 7;
                pg8::Gemm g{mlp ? (const bf16_t*)(ws + WS_H) : (const bf16_t*)(ws + WS_MIX),
                            mlp ? (const bf16_t*)(ws + WS_W2) + (size_t)li * DM * FF : (odd ? (const bf16_t*)(ws + WS_WOUTO) : (const bf16_t*)(ws + WS_WOUTE)) + (size_t)j * DM * DM, NTOK, DM, mlp ? FF / 2 : DM / 2, mlp ? FF : DM, 2};
                pg8::StaticOrder S; S.init(NTOK, DM, G, bid, 2);
                pg8::EpiPart E{(bf16_t*)(ws + WS_P0), (bf16_t*)(ws + WS_P1)};

#ifndef SK_RES
                pg8::gemm_phase<pg8::EpiPart, pg8::StaticOrder, true, true>(lds, g, S, E);
#endif

            }
            else {
                pg8::Gemm g{(const bf16_t*)(ws + WS_XN), (const bf16_t*)(ws + WS_W1) + (size_t)li * FF * DM, NTOK, FF, DM, DM, 1};
                pg8::StaticOrder S; S.init(NTOK, FF, G, bid);
                pg8::EpiRelu2 E{(bf16_t*)(ws + WS_H), FF};

#ifndef SK_MLP1
                pg8::gemm_phase<pg8::EpiRelu2, pg8::StaticOrder, true, true>(lds, g, S, E);
#endif

            }
        }
        { const bool again = DUP_MASK != 0 && rep == 0 && ph > 0 && ((DUP_MASK >> (((ph - 1) & 7) + 8 * (((ph - 1) >> 3) & 1))) & 1); rep = again ? 1 : 0; if (!again) ++ph; }
        if (ph < ph_hi) { if (ph_hi > 1000) grid.sync(); else xcd_barrier(xbar); }
    }
}

#ifndef DUP_MASK
#define DUP_MASK 0
#endif
#ifndef MK_PER_PHASE
#define MK_PER_PHASE 0
#endif
extern "C" void kernel_launch(void* const* d_in, const int* in_sizes, int n_in, void* d_out, int out_size, void* d_ws, size_t ws_size, hipStream_t stream) {
    static int grid = 0;
    if (grid == 0) {
        if (n_in != 27 || ws_size < WS_END) { fprintf(stderr, "kernel_launch: unexpected n_in %d / ws_size %zu\n", n_in, ws_size); grid = -1; return; }
        int dev = 0, cus = 0, per_cu = 0;
        hipGetDevice(&dev); hipDeviceGetAttribute(&cus, hipDeviceAttributeMultiprocessorCount, dev);
        if (hipFuncSetAttribute((const void*)hybrid_fwd, hipFuncAttributeMaxDynamicSharedMemorySize, LDS_BYTES) != hipSuccess) { fprintf(stderr, "kernel_launch: hipFuncSetAttribute failed\n"); grid = -1; return; }
        if (hipOccupancyMaxActiveBlocksPerMultiprocessor(&per_cu, (const void*)hybrid_fwd, 512, LDS_BYTES) != hipSuccess || per_cu < 1) { fprintf(stderr, "kernel_launch: occupancy query says %d blocks per CU\n", per_cu); grid = -1; (void)hipGetLastError(); return; }
        grid = cus;
    }
    if (grid < 0) return;
    hipMemsetAsync((char*)d_ws + WS_MODS, 0, 512 * 1024, stream);
    Params p{};
    for (int i = 0; i < 27; ++i) p.in[i] = (const float*)d_in[i];
    p.out = (float*)d_out; p.ws = (unsigned char*)d_ws;
#if MK_PER_PHASE
    for (int ph = 0; ph < 34; ++ph) { p.ph_lo = ph; p.ph_hi = ph + 1; hipLaunchKernelGGL(hybrid_fwd, dim3(grid), dim3(512), LDS_BYTES, stream, p); }
#else
    p.ph_lo = 0; p.ph_hi = 34;
    void* args[] = {&p};
    hipError_t e = hipLaunchCooperativeKernel((const void*)hybrid_fwd, dim3(grid), dim3(512), args, LDS_BYTES, stream);
    if (e != hipSuccess) fprintf(stderr, "cooperative launch failed: %s (grid %d)\n", hipGetErrorString(e), grid);
#endif
}
```

```cpp
#include <hip/hip_runtime.h>
#include <hip/hip_cooperative_groups.h>
#include <cstdio>
#include <cstdint>
namespace cg = cooperative_groups;
#ifndef DUP_MASK
#define DUP_MASK 0
#endif
#define GAS __attribute__((address_space(1)))
#define LDS_BARRIER() do { asm volatile("s_waitcnt lgkmcnt(0)" ::: "memory"); __builtin_amdgcn_s_barrier(); asm volatile("" ::: "memory"); } while (0)
__device__ __forceinline__ int tid_l() { int t = threadIdx.x; asm volatile("" : "+v"(t)); return t; }
namespace pg8 {
#define PG8_LAS __attribute__((address_space(3)))
typedef unsigned short bf16_t;
typedef short bf16x8 __attribute__((ext_vector_type(8)));
typedef float f32x4 __attribute__((ext_vector_type(4)));
typedef unsigned u32x4 __attribute__((ext_vector_type(4)));
constexpr int BM = 256, BK = 64, HALF = 128, HTB = HALF * BK * 2  , STAGE_BYTES = 8 * HTB, NXCD = 8, WGM = 8;

__host__ __device__ __forceinline__ int lds_byte(int r, int c) { const int st = (r >> 4) * 2 + (c >> 5), rr = r & 15, cc = c & 31, ob = rr * 64 + cc * 2; return st * 1024 + (ob ^ (((ob >> 9) & 1) << 5)); }
__host__ __device__ __forceinline__ void stage_rc(int b, int& R, int& C) { const int st = b / 1024, sb = b % 1024, swz = sb ^ (((sb >> 9) & 1) << 5); R = (st >> 1) * 16 + swz / 64; C = (st & 1) * 32 + (swz % 64) / 2; }
__host__ __device__ __forceinline__ int perm32(int rho) { const int n = rho >> 4, i = rho & 15; return 8 * (i >> 2) + 4 * n + (i & 3); }

struct Unit { int pm, pn, ks; };
struct Gemm { const bf16_t* A; const bf16_t* Bt; int M, N, K, ld, KS; };

struct StaticOrder {
    int nM, nN, nwg, G, c, nNr;
    __host__ __device__ void init(int M, int N, int G_, int c_, int KS = 1) { nM = M / BM; nNr = N / BM; nN = nNr * KS; nwg = nM * nN; G = G_; c = c_; }
    __host__ __device__ bool next(int i, Unit& u) const {
        const long L = (long)i * G + c; if (L >= nwg) return false;
        int wgid = (int)L; { const int q = nwg / NXCD, r = nwg % NXCD, xcd = wgid % NXCD, off = wgid / NXCD; wgid = (xcd < r ? xcd * (q + 1) : r * (q + 1) + (xcd - r) * q) + off; }
        const int nig = WGM * nN, gid = wgid / nig, fm = gid * WGM, gsz = (nM - fm) < WGM ? (nM - fm) : WGM;
        u.pm = fm + ((wgid % nig) % gsz); { const int pq = (wgid % nig) / gsz; u.pn = pq % nNr; u.ks = pq / nNr; } return true;
    }
    __device__ __forceinline__ void a_ready(const Unit&) const {}
    __device__ __forceinline__ void done(const Unit&) const {}
};

__device__ __forceinline__ unsigned cvt_pk_bf16(float lo, float hi) { unsigned r; asm volatile("v_cvt_pk_bf16_f32 %0, %1, %2" : "=v"(r) : "v"(lo), "v"(hi)); return r; }
typedef float f32x2 __attribute__((ext_vector_type(2)));
typedef unsigned u32x2 __attribute__((ext_vector_type(2)));

#define LDSP __attribute__((address_space(3)))
__device__ __forceinline__ unsigned long long ldq(const unsigned LDSP* pb, int i) { const unsigned lo = __builtin_amdgcn_readfirstlane(pb[2 * i]), hi = __builtin_amdgcn_readfirstlane(pb[2 * i + 1]); return ((unsigned long long)hi << 32) | lo; }
__device__ __forceinline__ float dpp_x1(float x) { return __builtin_bit_cast(float, __builtin_amdgcn_update_dpp(0, __builtin_bit_cast(int, x), 0xB1, 0xf, 0xf, true)); }
__device__ __forceinline__ float dpp_x2(float x) { return __builtin_bit_cast(float, __builtin_amdgcn_update_dpp(0, __builtin_bit_cast(int, x), 0x4E, 0xf, 0xf, true)); }
__device__ __forceinline__ void quad_transpose(float& v0, float& v1, float& v2, float& v3, int a) {
    { const bool hi = a & 1; const float r0 = dpp_x1(hi ? v0 : v1), r1 = dpp_x1(hi ? v2 : v3); if (hi) { v0 = r0; v2 = r1; } else { v1 = r0; v3 = r1; } }
    { const bool hi = a & 2; const float r0 = dpp_x2(hi ? v0 : v2), r1 = dpp_x2(hi ? v1 : v3); if (hi) { v0 = r0; v1 = r1; } else { v2 = r0; v3 = r1; } }
}
struct EpiRelu2 {
    static constexpr bool PERM = true, AFTER_DRAIN = false;
    bf16_t* O; int ldc;
    __device__ __forceinline__ void operator()(const f32x4 (&acc)[2][2][4][2], const Unit& u, int wr, int wc, int fr, int fq) const {
        const int row0 = u.pm * BM + wr * 64 + fr; const int col0 = u.pn * BM + wc * 32 + 8 * fq;
#pragma unroll
        for (int ai = 0; ai < 2; ++ai)
#pragma unroll
            for (int m = 0; m < 4; ++m) { bf16_t* rowp = O + (size_t)(row0 + ai * HALF + m * 16) * ldc + col0;
#pragma unroll
                for (int bj = 0; bj < 2; ++bj) { f32x4 v0 = acc[ai][bj][m][0], v1 = acc[ai][bj][m][1];
#pragma unroll
                    for (int i = 0; i < 4; ++i) { float a = fmaxf(v0[i], 0.f), b = fmaxf(v1[i], 0.f); v0[i] = a * a; v1[i] = b * b; }
                    u32x4 w; w.x = cvt_pk_bf16(v0[0], v0[1]); w.y = cvt_pk_bf16(v0[2], v0[3]); w.z = cvt_pk_bf16(v1[0], v1[1]); w.w = cvt_pk_bf16(v1[2], v1[3]);
                    *(u32x4*)(rowp + bj * HALF) = w; } }
    }
};
struct EpiPart {
    static constexpr bool PERM = true, AFTER_DRAIN = false;
    bf16_t* P0; bf16_t* P1;
    __device__ __forceinline__ void operator()(const f32x4 (&acc)[2][2][4][2], const Unit& u, int wr, int wc, int fr, int fq) const {
        bf16_t* P = u.ks ? P1 : P0;
        const int col0 = u.pn * BM + wc * 32 + 8 * fq;
#pragma unroll
        for (int ai = 0; ai < 2; ++ai)
#pragma unroll
            for (int m = 0; m < 4; ++m) { bf16_t* rowp = P + (size_t)(u.pm * BM + ai * HALF + wr * 64 + m * 16 + fr) * 1024 + col0;
#pragma unroll
                for (int bj = 0; bj < 2; ++bj) { const f32x4 v0 = acc[ai][bj][m][0], v1 = acc[ai][bj][m][1];
                    u32x4 w; w.x = cvt_pk_bf16(v0[0], v0[1]); w.y = cvt_pk_bf16(v0[2], v0[3]); w.z = cvt_pk_bf16(v1[0], v1[1]); w.w = cvt_pk_bf16(v1[2], v1[3]);
                    *(u32x4*)(rowp + bj * HALF) = w; } }
    }
};
struct EpiIn {
    static constexpr bool PERM = false, AFTER_DRAIN = false;
    int odd, j; const unsigned LDSP* pb;
    __device__ __forceinline__ void operator()(const f32x4 (&acc)[2][2][4][2], const Unit& u, int wr, int wc, int fr, int fq) const {
        unsigned char* ws = (unsigned char*)ldq(pb, 28); float* outp = (float*)ldq(pb, 27);
        bf16_t* proj = (bf16_t*)(ws + 150u * 1048576u); const int ldp = odd ? 3072 : 768; float* hg = (float*)(ws + 198u * 1048576u);
        const float* lbs = (const float*)(ws + 524288) + j * 1024; const float* rope = (const float*)(ws + 524288) + 4096;
        const float* qnw = (const float*)ldq(pb, odd ? 21 : 16) + j * 64; const float* knw = (const float*)ldq(pb, odd ? 22 : 17) + j * 64;
        float* outk = outp + (odd ? 14680064 : 8388608); float* outv = outp + (odd ? 23068672 : 9437184);
        const int unit = u.pn * 4 + wc;
        int type;
        if (!odd) type = unit < 8 ? 0 : unit < 24 ? 1 : unit < 40 ? 2 : unit < 48 ? 3 : unit < 50 ? 4 : 5;
        else type = unit < 16 ? 3 : unit < 32 ? 4 : 5;
        const int pu = odd ? unit : unit - 40;
        const bool lat = u.pm >= 16;
        f32x4 w4[2][2];
        if (type == 3 || type == 4) { const float* nw = (type == 3) ? qnw : knw;
#pragma unroll
            for (int bj = 0; bj < 2; ++bj)
#pragma unroll
                for (int n = 0; n < 2; ++n) w4[bj][n] = *(const f32x4*)(nw + 32 * bj + 16 * n + 4 * fq); }
        else if (type == 1) { const float* lb = lbs + ((unit - 8) >> 3) * 512 + ((unit - 8) & 7) * 64;
#pragma unroll
            for (int bj = 0; bj < 2; ++bj)
#pragma unroll
                for (int n = 0; n < 2; ++n) w4[bj][n] = *(const f32x4*)(lb + 32 * bj + 16 * n + 4 * fq); }
        else {
#pragma unroll
            for (int bj = 0; bj < 2; ++bj)
#pragma unroll
                for (int n = 0; n < 2; ++n) w4[bj][n] = (f32x4){0.f, 0.f, 0.f, 0.f}; }
#pragma unroll
        for (int ai = 0; ai < 2; ++ai)
#pragma unroll
            for (int m = 0; m < 4; ++m) {
                const int row = u.pm * BM + ai * HALF + wr * 64 + m * 16 + fr;
                f32x4 v[2][2];
#pragma unroll
                for (int bj = 0; bj < 2; ++bj)
#pragma unroll
                    for (int n = 0; n < 2; ++n) v[bj][n] = acc[ai][bj][m][n];
                if (type <= 2) {
                    float* hp = hg + (size_t)row * 2560 + unit * 64 + 4 * fq;
#pragma unroll
                    for (int bj = 0; bj < 2; ++bj)
#pragma unroll
                        for (int n = 0; n < 2; ++n) { f32x4 xv = v[bj][n];
                            if (type == 0) {
#pragma unroll
                                for (int i = 0; i < 4; ++i) xv[i] = xv[i] * __builtin_amdgcn_rcpf(1.f + __expf(-xv[i])) * 0.08838834764831845f; }
                            else if (type == 1) {
#pragma unroll
                                for (int i = 0; i < 4; ++i) { const float sg = __builtin_amdgcn_rcpf(1.f + __expf(-xv[i])); const float lb = w4[bj][n][i]; xv[i] = lb + (1.f - lb) * sg; } }
                            *(f32x4*)(hp + 32 * bj + 16 * n) = xv; }
                } else {
                    if (type != 5) {
                        float ss = 0.f;
#pragma unroll
                        for (int bj = 0; bj < 2; ++bj)
#pragma unroll
                            for (int n = 0; n < 2; ++n) { const f32x4 xv = v[bj][n]; ss += (xv[0] * xv[0] + xv[1] * xv[1]) + (xv[2] * xv[2] + xv[3] * xv[3]); }
                        ss += __shfl_xor(ss, 16); ss += __shfl_xor(ss, 32);
                        const float rs = rsqrtf(ss * (1.f / 64.f) + 1e-6f);
#pragma unroll
                        for (int bj = 0; bj < 2; ++bj)
#pragma unroll
                            for (int n = 0; n < 2; ++n) v[bj][n] = v[bj][n] * rs * w4[bj][n];
                    }
                    if (!lat && type >= 4) {
                        float* ob = (type == 4) ? outk : outv;
                        const int b = row >> 8, t = row & 255;
                        size_t off;
                        if (!odd) off = ((size_t)(b * 2 + j) * 256 + t) * 128 + (size_t)(unit - (type == 4 ? 48 : 50)) * 64;
                        else off = ((size_t)(b * 2 + j) * 256 + t) * 1024 + (size_t)(unit - (type == 4 ? 16 : 32)) * 64;
#pragma unroll
                        for (int bj = 0; bj < 2; ++bj)
#pragma unroll
                            for (int n = 0; n < 2; ++n) *(f32x4*)(ob + off + 32 * bj + 16 * n + 4 * fq) = v[bj][n];
                    }
                    if (lat && type != 5) {
                        const int t = (row - 4096) & 1023; const int rp = t >> 6, cp = t & 63;
#pragma unroll
                        for (int bj = 0; bj < 2; ++bj)
#pragma unroll
                            for (int n = 0; n < 2; ++n) { const f32x4 cs = *(const f32x4*)(rope + ((bj ? cp : rp) * 16 + 8 * n + 2 * fq) * 2);
                                const f32x4 xv = v[bj][n]; f32x4 o;
                                o[0] = xv[0] * cs[0] - xv[1] * cs[1]; o[1] = xv[0] * cs[1] + xv[1] * cs[0];
                                o[2] = xv[2] * cs[2] - xv[3] * cs[3]; o[3] = xv[2] * cs[3] + xv[3] * cs[2]; v[bj][n] = o; }
                    }
                    if (type == 5) {
                        const int t = lat ? ((row - 4096) & 1023) : (row & 255); const int L = lat ? 1024 : 256; const int C = odd ? 1024 : 128;
                        const int a = fr & 3;
                        unsigned short* vp = (unsigned short*)(ws + 310u * 1048576u) + (size_t)C * (row - t) + (size_t)((unit - (odd ? 32 : 50)) * 64 + 4 * fq + a) * L + (t - a);
#pragma unroll
                        for (int bj = 0; bj < 2; ++bj)
#pragma unroll
                            for (int n = 0; n < 2; ++n) { float x0 = v[bj][n][0], x1 = v[bj][n][1], x2 = v[bj][n][2], x3 = v[bj][n][3];
                                quad_transpose(x0, x1, x2, x3, a);
                                u32x2 w; w.x = cvt_pk_bf16(x0, x1); w.y = cvt_pk_bf16(x2, x3);
                                *(u32x2*)(vp + (size_t)(32 * bj + 16 * n) * L) = w; }
                    } else {
                    bf16_t* pp = proj + (size_t)row * ldp + pu * 64 + 4 * fq;
#pragma unroll
                    for (int bj = 0; bj < 2; ++bj)
#pragma unroll
                        for (int n = 0; n < 2; ++n) { u32x2 w; w.x = cvt_pk_bf16(v[bj][n][0], v[bj][n][1]); w.y = cvt_pk_bf16(v[bj][n][2], v[bj][n][3]); *(u32x2*)(pp + 32 * bj + 16 * n) = w; }
                    }
                }
            }
    }
};

template <class Epi, class Sched, bool ALIGN_EPI = false, bool SP2 = false>
__device__ __forceinline__ void gemm_phase(PG8_LAS unsigned char* lds, const Gemm g, const Sched& S, const Epi& E) {
    const int tid = tid_l(), wid = __builtin_amdgcn_readfirstlane(tid >> 6), lane = tid & 63, wr = wid >> 2, wc = wid & 3, fr = lane & 15, fq = lane >> 4;
    const int K = g.ld, nt = g.K / BK;
    unsigned voffA[2], voffB[2];
#pragma unroll
    for (int i = 0; i < 2; ++i) { int R, C; stage_rc(tid * 16 + i * 8192, R, C); const int Rb = Epi::PERM ? ((R & ~31) + perm32(R & 31)) : R;
        voffA[i] = (unsigned)(R * K + C) * 2u; voffB[i] = (unsigned)(Rb * K + C) * 2u; }
    const size_t kstep = (size_t)(BK * 2);
    const size_t hstep = (size_t)HALF * K * 2;
    const size_t tstep = 2 * hstep;
    const unsigned ldsw = (unsigned)wid * 1024u;
    const int aoff = lds_byte(wr * 64 + fr, fq * 8), boff = lds_byte(wc * 32 + fr, fq * 8);
#define PG8_SA(b, h) (((b) * 2 + (h)) * HTB)
#define PG8_SB(b, h) ((4 + (b) * 2 + (h)) * HTB)
#define PG8_STAGE(bufoff, gbase, voff) do { _Pragma("unroll") for (int _i = 0; _i < 2; ++_i) \
        __builtin_amdgcn_global_load_lds((const unsigned*)((const char*)(gbase) + (voff)[_i]), (PG8_LAS unsigned*)(lds + (bufoff) + ldsw + _i * 8192), 16, 0, 0); } while (0)
#define PG8_LDA(dst, b, h) do { _Pragma("unroll") for (int m = 0; m < 4; ++m) _Pragma("unroll") for (int k = 0; k < 2; ++k) dst[m][k] = *(const PG8_LAS bf16x8*)(lds + PG8_SA(b, h) + aoff + m * 2048 + k * 1024); } while (0)
#define PG8_LDB(dst, b, h) do { _Pragma("unroll") for (int n = 0; n < 2; ++n) _Pragma("unroll") for (int k = 0; k < 2; ++k) dst[n][k] = *(const PG8_LAS bf16x8*)(lds + PG8_SB(b, h) + boff + n * 2048 + k * 1024); } while (0)
#define PG8_MMA(ai, bj, At, Bt) do { __builtin_amdgcn_s_setprio(1); _Pragma("unroll") for (int m = 0; m < 4; ++m) _Pragma("unroll") for (int n = 0; n < 2; ++n) _Pragma("unroll") for (int k = 0; k < 2; ++k) \
        acc[ai][bj][m][n] = __builtin_amdgcn_mfma_f32_16x16x32_bf16(Bt[n][k], At[m][k], acc[ai][bj][m][n], 0, 0, 0); __builtin_amdgcn_s_setprio(0); } while (0)
#define PG8_WAIT_V(n) asm volatile("s_waitcnt vmcnt(" #n ")" ::: "memory")
#define PG8_WAIT_L(n) asm volatile("s_waitcnt lgkmcnt(" #n ")" ::: "memory")
#define PG8_BAR __builtin_amdgcn_s_barrier()
#define PG8_SCHED __builtin_amdgcn_sched_barrier(0)
    Unit cur, nxt; int ui = 0;
    if (!S.next(0, cur)) return;
    f32x4 acc[2][2][4][2];
#pragma unroll
    for (int a = 0; a < 2; ++a)
#pragma unroll
        for (int b = 0; b < 2; ++b)
#pragma unroll
            for (int m = 0; m < 4; ++m)
#pragma unroll
                for (int n = 0; n < 2; ++n) acc[a][b][m][n] = (f32x4){0.f, 0.f, 0.f, 0.f};
    bf16x8 At[4][2], B0[2][2], B1[2][2];
    const char* cA = (const char*)g.A + (size_t)cur.pm * tstep + (size_t)cur.ks * g.K * 2; const char* cB = (const char*)g.Bt + (size_t)cur.pn * tstep + (size_t)cur.ks * g.K * 2;
    S.a_ready(cur);
    if constexpr (SP2) {
        PG8_STAGE(PG8_SB(0, 0), cB, voffB); PG8_STAGE(PG8_SB(0, 1), cB + hstep, voffB); PG8_STAGE(PG8_SA(0, 0), cA, voffA); PG8_STAGE(PG8_SA(0, 1), cA + hstep, voffA);
        if (wr == 1) PG8_BAR;
        PG8_WAIT_V(2); PG8_BAR;
        PG8_STAGE(PG8_SB(1, 0), cB + kstep, voffB); PG8_STAGE(PG8_SA(1, 0), cA + kstep, voffA); PG8_STAGE(PG8_SB(1, 1), cB + hstep + kstep, voffB);
        PG8_WAIT_V(6); PG8_BAR;
    } else {
        PG8_STAGE(PG8_SB(0, 0), cB, voffB); PG8_STAGE(PG8_SA(0, 0), cA, voffA); PG8_STAGE(PG8_SB(0, 1), cB + hstep, voffB); PG8_STAGE(PG8_SA(0, 1), cA + hstep, voffA);
        if (wr == 1) PG8_BAR;
        PG8_WAIT_V(4); PG8_BAR;
        PG8_STAGE(PG8_SB(1, 0), cB + kstep, voffB); PG8_STAGE(PG8_SA(1, 0), cA + kstep, voffA); PG8_STAGE(PG8_SB(1, 1), cB + hstep + kstep, voffB);
        PG8_WAIT_V(6); PG8_BAR;
    }
    for (;;) {
        const bool has_next = S.next(ui + 1, nxt);
        const char* nA = has_next ? (const char*)g.A + (size_t)nxt.pm * tstep + (size_t)nxt.ks * g.K * 2 : cA; const char* nB = has_next ? (const char*)g.Bt + (size_t)nxt.pn * tstep + (size_t)nxt.ks * g.K * 2 : cB;
        for (int t = 0; t < nt; t += 2) {
            const bool last = (t == nt - 2);
            const char* a1 = cA + (size_t)(t + 1) * kstep;
            const char* a2 = last ? nA : cA + (size_t)(t + 2) * kstep; const char* b2 = last ? nB : cB + (size_t)(t + 2) * kstep;
            const char* a3 = a2 + kstep; const char* b3 = b2 + kstep;
            if (last && has_next) S.a_ready(nxt);
            if constexpr (SP2) {
            PG8_LDB(B0, 0, 0); PG8_LDB(B1, 0, 1); PG8_SCHED; PG8_LDA(At, 0, 0); PG8_STAGE(PG8_SA(1, 1), a1 + hstep, voffA);
            PG8_WAIT_V(8); PG8_WAIT_L(0); PG8_BAR; PG8_MMA(0, 0, At, B0); PG8_MMA(0, 1, At, B1); PG8_BAR; PG8_SCHED;
            PG8_LDA(At, 0, 1); PG8_STAGE(PG8_SB(0, 0), b2, voffB); PG8_STAGE(PG8_SB(0, 1), b2 + hstep, voffB); PG8_STAGE(PG8_SA(0, 0), a2, voffA);
            PG8_WAIT_V(8); PG8_WAIT_L(0); PG8_BAR; PG8_MMA(1, 0, At, B0); PG8_MMA(1, 1, At, B1); PG8_BAR; PG8_SCHED;
            PG8_LDB(B0, 1, 0); PG8_LDB(B1, 1, 1); PG8_SCHED; PG8_LDA(At, 1, 0); PG8_STAGE(PG8_SA(0, 1), a2 + hstep, voffA);
            PG8_WAIT_V(8); PG8_WAIT_L(0); PG8_BAR; PG8_MMA(0, 0, At, B0); PG8_MMA(0, 1, At, B1); PG8_BAR; PG8_SCHED;
            PG8_LDA(At, 1, 1); PG8_STAGE(PG8_SB(1, 0), b3, voffB); PG8_STAGE(PG8_SB(1, 1), b3 + hstep, voffB); PG8_STAGE(PG8_SA(1, 0), a3, voffA);
            PG8_WAIT_V(8); PG8_WAIT_L(0); PG8_BAR; PG8_MMA(1, 0, At, B0); PG8_MMA(1, 1, At, B1); PG8_BAR; PG8_SCHED;
            } else {
            PG8_LDB(B0, 0, 0); PG8_SCHED; PG8_LDA(At, 0, 0); PG8_STAGE(PG8_SA(1, 1), a1 + hstep, voffA);
            PG8_WAIT_L(8); PG8_BAR; PG8_WAIT_L(0); PG8_MMA(0, 0, At, B0); PG8_BAR; PG8_SCHED;
            PG8_LDB(B1, 0, 1); PG8_STAGE(PG8_SB(0, 0), b2, voffB);
            PG8_BAR; PG8_WAIT_L(0); PG8_MMA(0, 1, At, B1); PG8_BAR;
            PG8_LDA(At, 0, 1); PG8_STAGE(PG8_SA(0, 0), a2, voffA);
            PG8_BAR; PG8_WAIT_L(0); PG8_MMA(1, 0, At, B0); PG8_BAR; PG8_SCHED;
            PG8_STAGE(PG8_SB(0, 1), b2 + hstep, voffB);
            PG8_WAIT_V(6); PG8_BAR; PG8_MMA(1, 1, At, B1); PG8_BAR;
            PG8_LDB(B0, 1, 0); PG8_SCHED; PG8_LDA(At, 1, 0); PG8_STAGE(PG8_SA(0, 1), a2 + hstep, voffA);
            PG8_WAIT_L(8); PG8_BAR; PG8_WAIT_L(0); PG8_MMA(0, 0, At, B0); PG8_BAR; PG8_SCHED;
            PG8_LDB(B1, 1, 1); PG8_STAGE(PG8_SB(1, 0), b3, voffB);
            PG8_BAR; PG8_WAIT_L(0); PG8_MMA(0, 1, At, B1); PG8_BAR;
            PG8_LDA(At, 1, 1); PG8_STAGE(PG8_SA(1, 0), a3, voffA);
            PG8_BAR; PG8_WAIT_L(0); PG8_MMA(1, 0, At, B0); PG8_BAR; PG8_SCHED;
            PG8_STAGE(PG8_SB(1, 1), b3 + hstep, voffB);
            PG8_WAIT_V(6); PG8_BAR; PG8_MMA(1, 1, At, B1); PG8_BAR;
            }
        }
        if constexpr (ALIGN_EPI) { if (wr == 0) PG8_BAR; }
        if constexpr (!Epi::AFTER_DRAIN) { E(acc, cur, wr, wc, fr, fq); S.done(cur); }
        if (!has_next) break;
#pragma unroll
        for (int a = 0; a < 2; ++a)
#pragma unroll
            for (int b = 0; b < 2; ++b)
#pragma unroll
                for (int m = 0; m < 4; ++m)
#pragma unroll
                    for (int n = 0; n < 2; ++n) acc[a][b][m][n] = (f32x4){0.f, 0.f, 0.f, 0.f};
        cur = nxt; cA = nA; cB = nB; ++ui;
        if constexpr (ALIGN_EPI) { if (wr == 1) PG8_BAR; }
    }
    PG8_WAIT_V(0);
    if constexpr (!ALIGN_EPI) { if (wr == 0) PG8_BAR; }
    PG8_BAR;
    if constexpr (Epi::AFTER_DRAIN) { E.fused(acc, cur, wr, wc, fr, fq, lds, wid, lane); S.done(cur); }
#undef PG8_SA
#undef PG8_SB
#undef PG8_STAGE
#undef PG8_LDA
#undef PG8_LDB
#undef PG8_MMA
#undef PG8_WAIT_V
#undef PG8_WAIT_L
#undef PG8_BAR
#undef PG8_SCHED
}
}
#define LAS __attribute__((address_space(3)))
typedef unsigned short bf16_t;
typedef short bf16x8 __attribute__((ext_vector_type(8)));
typedef float f32x4 __attribute__((ext_vector_type(4)));
typedef float f32x2 __attribute__((ext_vector_type(2)));
typedef unsigned u32x4 __attribute__((ext_vector_type(4)));
typedef unsigned u32x2 __attribute__((ext_vector_type(2)));
using pg8::cvt_pk_bf16;

constexpr int NTOK = 8192, DM = 1024, NEV = 3328, NOD = 3072, FF = 4096;
constexpr int LDS_BYTES = 147456;
constexpr size_t MiB = 1u << 20;
constexpr size_t WS_MODS = 0;
constexpr size_t WS_BAR = 492 * 1024;
constexpr size_t WS_TAB = 512 * 1024;
constexpr size_t WS_WINE = 2 * MiB, WS_WOUTE = 16 * MiB, WS_WINO = 20 * MiB, WS_WOUTO = 32 * MiB, WS_W1 = 36 * MiB, WS_W2 = 68 * MiB;
constexpr size_t WS_XN = 100 * MiB, WS_MIX = 116 * MiB;
constexpr size_t WS_CKS = 132 * MiB, WS_CVS = 133 * MiB, WS_CKD = 134 * MiB, WS_CVD = 142 * MiB;
constexpr size_t WS_P0 = 150 * MiB, WS_P1 = 278 * MiB;
constexpr size_t WS_PROJ = 150 * MiB, WS_HG = 198 * MiB, WS_OF = 278 * MiB, WS_OB = 294 * MiB, WS_H = 198 * MiB, WS_VT = 310 * MiB, WS_END = 326 * MiB;
constexpr size_t OUT_KS = 8388608, OUT_VS = 9437184, OUT_ST = 10485760, OUT_KD = 14680064, OUT_VD = 23068672;

struct Params { const float* in[27]; float* out; unsigned char* ws; int ph_lo, ph_hi; };
constexpr int PB_OFF = 143360;
struct PB {
    LAS unsigned char* l;
    __device__ __forceinline__ unsigned long long q(int i) const { const LAS unsigned* w = (const LAS unsigned*)(l + PB_OFF) + 2 * i; const unsigned lo = __builtin_amdgcn_readfirstlane(w[0]), hi = __builtin_amdgcn_readfirstlane(w[1]); return ((unsigned long long)hi << 32) | lo; }
    __device__ __forceinline__ const float* in(int i) const { return (const float*)q(i); }
    __device__ __forceinline__ float* out() const { return (float*)q(27); }
    __device__ __forceinline__ unsigned char* ws() const { return (unsigned char*)q(28); }
};

__device__ __forceinline__ float wave_sum(float v) {
#pragma unroll
    for (int o = 1; o < 64; o <<= 1) v += __shfl_xor(v, o);
    return v;
}

__device__ __forceinline__ void p0_transpose_item(const float* W, int K, int N, bf16_t* WT, bool hperm, LAS float* scr, int item, int lane) {
    const int nblk = N / 64, kb = item / nblk, nb = item % nblk, k0 = 64 * kb, n0 = 64 * nb;
    const float* wp = W + (size_t)(k0 + (lane >> 4)) * N + n0 + (lane & 15) * 4;
    f32x4 t4[16];
#pragma unroll
    for (int i = 0; i < 16; ++i) t4[i] = __builtin_nontemporal_load((const f32x4*)(wp + (size_t)(4 * i) * N));
#pragma unroll
    for (int i = 0; i < 16; ++i) { LAS float* d = scr + (4 * i + (lane >> 4)) * 65 + (lane & 15) * 4; d[0] = t4[i][0]; d[1] = t4[i][1]; d[2] = t4[i][2]; d[3] = t4[i][3]; }
    asm volatile("s_waitcnt lgkmcnt(0)" ::: "memory");
    const int c = lane & 7;
#pragma unroll
    for (int jj = 0; jj < 8; ++jj) { const int n = (lane >> 3) + 8 * jj; const LAS float* s = scr + (8 * c) * 65 + n;
        u32x4 o; o.x = cvt_pk_bf16(s[0 * 65], s[1 * 65]); o.y = cvt_pk_bf16(s[2 * 65], s[3 * 65]); o.z = cvt_pk_bf16(s[4 * 65], s[5 * 65]); o.w = cvt_pk_bf16(s[6 * 65], s[7 * 65]);
        const int col = n0 + n; int drow = col;
        if (hperm) { const int cc = col & 255; drow = (col & ~255) + ((cc >> 5) & 1) * 128 + (cc >> 6) * 32 + (cc & 31); }
        *(u32x4*)(WT + (size_t)drow * K + k0 + 8 * c) = o; }
    asm volatile("s_waitcnt lgkmcnt(0)" ::: "memory");
}

__device__ __forceinline__ void convert_layer_a(const PB p, LAS unsigned char* lds, int L, int rank, int nw, int LW2) {
    const int tid = tid_l(), lane = tid & 63, wave = __builtin_amdgcn_readfirstlane(tid >> 6);
    unsigned char* ws = p.ws();
    LAS float* scr = (LAS float*)(lds + wave * 16640);
    const int odd = L & 1, j = L >> 1;
    const int I_IN = L < 0 ? 0 : (odd ? 16 * (NOD / 64) : 16 * (NEV / 64)), I_SQ = L < 0 ? 0 : 256, I_W = L < 0 ? 0 : 1024;
    const int nitems = I_IN + I_SQ + I_W + (LW2 >= 0 ? 1024 : 0);
    for (int it = rank; it < nitems; it += nw) {
        int r = it, jj, K = DM, N = DM, srci; size_t dof; bool hp = false;
        if (r >= I_IN + I_SQ + I_W) { r -= I_IN + I_SQ + I_W; srci = 26; K = FF; jj = LW2; dof = WS_W2 + (size_t)LW2 * DM * FF * 2; }
        else if (r < I_IN) { srci = odd ? 19 : 12; N = odd ? NOD : NEV; hp = true; jj = j; dof = (odd ? WS_WINO : WS_WINE) + (size_t)j * N * DM * 2; }
        else if ((r -= I_IN) < I_SQ) { srci = odd ? 20 : 13; jj = j; dof = (odd ? WS_WOUTO : WS_WOUTE) + (size_t)j * DM * DM * 2; }
        else { r -= I_SQ; srci = 25; N = FF; jj = L; dof = WS_W1 + (size_t)L * FF * DM * 2; }
        p0_transpose_item(p.in(srci) + (size_t)jj * K * N, K, N, (bf16_t*)(ws + dof), hp, scr, r, lane);
    }
}
__device__ __forceinline__ void phase0(const PB p, LAS unsigned char* lds) {
    const int tid = tid_l(), lane = tid & 63, wave = __builtin_amdgcn_readfirstlane(tid >> 6);
    const int G = gridDim.x, bid = blockIdx.x;
    unsigned char* ws = p.ws();
    {
        LAS float* scr = (LAS float*)(lds + wave * 16640);
        const int gw = bid * 8 + wave, NGW = G * 8;
        constexpr int I_INE = 16 * (NEV / 64), I_SQ = 16 * 16, I_INO = 16 * (NOD / 64), I_W1 = 16 * (FF / 64), I_W2 = 64 * 16;
        constexpr int I_CVD = 8 * 16, I_CVS = 8 * 2;
        constexpr int NITEMS = I_INE + I_SQ + I_W1 + 1 * I_W2 + 8 * I_CVD + 8 * I_CVS;
        for (int it = gw; it < NITEMS; it += NGW) {
            int r = it, jj = 0, K = DM, N = DM, srci = 26; size_t dof; bool hp = false;
            if (r < I_INE) { srci = 12; N = NEV; hp = true; dof = WS_WINE; }
            else if ((r -= I_INE) < I_SQ) { srci = 13; dof = WS_WOUTE; }
            else if ((r -= I_SQ) < I_W1) { srci = 25; N = FF; dof = WS_W1; }
            else if ((r -= I_W1) < 1 * I_W2) { srci = 26; K = FF; dof = WS_W2; }
            else if ((r -= 1 * I_W2) < 8 * I_CVD) { jj = r / I_CVD; r -= jj * I_CVD; srci = 6; K = 512; N = 1024; dof = WS_CVD + (size_t)jj * 1024 * 512 * 2; }
            else { r -= 8 * I_CVD; jj = r / I_CVS; r -= jj * I_CVS; srci = 3; K = 512; N = 128; dof = WS_CVS + (size_t)jj * 128 * 512 * 2; }
            p0_transpose_item(p.in(srci) + (size_t)jj * K * N, K, N, (bf16_t*)(ws + dof), hp, scr, r, lane);
        }
    }
    {
        float* mods = (float*)(ws + WS_MODS);
        LAS float* s = (LAS float*)lds; LAS float* red = (LAS float*)(lds + 20480);
        for (int u = bid; u < 192; u += G) {
            const int li = u / 48, nc = u % 48;
            __syncthreads();
            for (int e = tid; e < 5120; e += 512) { const int cnd = e >> 10, k = e & 1023; const float cv = (cnd == 0) ? p.in(8)[k] : p.in(7)[(cnd - 1) * 1024 + k]; s[e] = cv / (1.f + __expf(-cv)); }
            __syncthreads();
            const int kg = tid >> 7, col = tid & 127, n = nc * 128 + col;
            const float* w = p.in(10) + ((size_t)li * 1024 + kg * 256) * 6144 + n;
            const LAS float* sk = s + kg * 256;
            float a0 = 0.f, a1 = 0.f, a2 = 0.f, a3 = 0.f, a4 = 0.f;
#pragma unroll 8
            for (int k = 0; k < 256; ++k) { const float wv = w[(size_t)k * 6144]; a0 += sk[k] * wv; a1 += sk[1024 + k] * wv; a2 += sk[2048 + k] * wv; a3 += sk[3072 + k] * wv; a4 += sk[4096 + k] * wv; }
            red[(kg * 5 + 0) * 128 + col] = a0; red[(kg * 5 + 1) * 128 + col] = a1; red[(kg * 5 + 2) * 128 + col] = a2; red[(kg * 5 + 3) * 128 + col] = a3; red[(kg * 5 + 4) * 128 + col] = a4;
            __syncthreads();
            for (int e = tid; e < 640; e += 512) { const int c = e >> 7, cl = e & 127;
                const float sum = ((red[(0 * 5 + c) * 128 + cl] + red[(1 * 5 + c) * 128 + cl]) + red[(2 * 5 + c) * 128 + cl]) + red[(3 * 5 + c) * 128 + cl];
                mods[(size_t)(li * 5 + c) * 6144 + nc * 128 + cl] = sum + p.in(11)[li * 6144 + nc * 128 + cl]; }
        }
    }
    if (bid == G - 1) {
        float* tab = (float*)(ws + WS_TAB);
        for (int e = tid; e < 1024; e += 512) { const float l0 = p.in(14)[e], l1 = p.in(14)[1024 + e]; tab[e] = 0.f; tab[1024 + e] = 1.f / (1.f + __expf(l0 - l1)); }
        if (tid < 2) { const int jj = tid; const float* lp = p.in(23) + jj * 256; float d1 = 0.f, d2 = 0.f;
            for (int i = 0; i < 64; ++i) { d1 += lp[i] * lp[64 + i]; d2 += lp[128 + i] * lp[192 + i]; }
            const float li_ = (float)(2 * jj + 1); const float lam_init = 0.8f - 0.6f * expf(-0.3f * li_);
            tab[2048 + jj] = expf(d1) - expf(d2) + lam_init; tab[2050 + jj] = lam_init; }
        for (int e = tid; e < 1024; e += 512) { const int pos = e >> 4, f = e & 15;
            const float inv = exp2f(-(float)(2 * f) * (13.287712379549449f / 32.0f));
            const float a = (float)pos * inv;
            const float kk = rintf(a * 0.15915494309189535f); float rr = fmaf(-kk, 6.2831854820251465f, a); rr = fmaf(-kk, -1.7484555e-7f, rr);
            tab[4096 + e * 2] = __cosf(rr); tab[4096 + e * 2 + 1] = __sinf(rr); }
    }
    {
        const size_t gt = (size_t)bid * 512 + tid, GT = (size_t)G * 512;
#define CVT_ARR(SRC, DST, N4) for (size_t i = gt; i < (size_t)(N4); i += GT) { const f32x4 v = ((const f32x4*)(SRC))[i]; u32x2 w; w.x = cvt_pk_bf16(v[0], v[1]); w.y = cvt_pk_bf16(v[2], v[3]); ((u32x2*)(DST))[i] = w; }
        CVT_ARR(p.in(2), ws + WS_CKS, 131072) CVT_ARR(p.in(5), ws + WS_CKD, 1048576)
#undef CVT_ARR
    }
}

__device__ __forceinline__ f32x4 bf4(u32x2 w) { f32x4 r; r[0] = __builtin_bit_cast(float, w.x << 16); r[1] = __builtin_bit_cast(float, w.x & 0xffff0000u); r[2] = __builtin_bit_cast(float, w.y << 16); r[3] = __builtin_bit_cast(float, w.y & 0xffff0000u); return r; }
__device__ __forceinline__ void norm_phase(const PB p, int mode, int li, int which, int gate_off) {
    const int tid = tid_l(), lane = tid & 63, wave = tid >> 6;
    const int gw = blockIdx.x * 8 + wave, NGW = gridDim.x * 8;
    unsigned char* ws = p.ws();
    const float* mods = (const float*)(ws + WS_MODS);
    const bf16_t* P0 = (const bf16_t*)(ws + WS_P0); const bf16_t* P1 = (const bf16_t*)(ws + WS_P1);
    bf16_t* XN = (bf16_t*)(ws + WS_XN);
    float* xo = p.out();
    const float* nw = p.in(9) + (li * 2 + which) * 1024;
    const float* x0 = p.in(0); const float* x1 = p.in(1);
    for (int grp = gw; grp < NTOK / 4; grp += NGW) {
        const int row0 = grp * 4; const int cond = row0 < 4096 ? 0 : 1 + ((row0 - 4096) >> 10);
        const float* md = mods + (size_t)(li * 5 + cond) * 6144 + which * 3072;
        f32x4 g4[4], w4[4], sh4[4], sc4[4];
#pragma unroll
        for (int jj = 0; jj < 4; ++jj) { const int c = 4 * lane + 256 * jj;
            if (mode != 0) g4[jj] = *(const f32x4*)(mods + gate_off + cond * 6144 + c);
            if (mode != 2) { w4[jj] = *(const f32x4*)(nw + c); sh4[jj] = *(const f32x4*)(md + c); sc4[jj] = *(const f32x4*)(md + 1024 + c); } }
#pragma unroll
        for (int hh = 0; hh < 2; ++hh) {
            f32x4 x[2][4]; u32x2 a0[2][4], a1[2][4];
#pragma unroll
            for (int rr = 0; rr < 2; ++rr) { const int row = row0 + 2 * hh + rr;
                const float* xr = mode == 0 ? (row < 4096 ? x0 + (size_t)row * 1024 : x1 + (size_t)(row - 4096) * 1024) : xo + (size_t)row * 1024;
#pragma unroll
                for (int jj = 0; jj < 4; ++jj) { const int c = 4 * lane + 256 * jj; x[rr][jj] = __builtin_nontemporal_load((const f32x4*)(xr + c));
                    if (mode != 0) { a0[rr][jj] = __builtin_nontemporal_load((const u32x2*)(P0 + (size_t)row * 1024 + c)); a1[rr][jj] = __builtin_nontemporal_load((const u32x2*)(P1 + (size_t)row * 1024 + c)); } } }
#pragma unroll
            for (int rr = 0; rr < 2; ++rr) { const int row = row0 + 2 * hh + rr; float ss = 0.f;
#pragma unroll
                for (int jj = 0; jj < 4; ++jj) { const int c = 4 * lane + 256 * jj;
                    if (mode != 0) x[rr][jj] = x[rr][jj] + g4[jj] * (bf4(a0[rr][jj]) + bf4(a1[rr][jj]));
                    ss += (x[rr][jj][0] * x[rr][jj][0] + x[rr][jj][1] * x[rr][jj][1]) + (x[rr][jj][2] * x[rr][jj][2] + x[rr][jj][3] * x[rr][jj][3]);
                    __builtin_nontemporal_store(x[rr][jj], (f32x4*)(xo + (size_t)row * 1024 + c)); }
                if (mode != 2) {
                    const float rstd = rsqrtf(wave_sum(ss) * (1.f / 1024.f) + 1e-6f);
#pragma unroll
                    for (int jj = 0; jj < 4; ++jj) { const int c = 4 * lane + 256 * jj;
                        const f32x4 o = x[rr][jj] * rstd * w4[jj] * (1.f + sc4[jj]) + sh4[jj];
                        u32x2 pk; pk.x = cvt_pk_bf16(o[0], o[1]); pk.y = cvt_pk_bf16(o[2], o[3]);
                        *(u32x2*)(XN + (size_t)row * 1024 + c) = pk; } } }
        }
    }
}

constexpr int HC_QP = 0, HC_QPP = 17408, HC_KP = 34816, HC_KT = 52224, HC_VT = 70656, HC_ST = 89088, HC_P = 123904, HC_SC = 133120;
__device__ __forceinline__ float exp_c(float x) { return __builtin_amdgcn_exp2f(fminf(x, 115.f)); }
__device__ __forceinline__ unsigned short bf16r(float x) { return (unsigned short)(cvt_pk_bf16(x, 0.f) & 0xffffu); }
template <int BWD, int DIR> __device__ __forceinline__ void hc_load(float (&rq)[16], float (&rf)[16], float (&rv)[16], const GAS float* base) {
    constexpr int st = DIR ? -2560 : 2560, fo = 512 + DIR * 512;
    asm volatile("" : "+v"(base));
#pragma unroll
    for (int i = 0; i < 16; ++i) { const GAS float* rp = base + (BWD ? -i : i) * st; rq[i] = rp[0]; rf[i] = rp[fo]; rv[i] = rp[1536]; }
}
template <int BWD> __device__ __forceinline__ void hc_pass2(const float (&rq)[16], const float (&rf)[16], const float (&rv)[16], const float (&rel)[16], float off, float ecm, int ch, int anchor,
        LAS unsigned short* QP, LAS unsigned short* QPP, LAS unsigned short* KP, LAS unsigned short* KT, LAS unsigned short* VT, bool vmine) {
    LAS unsigned short* qp_ = QP + anchor * 136 + ch; LAS unsigned short* qpp_ = QPP + anchor * 136 + ch; LAS unsigned short* kp_ = KP + anchor * 136 + ch;
    unsigned kk[16];
#pragma unroll
    for (int i = 0; i < 16; ++i) { const int d = BWD ? -i : i; const float r = rel[i] + off;
        const float qp = rq[i] * exp_c(r); const float kp = (1.f - rf[i]) * exp_c(-r);
        qp_[d * 136] = bf16r(qp); qpp_[d * 136] = bf16r(qp * ecm); const unsigned short k16 = bf16r(kp); kp_[d * 136] = k16; kk[BWD ? 15 - i : i] = k16; }
    const int t0 = BWD ? anchor - 15 : anchor;
    u32x4 w0, w1, v0, v1;
    w0.x = kk[0] | (kk[1] << 16); w0.y = kk[2] | (kk[3] << 16); w0.z = kk[4] | (kk[5] << 16); w0.w = kk[6] | (kk[7] << 16);
    w1.x = kk[8] | (kk[9] << 16); w1.y = kk[10] | (kk[11] << 16); w1.z = kk[12] | (kk[13] << 16); w1.w = kk[14] | (kk[15] << 16);
#define RV(e_) rv[BWD ? 15 - (e_) : (e_)]
    v0.x = cvt_pk_bf16(RV(0), RV(1)); v0.y = cvt_pk_bf16(RV(2), RV(3)); v0.z = cvt_pk_bf16(RV(4), RV(5)); v0.w = cvt_pk_bf16(RV(6), RV(7));
    v1.x = cvt_pk_bf16(RV(8), RV(9)); v1.y = cvt_pk_bf16(RV(10), RV(11)); v1.z = cvt_pk_bf16(RV(12), RV(13)); v1.w = cvt_pk_bf16(RV(14), RV(15));
#undef RV
    *(LAS u32x4*)(KT + ch * 72 + t0) = w0; *(LAS u32x4*)(KT + ch * 72 + t0 + 8) = w1;
    if (vmine) { *(LAS u32x4*)(VT + (ch & 63) * 72 + t0) = v0; *(LAS u32x4*)(VT + (ch & 63) * 72 + t0 + 8) = v1; }
}
template <int DIR>
__device__ __forceinline__ void hgrn_chunked_item(const PB p, LAS unsigned char* lds, int j, int s, int h, int vh) {
    constexpr int dir = DIR;
    const int tid = tid_l(), lane = tid & 63, fr = lane & 15, fq = lane >> 4; const int w = __builtin_amdgcn_readfirstlane(tid >> 6);
    const int L = s < 16 ? 256 : 1024, R0 = s < 16 ? s * 256 : 4096 + (s - 16) * 1024;
    const GAS float* hg = (const GAS float*)(p.ws() + WS_HG);
    GAS float* og = (GAS float*)(p.ws() + (dir ? WS_OB : WS_OF));
    LAS unsigned short* QP = (LAS unsigned short*)(lds + HC_QP); LAS unsigned short* QPP = (LAS unsigned short*)(lds + HC_QPP); LAS unsigned short* KP = (LAS unsigned short*)(lds + HC_KP);
    LAS unsigned short* KT = (LAS unsigned short*)(lds + HC_KT); LAS unsigned short* VT = (LAS unsigned short*)(lds + HC_VT); LAS unsigned short* ST = (LAS unsigned short*)(lds + HC_ST);
    LAS unsigned short* PM = (LAS unsigned short*)(lds + HC_P); LAS float* scal = (LAS float*)(lds + HC_SC);
    const int vb = w & 3, kh = w >> 2;
    f32x4 S[4];
    if (s >= 16) { const GAS float* st = (const GAS float*)p.in(4) + ((((size_t)(s - 16) * 2 + j) * 2 + dir) * 4 + h) * 16384;
#pragma unroll
        for (int kb = 0; kb < 4; ++kb) S[kb] = *(const GAS f32x4*)(st + (size_t)(16 * (4 * kh + kb) + fr) * 128 + 64 * vh + 16 * vb + 4 * fq); }
    else {
#pragma unroll
        for (int kb = 0; kb < 4; ++kb) S[kb] = (f32x4){0.f, 0.f, 0.f, 0.f}; }
    const int quarter = __builtin_amdgcn_readfirstlane(tid >> 7); const bool bwd = quarter < 2; const int ch = tid & 127;
    const int anchor = quarter == 0 ? 15 : quarter == 1 ? 31 : quarter == 2 ? 32 : 48;
    constexpr int st = dir ? -2560 : 2560;
    const GAS float* row0 = hg + (size_t)(R0 + (dir ? L - 1 : 0)) * 2560 + h * 128;
    float rq[16], rf[16], rv[16];
    float nq[16], nf[16], nv[16];
#define HC_LOAD(cc_, Q_, F_, V_) do { const GAS float* rc_ = row0 + ((long)(cc_) * 64 + anchor) * st + ch; if (bwd) hc_load<1, DIR>(Q_, F_, V_, rc_); else hc_load<0, DIR>(Q_, F_, V_, rc_); } while (0)
    HC_LOAD(0, rq, rf, rv);
    LDS_BARRIER();
#pragma unroll
    for (int kb = 0; kb < 4; ++kb)
#pragma unroll
        for (int r = 0; r < 4; ++r) ST[(16 * vb + 4 * fq + r) * 136 + 16 * (4 * kh + kb) + fr] = bf16r(S[kb][r]);
    const int nchunk = L >> 6;
    for (int c = 0; c < nchunk; ++c) {
        float rel[16];
        if (c + 1 < nchunk) HC_LOAD(c + 1, nq, nf, nv);
        { float cc = 0.f;
#pragma unroll
            for (int i = 0; i < 16; ++i) { const float g = __builtin_amdgcn_logf(rf[i]);   if (!bwd) { cc += g; rel[i] = cc; } else { rel[i] = -cc; cc += g; } }
            scal[quarter * 128 + ch] = cc; }
        LDS_BARRIER();
        { const float t0 = scal[ch], t1 = scal[128 + ch], t2 = scal[256 + ch], t3 = scal[384 + ch];
            const float off = quarter == 0 ? -t1 : quarter == 3 ? t2 : 0.f; const float cm = t0 + t1;
            if (quarter == 1) scal[512 + ch] = cm; if (quarter == 2) scal[640 + ch] = t2 + t3;
            const float ecm = exp_c(cm);
            const bool vmine = (ch >> 6) == vh;
            if (bwd) hc_pass2<1>(rq, rf, rv, rel, off, ecm, ch, anchor, QP, QPP, KP, KT, VT, vmine); else hc_pass2<0>(rq, rf, rv, rel, off, ecm, ch, anchor, QP, QPP, KP, KT, VT, vmine); }
        LDS_BARRIER();
        { const int tb = w & 3, sh = w >> 2; const int t = 16 * tb + fr;
#pragma unroll
            for (int sbi = 0; sbi < 2; ++sbi) { const int sb = 2 * sh + sbi; f32x4 a = {0.f, 0.f, 0.f, 0.f};
                if (sb <= tb) {
#pragma unroll
                    for (int ks = 0; ks < 4; ++ks) { const bf16x8 A = *(const LAS bf16x8*)(KP + (16 * sb + fr) * 136 + 32 * ks + 8 * fq); const bf16x8 B = *(const LAS bf16x8*)(QP + (16 * tb + fr) * 136 + 32 * ks + 8 * fq);
                        a = __builtin_amdgcn_mfma_f32_16x16x32_bf16(A, B, a, 0, 0, 0); } }
#pragma unroll
                for (int r = 0; r < 4; ++r) if (16 * sb + 4 * fq + r > t) a[r] = 0.f;
                u32x2 wv; wv.x = cvt_pk_bf16(a[0], a[1]); wv.y = cvt_pk_bf16(a[2], a[3]);
                *(LAS u32x2*)(PM + t * 72 + 16 * sb + 4 * fq) = wv; } }
        LDS_BARRIER();
        { bf16x8 vt[2], stf[4];
#pragma unroll
            for (int sl = 0; sl < 2; ++sl) vt[sl] = *(const LAS bf16x8*)(VT + (16 * vb + fr) * 72 + 32 * sl + 8 * fq);
#pragma unroll
            for (int ks = 0; ks < 4; ++ks) stf[ks] = *(const LAS bf16x8*)(ST + (16 * vb + fr) * 136 + 32 * ks + 8 * fq);
            GAS float* ob = og + (size_t)(R0 + (dir ? L - 1 : 0)) * 512 + (long)c * 64 * (dir ? -512 : 512) + h * 128 + 64 * vh + 16 * vb + 4 * fq;
#pragma unroll
            for (int tbi = 0; tbi < 2; ++tbi) { const int tb = 2 * kh + tbi; f32x4 o = {0.f, 0.f, 0.f, 0.f};
#pragma unroll
                for (int sl = 0; sl < 2; ++sl) if (32 * sl <= 16 * tb + 15) { const bf16x8 B = *(const LAS bf16x8*)(PM + (16 * tb + fr) * 72 + 32 * sl + 8 * fq); o = __builtin_amdgcn_mfma_f32_16x16x32_bf16(vt[sl], B, o, 0, 0, 0); }
#pragma unroll
                for (int ks = 0; ks < 4; ++ks) { const bf16x8 B = *(const LAS bf16x8*)(QPP + (16 * tb + fr) * 136 + 32 * ks + 8 * fq); o = __builtin_amdgcn_mfma_f32_16x16x32_bf16(stf[ks], B, o, 0, 0, 0); }
                *(GAS f32x4*)(ob + (long)(16 * tb + fr) * (dir ? -512 : 512)) = o; }
#pragma unroll
            for (int kbi = 0; kbi < 4; ++kbi) { const int kb = 4 * kh + kbi; const float cmv = scal[512 + 16 * kb + fr], r63 = scal[640 + 16 * kb + fr]; const float dec = exp_c(cmv + r63), e63 = exp_c(r63);
                f32x4 tt = {0.f, 0.f, 0.f, 0.f};
#pragma unroll
                for (int sl = 0; sl < 2; ++sl) { const bf16x8 B = *(const LAS bf16x8*)(KT + (16 * kb + fr) * 72 + 32 * sl + 8 * fq); tt = __builtin_amdgcn_mfma_f32_16x16x32_bf16(vt[sl], B, tt, 0, 0, 0); }
                S[kbi] = S[kbi] * dec + tt * e63; } }
        LDS_BARRIER();
#pragma unroll
        for (int kb = 0; kb < 4; ++kb)
#pragma unroll
            for (int r = 0; r < 4; ++r) ST[(16 * vb + 4 * fq + r) * 136 + 16 * (4 * kh + kb) + fr] = bf16r(S[kb][r]);
#pragma unroll
        for (int i = 0; i < 16; ++i) { rq[i] = nq[i]; rf[i] = nf[i]; rv[i] = nv[i]; }
    }
#undef HC_LOAD
    if (s < 16) { GAS float* so = (GAS float*)p.out() + OUT_ST + ((((size_t)s * 2 + j) * 2 + dir) * 4 + h) * 16384;
#pragma unroll
        for (int kb = 0; kb < 4; ++kb) *(GAS f32x4*)(so + (size_t)(16 * (4 * kh + kb) + fr) * 128 + 64 * vh + 16 * vb + 4 * fq) = S[kb]; }
}
__device__ __forceinline__ void hgrn_chunked_dispatch(const PB p, LAS unsigned char* lds, int j, int it) {
    const int s = it >> 4, h = (it >> 2) & 3, vh = it & 1;
    if (it & 2) hgrn_chunked_item<1>(p, lds, j, s, h, vh); else hgrn_chunked_item<0>(p, lds, j, s, h, vh);
}
__device__ __forceinline__ void hgrn_readout(const PB p, int j) {
    const int tid = tid_l(), lane = tid & 63, wave = tid >> 6;
    const int gw = blockIdx.x * 8 + wave, NGW = gridDim.x * 8;
    const float* of = (const float*)(p.ws() + WS_OF); const float* ob = (const float*)(p.ws() + WS_OB); const float* hg = (const float*)(p.ws() + WS_HG);
    bf16_t* MIX = (bf16_t*)(p.ws() + WS_MIX);
    const int col = (lane >> 4) * 128 + (lane & 15) * 8;
    const float* nw = p.in(15) + j * 128 + (lane & 15) * 8;
    const f32x4 w0 = *(const f32x4*)nw, w1 = *(const f32x4*)(nw + 4);
    for (int row = gw; row < NTOK; row += NGW) {
        const f32x4 a0 = *(const f32x4*)(of + (size_t)row * 512 + col) + *(const f32x4*)(ob + (size_t)row * 512 + col);
        const f32x4 a1 = *(const f32x4*)(of + (size_t)row * 512 + col + 4) + *(const f32x4*)(ob + (size_t)row * 512 + col + 4);
        const f32x4 g0 = *(const f32x4*)(hg + (size_t)row * 2560 + 2048 + col), g1 = *(const f32x4*)(hg + (size_t)row * 2560 + 2048 + col + 4);
        float ss = (a0[0] * a0[0] + a0[1] * a0[1]) + (a0[2] * a0[2] + a0[3] * a0[3]) + (a1[0] * a1[0] + a1[1] * a1[1]) + (a1[2] * a1[2] + a1[3] * a1[3]);
        ss += __shfl_xor(ss, 1); ss += __shfl_xor(ss, 2); ss += __shfl_xor(ss, 4); ss += __shfl_xor(ss, 8);
        const float rs = rsqrtf(ss * (1.f / 128.f) + 1e-6f);
        f32x4 o0, o1;
#pragma unroll
        for (int i = 0; i < 4; ++i) { o0[i] = a0[i] * rs * w0[i] * g0[i] * __builtin_amdgcn_rcpf(1.f + __expf(-g0[i])); o1[i] = a1[i] * rs * w1[i] * g1[i] * __builtin_amdgcn_rcpf(1.f + __expf(-g1[i])); }
        u32x4 w; w.x = cvt_pk_bf16(o0[0], o0[1]); w.y = cvt_pk_bf16(o0[2], o0[3]); w.z = cvt_pk_bf16(o1[0], o1[1]); w.w = cvt_pk_bf16(o1[2], o1[3]);
        *(u32x4*)(MIX + (size_t)row * 1024 + col) = w;
    }
}

struct ASeg { const GAS bf16_t* K; const GAS bf16_t* V; int ldk, ldv, kpos0, ntiles, masked; };
template <int DV>
__device__ __forceinline__ void attn_tile(const LAS unsigned char* Ks, const LAS unsigned char* VT, bool msk, int kp0, int qpos, float c2, const bf16x8 qf0, const bf16x8 qf1, int fr, int fq, f32x4 (&o)[DV / 16], float& m, float& l) {
    f32x4 sc[4];
#pragma unroll
    for (int b = 0; b < 4; ++b) {
        const bf16x8 k0 = *(const LAS bf16x8*)(Ks + (16 * b + fr) * 144 + fq * 16), k1 = *(const LAS bf16x8*)(Ks + (16 * b + fr) * 144 + 64 + fq * 16);
        f32x4 a = {0.f, 0.f, 0.f, 0.f};
        a = __builtin_amdgcn_mfma_f32_16x16x32_bf16(k0, qf0, a, 0, 0, 0);
        a = __builtin_amdgcn_mfma_f32_16x16x32_bf16(k1, qf1, a, 0, 0, 0);
        sc[b] = a;
    }
    float mx = -1e30f; unsigned vmask = 0xffffu;
#pragma unroll
    for (int b = 0; b < 4; ++b)
#pragma unroll
        for (int r = 0; r < 4; ++r) { float v = sc[b][r];
            if (msk) { const int d = qpos - (kp0 + 32 * (b >> 1) + 4 * (b & 1) + r); if (d > 128 || d < -128) { v = -1e30f; vmask &= ~(1u << (b * 4 + r)); } }
            sc[b][r] = v; mx = fmaxf(mx, v); }
    mx *= c2;
    { auto r16 = __builtin_amdgcn_permlane16_swap(__float_as_uint(mx), __float_as_uint(mx), false, false); mx = fmaxf(__uint_as_float(r16[0]), __uint_as_float(r16[1]));
      auto r32 = __builtin_amdgcn_permlane32_swap(__float_as_uint(mx), __float_as_uint(mx), false, false); mx = fmaxf(__uint_as_float(r32[0]), __uint_as_float(r32[1])); }
    const float mn = fmaxf(m, mx); const float alpha = __builtin_amdgcn_exp2f(m - mn); m = mn;
    l *= alpha;
#pragma unroll
    for (int db = 0; db < DV / 16; ++db) o[db] = o[db] * alpha;
    float ls = 0.f;
#pragma unroll
    for (int b = 0; b < 4; ++b)
#pragma unroll
        for (int r = 0; r < 4; ++r) { float pr = __builtin_amdgcn_exp2f(fmaf(sc[b][r], c2, -mn)); if (msk && !((vmask >> (b * 4 + r)) & 1u)) pr = 0.f; sc[b][r] = pr; ls += pr; }
    l += ls;
    bf16x8 pf[2];
#pragma unroll
    for (int ks = 0; ks < 2; ++ks) { u32x4 w; w.x = cvt_pk_bf16(sc[2 * ks][0], sc[2 * ks][1]); w.y = cvt_pk_bf16(sc[2 * ks][2], sc[2 * ks][3]); w.z = cvt_pk_bf16(sc[2 * ks + 1][0], sc[2 * ks + 1][1]); w.w = cvt_pk_bf16(sc[2 * ks + 1][2], sc[2 * ks + 1][3]); pf[ks] = __builtin_bit_cast(bf16x8, w); }
#pragma unroll
    for (int db = 0; db < DV / 16; ++db)
#pragma unroll
        for (int ks = 0; ks < 2; ++ks) { const bf16x8 vv = *(const LAS bf16x8*)(VT + (16 * db + fr) * 144 + ks * 64 + fq * 16);
            o[db] = __builtin_amdgcn_mfma_f32_16x16x32_bf16(vv, pf[ks], o[db], 0, 0, 0); }
}
template <int DV>
__device__ __forceinline__ void attn_run(LAS unsigned char* lds, const GAS bf16_t* Qw, int qpos, const ASeg A, const ASeg B, float c2, f32x4 (&o)[DV / 16], float& m, float& l) {
    constexpr int BUF = 9216 + DV * 144;
    const int tid = tid_l(), lane = tid & 63, fr = lane & 15, fq = lane >> 4;
    const bf16x8 qf0 = *(const GAS bf16x8*)(Qw + fq * 8), qf1 = *(const GAS bf16x8*)(Qw + 32 + fq * 8);
    const int nt = A.ntiles + B.ntiles;
    const int kkey = tid >> 3, kch = tid & 7;
    const int krow = 32 * (kkey >> 5) + 16 * ((kkey >> 2) & 1) + 4 * ((kkey >> 3) & 3) + (kkey & 3);
    u32x4 kreg, vreg[DV / 64];
#define AT_LOAD(i_) do { const bool inA_ = (i_) < A.ntiles; const int ti_ = inA_ ? (i_) : (i_) - A.ntiles; const GAS bf16_t* kp_ = inA_ ? A.K : B.K; const GAS bf16_t* vp_ = inA_ ? A.V : B.V; const int ldk_ = inA_ ? A.ldk : B.ldk, ldv_ = inA_ ? A.ldv : B.ldv; \
        kreg = *(const GAS u32x4*)(kp_ + (size_t)(ti_ * 64 + kkey) * ldk_ + kch * 8); \
        _Pragma("unroll") for (int pp_ = 0; pp_ < DV / 64; ++pp_) vreg[pp_] = *(const GAS u32x4*)(vp_ + (size_t)(kkey + 64 * pp_) * ldv_ + ti_ * 64 + kch * 8); } while (0)
#define AT_STORE(b_) do { LAS unsigned char* kb_ = lds + (b_) * BUF; *(LAS u32x4*)(kb_ + krow * 144 + kch * 16) = kreg; \
        _Pragma("unroll") for (int pp_ = 0; pp_ < DV / 64; ++pp_) *(LAS u32x4*)(kb_ + 9216 + (kkey + 64 * pp_) * 144 + kch * 16) = vreg[pp_]; } while (0)
    AT_LOAD(0);
    LDS_BARRIER();
    AT_STORE(0);
    if (nt > 1) AT_LOAD(1);
    LDS_BARRIER();
    for (int it = 0; it < nt; ++it) {
        const LAS unsigned char* Ks = lds + (it & 1) * BUF;
        attn_tile<DV>(Ks, Ks + 9216, (it < A.ntiles) && A.masked, A.kpos0 + it * 64 + 8 * fq, qpos, c2, qf0, qf1, fr, fq, o, m, l);
        if (it + 1 < nt) { AT_STORE((it + 1) & 1); if (it + 2 < nt) AT_LOAD(it + 2); }
        LDS_BARRIER();
    }
#undef AT_LOAD
#undef AT_STORE
}
__device__ __forceinline__ void diff_attn_run(LAS unsigned char* lds, const GAS bf16_t* Qw, int nA, int nB, const GAS bf16_t* KA, int ldkA, const GAS bf16_t* VA, int ldvA, const GAS bf16_t* KB, int ldkB, const GAS bf16_t* VB, int ldvB,
        float c2, f32x4 (&o0)[8], f32x4 (&o1)[8], float& m0, float& l0, float& m1, float& l1) {
    constexpr int BUF = 36864;
    const int tid = tid_l(), lane = tid & 63, fr = lane & 15, fq = lane >> 4;
    const bf16x8 q00 = *(const GAS bf16x8*)(Qw + fq * 8), q01 = *(const GAS bf16x8*)(Qw + 32 + fq * 8), q10 = *(const GAS bf16x8*)(Qw + 64 + fq * 8), q11 = *(const GAS bf16x8*)(Qw + 96 + fq * 8);
    const int nt = nA + nB;
    const int kkey = tid >> 3, kch = tid & 7;
    const int krow = 32 * (kkey >> 5) + 16 * ((kkey >> 2) & 1) + 4 * ((kkey >> 3) & 3) + (kkey & 3);
    u32x4 k0r, k1r, vreg[2];
#define DA_LOAD(i_) do { const bool inA_ = (i_) < nA; const int ti_ = inA_ ? (i_) : (i_) - nA; const GAS bf16_t* kp_ = (inA_ ? KA : KB) + (size_t)(ti_ * 64 + kkey) * (inA_ ? ldkA : ldkB) + kch * 8; const GAS bf16_t* vp_ = inA_ ? VA : VB; const int ldv_ = inA_ ? ldvA : ldvB; \
        k0r = *(const GAS u32x4*)kp_; k1r = *(const GAS u32x4*)(kp_ + 64); \
        _Pragma("unroll") for (int pp_ = 0; pp_ < 2; ++pp_) vreg[pp_] = *(const GAS u32x4*)(vp_ + (size_t)(kkey + 64 * pp_) * ldv_ + ti_ * 64 + kch * 8); } while (0)
#define DA_STORE(b_) do { LAS unsigned char* kb_ = lds + (b_) * BUF; *(LAS u32x4*)(kb_ + krow * 144 + kch * 16) = k0r; *(LAS u32x4*)(kb_ + 9216 + krow * 144 + kch * 16) = k1r; \
        _Pragma("unroll") for (int pp_ = 0; pp_ < 2; ++pp_) *(LAS u32x4*)(kb_ + 18432 + (kkey + 64 * pp_) * 144 + kch * 16) = vreg[pp_]; } while (0)
    DA_LOAD(0);
    LDS_BARRIER();
    DA_STORE(0);
    if (nt > 1) DA_LOAD(1);
    LDS_BARRIER();
    for (int it = 0; it < nt; ++it) {
        const LAS unsigned char* Ks = lds + (it & 1) * BUF;
        attn_tile<128>(Ks, Ks + 18432, false, 0, 0, c2, q00, q01, fr, fq, o0, m0, l0);
        attn_tile<128>(Ks + 9216, Ks + 18432, false, 0, 0, c2, q10, q11, fr, fq, o1, m1, l1);
        if (it + 1 < nt) { DA_STORE((it + 1) & 1); if (it + 2 < nt) DA_LOAD(it + 2); }
        LDS_BARRIER();
    }
#undef DA_LOAD
#undef DA_STORE
}

__device__ __forceinline__ void swa_unit(const PB p, LAS unsigned char* lds, int j, int s, int hq, int qb) {
    const int tid = tid_l(), lane = tid & 63, fr = lane & 15, fq = lane >> 4, wave = tid >> 6;
    const bool lat = s >= 16; const int R0 = lat ? 4096 + (s - 16) * 1024 : s * 256; const int kvh = hq >> 2;
    const GAS bf16_t* PR = (const GAS bf16_t*)(p.ws() + WS_PROJ);
    const int q0 = qb * 128, qrow = q0 + wave * 16 + fr;
    const GAS bf16_t* Qw = PR + (size_t)(R0 + qrow) * 768 + hq * 64;
    ASeg A, B;
    const GAS bf16_t* VTo = (const GAS bf16_t*)(p.ws() + WS_VT) + (size_t)128 * R0 + (size_t)(kvh * 64) * (lat ? 1024 : 256);
    A.ldk = 768; A.ldv = lat ? 1024 : 256; B.ldk = 128; B.ldv = 512; B.kpos0 = 0; B.masked = 0;
    if (lat) { const int t0 = q0 - 128 < 0 ? 0 : q0 - 128; const int t1 = q0 + 256 > 1024 ? 1024 : q0 + 256;
        A.kpos0 = t0; A.ntiles = (t1 - t0) >> 6; A.masked = 1;
        A.K = PR + (size_t)(R0 + t0) * 768 + 512 + kvh * 64; A.V = VTo + t0;
        B.ntiles = 8; B.K = (const GAS bf16_t*)(p.ws() + WS_CKS) + ((size_t)((s - 16) * 2 + j) * 512) * 128 + kvh * 64; B.V = (const GAS bf16_t*)(p.ws() + WS_CVS) + ((size_t)((s - 16) * 2 + j) * 128 + kvh * 64) * 512; }
    else { A.kpos0 = 0; A.ntiles = 4; A.masked = 0; A.K = PR + (size_t)R0 * 768 + 512 + kvh * 64; A.V = VTo; B.ntiles = 0; B.K = A.K; B.V = A.V; }
    f32x4 o[4]; float m = -1e30f, l = 0.f;
#pragma unroll
    for (int db = 0; db < 4; ++db) o[db] = (f32x4){0.f, 0.f, 0.f, 0.f};
    attn_run<64>(lds, Qw, qrow, A, B, 0.125f * 1.4426950408889634f, o, m, l);
    l += __shfl_xor(l, 16); l += __shfl_xor(l, 32);
    const float sk = p.in(18)[j * 8 + hq] * 1.4426950408889634f;
    const float mf = fmaxf(m, sk); const float a = __builtin_amdgcn_exp2f(m - mf); const float lt = l * a + __builtin_amdgcn_exp2f(sk - mf);
    const float sc = a / lt;
    GAS bf16_t* op = (GAS bf16_t*)(p.ws() + WS_MIX) + (size_t)(R0 + qrow) * 1024 + 512 + hq * 64 + 4 * fq;
#pragma unroll
    for (int db = 0; db < 4; ++db) { const f32x4 v = o[db] * sc; u32x2 w; w.x = cvt_pk_bf16(v[0], v[1]); w.y = cvt_pk_bf16(v[2], v[3]); *(GAS u32x2*)(op + 16 * db) = w; }
}
__device__ __forceinline__ void diff_unit(const PB p, LAS unsigned char* lds, int j, int s, int h, int qb) {
    const int tid = tid_l(), lane = tid & 63, fr = lane & 15, fq = lane >> 4, wave = tid >> 6;
    const bool lat = s >= 16; const int R0 = lat ? 4096 + (s - 16) * 1024 : s * 256;
    const GAS bf16_t* PR = (const GAS bf16_t*)(p.ws() + WS_PROJ);
    const int q0 = qb * 128, qrow = q0 + wave * 16 + fr;
    const float* tab = (const float*)(p.ws() + WS_TAB);
    const float lam = tab[2048 + j], lam_init = tab[2050 + j];
    const GAS bf16_t* Qw = PR + (size_t)(R0 + qrow) * 3072 + h * 128;
    const GAS bf16_t* KA = PR + (size_t)R0 * 3072 + 1024 + h * 128;
    const GAS bf16_t* VA = (const GAS bf16_t*)(p.ws() + WS_VT) + (size_t)1024 * R0 + (size_t)(h * 128) * (lat ? 1024 : 256);
    const GAS bf16_t* KB = lat ? (const GAS bf16_t*)(p.ws() + WS_CKD) + ((size_t)((s - 16) * 2 + j) * 512) * 1024 + h * 128 : KA;
    const GAS bf16_t* VB = lat ? (const GAS bf16_t*)(p.ws() + WS_CVD) + ((size_t)((s - 16) * 2 + j) * 1024 + h * 128) * 512 : VA;
    f32x4 o0[8], o1[8]; float m0 = -1e30f, l0 = 0.f, m1 = -1e30f, l1 = 0.f;
#pragma unroll
    for (int db = 0; db < 8; ++db) { o0[db] = (f32x4){0.f, 0.f, 0.f, 0.f}; o1[db] = (f32x4){0.f, 0.f, 0.f, 0.f}; }
    diff_attn_run(lds, Qw, lat ? 16 : 4, lat ? 8 : 0, KA, 3072, VA, lat ? 1024 : 256, KB, 1024, VB, 512, 0.125f * 1.4426950408889634f, o0, o1, m0, l0, m1, l1);
    l0 += __shfl_xor(l0, 16); l0 += __shfl_xor(l0, 32); l1 += __shfl_xor(l1, 16); l1 += __shfl_xor(l1, 32);
    const float i0 = 1.f / l0, i1 = lam / l1; float ss = 0.f;
#pragma unroll
    for (int db = 0; db < 8; ++db) { const f32x4 r = o0[db] * i0 - o1[db] * i1; o0[db] = r; ss += (r[0] * r[0] + r[1] * r[1]) + (r[2] * r[2] + r[3] * r[3]); }
    ss += __shfl_xor(ss, 16); ss += __shfl_xor(ss, 32);
    const float rs = rsqrtf(ss * (1.f / 128.f) + 1e-6f) * (1.f - lam_init);
    const float* sw = p.in(24) + j * 128 + 4 * fq;
    GAS bf16_t* op = (GAS bf16_t*)(p.ws() + WS_MIX) + (size_t)(R0 + qrow) * 1024 + h * 128 + 4 * fq;
#pragma unroll
    for (int db = 0; db < 8; ++db) { const f32x4 w4 = *(const f32x4*)(sw + 16 * db); const f32x4 v = o0[db] * rs * w4; u32x2 w; w.x = cvt_pk_bf16(v[0], v[1]); w.y = cvt_pk_bf16(v[2], v[3]); *(GAS u32x2*)(op + 16 * db) = w; }
}
__device__ __forceinline__ void unit_decode(int u, int& s, int& h, int& qb) {
    if (u < 256) { s = 16 + (u >> 6); h = (u >> 3) & 7; qb = u & 7; } else { const int c = u - 256; s = c >> 4; h = (c >> 1) & 7; qb = c & 1; }
}

typedef __attribute__((address_space(1))) unsigned gu32;
#define XB_TMO      128
#define XB_XCNT(j)  (256  + 64 * (j))
#define XB_XSUB(j)  (1280 + 64 * (j))
#define XB_XGEN(j)  (2304 + 64 * (j))
#define XB_TOP      3328
#define XB_TOPGEN   3392
#define XCD_BAR_WORDS 3456
#define XB_SPIN_CAP (1u << 18)

__device__ __forceinline__ unsigned xb_ld(unsigned* p)              { return __hip_atomic_load(p, __ATOMIC_RELAXED, __HIP_MEMORY_SCOPE_AGENT); }
__device__ __forceinline__ unsigned xb_add(unsigned* p, unsigned v) { return __hip_atomic_fetch_add(p, v, __ATOMIC_RELAXED, __HIP_MEMORY_SCOPE_AGENT); }
__device__ __forceinline__ unsigned xb_xcc_id() { return (unsigned)__builtin_amdgcn_s_getreg((3 << 11) | 20) & 0xFu; }
#define XB_SPIN(cond, bar) do { unsigned _sp = 0; while (cond) { __builtin_amdgcn_s_sleep(1); \
    if ((++_sp & 255u) == 0u) { if (xb_ld(&(bar)[XB_TMO])) break; if (_sp > XB_SPIN_CAP) { atomicAdd(&(bar)[XB_TMO], 1u); break; } } } } while (0)

struct XcdBarrier {
    unsigned* bar; unsigned x;
    volatile LAS unsigned* st;
};

__device__ __forceinline__ XcdBarrier xcd_barrier_post(unsigned* bar, volatile LAS unsigned* st) {
    XcdBarrier b; b.bar = bar; b.x = xb_xcc_id(); b.st = st;
    if (threadIdx.x == 0) (void)xb_add(&bar[XB_XCNT(b.x)], 1u);
    return b;
}
__device__ __forceinline__ void xcd_barrier_complete(unsigned* bar, unsigned x, unsigned& nloc, unsigned& nx) {
    const unsigned G = gridDim.x * gridDim.y * gridDim.z;
    unsigned sum, cnt, mine, sp = 0u;
    for (;;) {
        sum = 0u; cnt = 0u; mine = 0u;
#pragma unroll
        for (unsigned j = 0; j < 16; ++j) { const unsigned c = xb_ld(&bar[XB_XCNT(j)]); sum += c; cnt += (c > 0u) ? 1u : 0u; mine = (j == x) ? c : mine; }
        if (sum == G) break;
        __builtin_amdgcn_s_sleep(1);
        if ((++sp & 255u) == 0u) { if (xb_ld(&bar[XB_TMO])) break; if (sp > XB_SPIN_CAP) { atomicAdd(&bar[XB_TMO], 1u); break; } }
    }
    nloc = mine > 0u ? mine : 1u; nx = cnt > 0u ? cnt : 1u;
}

__device__ __forceinline__ void xcd_barrier(const XcdBarrier& b) {
    asm volatile("s_waitcnt vmcnt(0)" ::: "memory");
    __syncthreads();
    if (threadIdx.x == 0) {
        unsigned* bar = b.bar;
        __builtin_amdgcn_s_waitcnt(0);
        unsigned nloc = b.st[0], nx = b.st[1];
        if (nloc == 0u) { xcd_barrier_complete(bar, b.x, nloc, nx); b.st[0] = nloc; b.st[1] = nx; }
        const unsigned old = xb_add(&bar[XB_XSUB(b.x)], 1u);
        const unsigned gen = old / nloc;
        if (old + 1u == (gen + 1u) * nloc) {
            __builtin_amdgcn_fence(__ATOMIC_RELEASE, "agent");
            asm volatile("s_waitcnt vmcnt(0)" ::: "memory");
            const unsigned og = xb_add(&bar[XB_TOP], 1u);
            const unsigned tg = og / nx;
            if (og + 1u == (tg + 1u) * nx) xb_add(&bar[XB_TOPGEN], 1u);
            else XB_SPIN(xb_ld(&bar[XB_TOPGEN]) == tg, bar);
            __builtin_amdgcn_fence(__ATOMIC_ACQUIRE, "agent");
            xb_add(&bar[XB_XGEN(b.x)], 1u);
            asm volatile("s_waitcnt vmcnt(0)" ::: "memory");
        } else {
            XB_SPIN(xb_ld(&bar[XB_XGEN(b.x)]) == gen, bar);
            __builtin_amdgcn_fence(__ATOMIC_ACQUIRE, "agent");
            asm volatile("s_waitcnt vmcnt(0)" ::: "memory");
        }
    }
    __syncthreads();
}

__global__ void __launch_bounds__(512, 2) hybrid_fwd(Params ka) {
    extern __shared__ __attribute__((aligned(16))) unsigned char lds_raw[];
    LAS unsigned char* lds = (LAS unsigned char*)lds_raw;
    cg::grid_group grid = cg::this_grid();
    if (threadIdx.x == 0) {
#pragma unroll
        for (int i = 0; i < 27; ++i) *(LAS unsigned long long*)(lds + PB_OFF + 8 * i) = (unsigned long long)ka.in[i];
        *(LAS unsigned long long*)(lds + PB_OFF + 8 * 27) = (unsigned long long)ka.out; *(LAS unsigned long long*)(lds + PB_OFF + 8 * 28) = (unsigned long long)ka.ws; }
    if (threadIdx.x == 1) { *(LAS unsigned*)(lds + PB_OFF + 256) = 0u; *(LAS unsigned*)(lds + PB_OFF + 260) = 0u; }
    __syncthreads();
    const PB p{lds};
    const XcdBarrier xbar = xcd_barrier_post((unsigned*)(ka.ws + WS_BAR), (volatile LAS unsigned*)(lds + PB_OFF + 256));
    const int ph_hi = ka.ph_hi;
    int rep = 0;
    for (int ph = ka.ph_lo; ph < ph_hi; ) {
        const int G = gridDim.x, bid = blockIdx.x;
        unsigned char* ws = p.ws();
        if (ph == 0) {
#ifndef SK_P0
            phase0(p, lds);
#endif
        }
        else if (ph == 33) { norm_phase(p, 2, 3, 1, (3 * 5) * 6144 + 5 * 1024); }
        else {
            const int li = (ph - 1) >> 3, sub = (ph - 1) & 7, j = li >> 1, odd = li & 1;
            if (sub == 3 && odd) { ++ph; continue; }
            if (sub == 0) { norm_phase(p, li == 0 ? 0 : 1, li, 0, ((li - 1) * 5) * 6144 + 5 * 1024); }
            else if (sub == 5) { norm_phase(p, 1, li, 1, (li * 5) * 6144 + 2 * 1024); }
            else if (sub == 1) {
                pg8::Gemm g{(const bf16_t*)(ws + WS_XN), odd ? (const bf16_t*)(ws + WS_WINO) + (size_t)j * NOD * DM : (const bf16_t*)(ws + WS_WINE) + (size_t)j * NEV * DM, NTOK, odd ? NOD : NEV, DM, DM, 1};
                pg8::StaticOrder S; S.init(NTOK, g.N, G, bid);
                pg8::EpiIn E; E.odd = odd; E.j = j; E.pb = (const LAS unsigned*)(lds + PB_OFF);

#ifndef SK_IN
                pg8::gemm_phase<pg8::EpiIn, pg8::StaticOrder, true, true>(lds, g, S, E);
#endif
                {
                    const int nun = (NTOK / 256) * (g.N / 256);
                    const bool part = (nun > G && nun < 2 * G);
                    const int first = part ? nun - G : 0, cnt = part ? 2 * G - nun : G;
                    __syncthreads();
                    if (bid >= first) convert_layer_a(p, lds, li < 3 ? li + 1 : -1, (bid - first) * 8 + __builtin_amdgcn_readfirstlane(tid_l() >> 6), cnt * 8, li >= 1 ? li : -1);
                }

            }
            else if (sub == 2) {
#ifndef SK_MIX
                const int vb = (G % 8 == 0) ? (bid & 7) * (G >> 3) + (bid >> 3) : bid;
                if (!odd) {
                    { const bool fast = (G == 256); const int k = vb - 64;
                        const int nh = fast ? (vb >= 192 ? 2 : 1) : (vb < 320 ? (320 - vb + G - 1) / G : 0);
                        for (int q = 0; q < nh; ++q) { int it;
                            if (fast) it = vb < 64 ? 256 + vb : (q == 0 ? k : 192 + (k - 128)); else { const int r = vb + q * G; it = r < 64 ? 256 + r : r - 64; }
#ifdef PROBE_HG2
                            hgrn_chunked_dispatch(p, lds, j, it);
#endif
                            hgrn_chunked_dispatch(p, lds, j, it); }
                        const int nu = fast ? (vb < 64 ? 0 : (k < 64 ? 2 : (k < 128 ? 4 : 2))) : (vb < 512 ? (512 - vb + G - 1) / G : 0);
#ifdef PROBE_SWA2
                        for (int rp_ = 0; rp_ < 2; ++rp_)
#endif
                        for (int q = 0; q < nu; ++q) { int u;
                            if (!fast) u = vb + q * G;
                            else if (k < 64) u = q == 0 ? k : 64 + k;
                            else if (k < 128) u = q == 0 ? 128 + (k - 64) : 256 + (k - 64) * 3 + (q - 1);
                            else u = q == 0 ? 192 + (k - 128) : 256 + 192 + (k - 128);
                            int s, h, qb; unit_decode(u, s, h, qb); swa_unit(p, lds, j, s, h, qb); } }
                } else {
                    for (int u = vb; u < 512; u += G) { int s, h, qb; unit_decode(u, s, h, qb); diff_unit(p, lds, j, s, h, qb); }
                }
#endif
            }
            else if (sub == 3) { hgrn_readout(p, j); }
            else if (sub == 4 || sub == 7) {
                const bool mlp = sub == 7;
                pg8::Gemm g{mlp ? (const bf16_t*)(ws + WS_H) : (const bf16_t*)(ws + WS_MIX),
                            mlp ? (const bf16_t*)(ws + WS_W2) + (size_t)li * DM * FF : (odd ? (const bf16_t*)(ws + WS_WOUTO) : (const bf16_t*)(ws + WS_WOUTE)) + (size_t)j * DM * DM, NTOK, DM, mlp ? FF / 2 : DM / 2, mlp ? FF : DM, 2};
                pg8::StaticOrder S; S.init(NTOK, DM, G, bid, 2);
                pg8::EpiPart E{(bf16_t*)(ws + WS_P0), (bf16_t*)(ws + WS_P1)};

#ifndef SK_RES
                pg8::gemm_phase<pg8::EpiPart, pg8::StaticOrder, true, true>(lds, g, S, E);
#endif

            }
            else {
                pg8::Gemm g{(const bf16_t*)(ws + WS_XN), (const bf16_t*)(ws + WS_W1) + (size_t)li * FF * DM, NTOK, FF, DM, DM, 1};
                pg8::StaticOrder S; S.init(NTOK, FF, G, bid);
                pg8::EpiRelu2 E{(bf16_t*)(ws + WS_H), FF};

#ifndef SK_MLP1
                pg8::gemm_phase<pg8::EpiRelu2, pg8::StaticOrder, true, true>(lds, g, S, E);
#endif

            }
        }
        { const bool again = DUP_MASK != 0 && rep == 0 && ph > 0 && ((DUP_MASK >> (((ph - 1) & 7) + 8 * (((ph - 1) >> 3) & 1))) & 1); rep = again ? 1 : 0; if (!again) ++ph; }
        if (ph < ph_hi) { if (ph_hi > 1000) grid.sync(); else xcd_barrier(xbar); }
    }
}

#ifndef DUP_MASK
#define DUP_MASK 0
#endif
#ifndef MK_PER_PHASE
#define MK_PER_PHASE 0
#endif
extern "C" void kernel_launch(void* const* d_in, const int* in_sizes, int n_in, void* d_out, int out_size, void* d_ws, size_t ws_size, hipStream_t stream) {
    static int grid = 0;
    if (grid == 0) {
        if (n_in != 27 || ws_size < WS_END) { fprintf(stderr, "kernel_launch: unexpected n_in %d / ws_size %zu\n", n_in, ws_size); grid = -1; return; }
        int dev = 0, cus = 0, per_cu = 0;
        hipGetDevice(&dev); hipDeviceGetAttribute(&cus, hipDeviceAttributeMultiprocessorCount, dev);
        if (hipFuncSetAttribute((const void*)hybrid_fwd, hipFuncAttributeMaxDynamicSharedMemorySize, LDS_BYTES) != hipSuccess) { fprintf(stderr, "kernel_launch: hipFuncSetAttribute failed\n"); grid = -1; return; }
        if (hipOccupancyMaxActiveBlocksPerMultiprocessor(&per_cu, (const void*)hybrid_fwd, 512, LDS_BYTES) != hipSuccess || per_cu < 1) { fprintf(stderr, "kernel_launch: occupancy query says %d blocks per CU\n", per_cu); grid = -1; (void)hipGetLastError(); return; }
        grid = cus;
    }
    if (grid < 0) return;
    hipMemsetAsync((char*)d_ws + WS_MODS, 0, 512 * 1024, stream);
    Params p{};
    for (int i = 0; i < 27; ++i) p.in[i] = (const float*)d_in[i];
    p.out = (float*)d_out; p.ws = (unsigned char*)d_ws;
#if MK_PER_PHASE
    for (int ph = 0; ph < 34; ++ph) { p.ph_lo = ph; p.ph_hi = ph + 1; hipLaunchKernelGGL(hybrid_fwd, dim3(grid), dim3(512), LDS_BYTES, stream, p); }
#else
    p.ph_lo = 0; p.ph_hi = 34;
    void* args[] = {&p};
    hipError_t e = hipLaunchCooperativeKernel((const void*)hybrid_fwd, dim3(grid), dim3(512), args, LDS_BYTES, stream);
    if (e != hipSuccess) fprintf(stderr, "cooperative launch failed: %s (grid %d)\n", hipGetErrorString(e), grid);
#endif
}
```

```cpp
#include <hip/hip_runtime.h>
#include <hip/hip_cooperative_groups.h>
#include <cstdio>
#include <cstdint>
namespace cg = cooperative_groups;
#ifndef DUP_MASK
#define DUP_MASK 0
#endif
#define GAS __attribute__((address_space(1)))
#define LDS_BARRIER() do { asm volatile("s_waitcnt lgkmcnt(0)" ::: "memory"); __builtin_amdgcn_s_barrier(); asm volatile("" ::: "memory"); } while (0)
__device__ __forceinline__ int tid_l() { int t = threadIdx.x; asm volatile("" : "+v"(t)); return t; }
namespace pg8 {
#define PG8_LAS __attribute__((address_space(3)))
typedef unsigned short bf16_t;
typedef short bf16x8 __attribute__((ext_vector_type(8)));
typedef float f32x4 __attribute__((ext_vector_type(4)));
typedef unsigned u32x4 __attribute__((ext_vector_type(4)));
constexpr int BM = 256, BK = 64, HALF = 128, HTB = HALF * BK * 2  , STAGE_BYTES = 8 * HTB, NXCD = 8, WGM = 8;

__host__ __device__ __forceinline__ int lds_byte(int r, int c) { const int st = (r >> 4) * 2 + (c >> 5), rr = r & 15, cc = c & 31, ob = rr * 64 + cc * 2; return st * 1024 + (ob ^ (((ob >> 9) & 1) << 5)); }
__host__ __device__ __forceinline__ void stage_rc(int b, int& R, int& C) { const int st = b / 1024, sb = b % 1024, swz = sb ^ (((sb >> 9) & 1) << 5); R = (st >> 1) * 16 + swz / 64; C = (st & 1) * 32 + (swz % 64) / 2; }
__host__ __device__ __forceinline__ int perm32(int rho) { const int n = rho >> 4, i = rho & 15; return 8 * (i >> 2) + 4 * n + (i & 3); }

struct Unit { int pm, pn, ks; };
struct Gemm { const bf16_t* A; const bf16_t* Bt; int M, N, K, ld, KS; };

struct StaticOrder {
    int nM, nN, nwg, G, c, nNr;
    __host__ __device__ void init(int M, int N, int G_, int c_, int KS = 1) { nM = M / BM; nNr = N / BM; nN = nNr * KS; nwg = nM * nN; G = G_; c = c_; }
    __host__ __device__ bool next(int i, Unit& u) const {
        const long L = (long)i * G + c; if (L >= nwg) return false;
        int wgid = (int)L; { const int q = nwg / NXCD, r = nwg % NXCD, xcd = wgid % NXCD, off = wgid / NXCD; wgid = (xcd < r ? xcd * (q + 1) : r * (q + 1) + (xcd - r) * q) + off; }
        const int nig = WGM * nN, gid = wgid / nig, fm = gid * WGM, gsz = (nM - fm) < WGM ? (nM - fm) : WGM;
        u.pm = fm + ((wgid % nig) % gsz); { const int pq = (wgid % nig) / gsz; u.pn = pq % nNr; u.ks = pq / nNr; } return true;
    }
    __device__ __forceinline__ void a_ready(const Unit&) const {}
    __device__ __forceinline__ void done(const Unit&) const {}
};

__device__ __forceinline__ unsigned cvt_pk_bf16(float lo, float hi) { unsigned r; asm volatile("v_cvt_pk_bf16_f32 %0, %1, %2" : "=v"(r) : "v"(lo), "v"(hi)); return r; }
typedef float f32x2 __attribute__((ext_vector_type(2)));
typedef unsigned u32x2 __attribute__((ext_vector_type(2)));

#define LDSP __attribute__((address_space(3)))
__device__ __forceinline__ unsigned long long ldq(const unsigned LDSP* pb, int i) { const unsigned lo = __builtin_amdgcn_readfirstlane(pb[2 * i]), hi = __builtin_amdgcn_readfirstlane(pb[2 * i + 1]); return ((unsigned long long)hi << 32) | lo; }
__device__ __forceinline__ float dpp_x1(float x) { return __builtin_bit_cast(float, __builtin_amdgcn_update_dpp(0, __builtin_bit_cast(int, x), 0xB1, 0xf, 0xf, true)); }
__device__ __forceinline__ float dpp_x2(float x) { return __builtin_bit_cast(float, __builtin_amdgcn_update_dpp(0, __builtin_bit_cast(int, x), 0x4E, 0xf, 0xf, true)); }
__device__ __forceinline__ void quad_transpose(float& v0, float& v1, float& v2, float& v3, int a) {
    { const bool hi = a & 1; const float r0 = dpp_x1(hi ? v0 : v1), r1 = dpp_x1(hi ? v2 : v3); if (hi) { v0 = r0; v2 = r1; } else { v1 = r0; v3 = r1; } }
    { const bool hi = a & 2; const float r0 = dpp_x2(hi ? v0 : v2), r1 = dpp_x2(hi ? v1 : v3); if (hi) { v0 = r0; v1 = r1; } else { v2 = r0; v3 = r1; } }
}
struct EpiRelu2 {
    static constexpr bool PERM = true, AFTER_DRAIN = false;
    bf16_t* O; int ldc;
    __device__ __forceinline__ void operator()(const f32x4 (&acc)[2][2][4][2], const Unit& u, int wr, int wc, int fr, int fq) const {
        const int row0 = u.pm * BM + wr * 64 + fr; const int col0 = u.pn * BM + wc * 32 + 8 * fq;
#pragma unroll
        for (int ai = 0; ai < 2; ++ai)
#pragma unroll
            for (int m = 0; m < 4; ++m) { bf16_t* rowp = O + (size_t)(row0 + ai * HALF + m * 16) * ldc + col0;
#pragma unroll
                for (int bj = 0; bj < 2; ++bj) { f32x4 v0 = acc[ai][bj][m][0], v1 = acc[ai][bj][m][1];
#pragma unroll
                    for (int i = 0; i < 4; ++i) { float a = fmaxf(v0[i], 0.f), b = fmaxf(v1[i], 0.f); v0[i] = a * a; v1[i] = b * b; }
                    u32x4 w; w.x = cvt_pk_bf16(v0[0], v0[1]); w.y = cvt_pk_bf16(v0[2], v0[3]); w.z = cvt_pk_bf16(v1[0], v1[1]); w.w = cvt_pk_bf16(v1[2], v1[3]);
                    *(u32x4*)(rowp + bj * HALF) = w; } }
    }
};
struct EpiPart {
    static constexpr bool PERM = true, AFTER_DRAIN = false;
    bf16_t* P0; bf16_t* P1;
    __device__ __forceinline__ void operator()(const f32x4 (&acc)[2][2][4][2], const Unit& u, int wr, int wc, int fr, int fq) const {
        bf16_t* P = u.ks ? P1 : P0;
        const int col0 = u.pn * BM + wc * 32 + 8 * fq;
#pragma unroll
        for (int ai = 0; ai < 2; ++ai)
#pragma unroll
            for (int m = 0; m < 4; ++m) { bf16_t* rowp = P + (size_t)(u.pm * BM + ai * HALF + wr * 64 + m * 16 + fr) * 1024 + col0;
#pragma unroll
                for (int bj = 0; bj < 2; ++bj) { const f32x4 v0 = acc[ai][bj][m][0], v1 = acc[ai][bj][m][1];
                    u32x4 w; w.x = cvt_pk_bf16(v0[0], v0[1]); w.y = cvt_pk_bf16(v0[2], v0[3]); w.z = cvt_pk_bf16(v1[0], v1[1]); w.w = cvt_pk_bf16(v1[2], v1[3]);
                    *(u32x4*)(rowp + bj * HALF) = w; } }
    }
};
struct EpiIn {
    static constexpr bool PERM = false, AFTER_DRAIN = false;
    int odd, j; const unsigned LDSP* pb;
    __device__ __forceinline__ void operator()(const f32x4 (&acc)[2][2][4][2], const Unit& u, int wr, int wc, int fr, int fq) const {
        unsigned char* ws = (unsigned char*)ldq(pb, 28); float* outp = (float*)ldq(pb, 27);
        bf16_t* proj = (bf16_t*)(ws + 150u * 1048576u); const int ldp = odd ? 3072 : 768; float* hg = (float*)(ws + 198u * 1048576u);
        const float* lbs = (const float*)(ws + 524288) + j * 1024; const float* rope = (const float*)(ws + 524288) + 4096;
        const float* qnw = (const float*)ldq(pb, odd ? 21 : 16) + j * 64; const float* knw = (const float*)ldq(pb, odd ? 22 : 17) + j * 64;
        float* outk = outp + (odd ? 14680064 : 8388608); float* outv = outp + (odd ? 23068672 : 9437184);
        const int unit = u.pn * 4 + wc;
        int type;
        if (!odd) type = unit < 8 ? 0 : unit < 24 ? 1 : unit < 40 ? 2 : unit < 48 ? 3 : unit < 50 ? 4 : 5;
        else type = unit < 16 ? 3 : unit < 32 ? 4 : 5;
        const int pu = odd ? unit : unit - 40;
        const bool lat = u.pm >= 16;
        f32x4 w4[2][2];
        if (type == 3 || type == 4) { const float* nw = (type == 3) ? qnw : knw;
#pragma unroll
            for (int bj = 0; bj < 2; ++bj)
#pragma unroll
                for (int n = 0; n < 2; ++n) w4[bj][n] = *(const f32x4*)(nw + 32 * bj + 16 * n + 4 * fq); }
        else if (type == 1) { const float* lb = lbs + ((unit - 8) >> 3) * 512 + ((unit - 8) & 7) * 64;
#pragma unroll
            for (int bj = 0; bj < 2; ++bj)
#pragma unroll
                for (int n = 0; n < 2; ++n) w4[bj][n] = *(const f32x4*)(lb + 32 * bj + 16 * n + 4 * fq); }
        else {
#pragma unroll
            for (int bj = 0; bj < 2; ++bj)
#pragma unroll
                for (int n = 0; n < 2; ++n) w4[bj][n] = (f32x4){0.f, 0.f, 0.f, 0.f}; }
#pragma unroll
        for (int ai = 0; ai < 2; ++ai)
#pragma unroll
            for (int m = 0; m < 4; ++m) {
                const int row = u.pm * BM + ai * HALF + wr * 64 + m * 16 + fr;
                f32x4 v[2][2];
#pragma unroll
                for (int bj = 0; bj < 2; ++bj)
#pragma unroll
                    for (int n = 0; n < 2; ++n) v[bj][n] = acc[ai][bj][m][n];
                if (type <= 2) {
                    float* hp = hg + (size_t)row * 2560 + unit * 64 + 4 * fq;
#pragma unroll
                    for (int bj = 0; bj < 2; ++bj)
#pragma unroll
                        for (int n = 0; n < 2; ++n) { f32x4 xv = v[bj][n];
                            if (type == 0) {
#pragma unroll
                                for (int i = 0; i < 4; ++i) xv[i] = xv[i] * __builtin_amdgcn_rcpf(1.f + __expf(-xv[i])) * 0.08838834764831845f; }
                            else if (type == 1) {
#pragma unroll
                                for (int i = 0; i < 4; ++i) { const float sg = __builtin_amdgcn_rcpf(1.f + __expf(-xv[i])); const float lb = w4[bj][n][i]; xv[i] = lb + (1.f - lb) * sg; } }
                            *(f32x4*)(hp + 32 * bj + 16 * n) = xv; }
                } else {
                    if (type != 5) {
                        float ss = 0.f;
#pragma unroll
                        for (int bj = 0; bj < 2; ++bj)
#pragma unroll
                            for (int n = 0; n < 2; ++n) { const f32x4 xv = v[bj][n]; ss += (xv[0] * xv[0] + xv[1] * xv[1]) + (xv[2] * xv[2] + xv[3] * xv[3]); }
                        ss += __shfl_xor(ss, 16); ss += __shfl_xor(ss, 32);
                        const float rs = rsqrtf(ss * (1.f / 64.f) + 1e-6f);
#pragma unroll
                        for (int bj = 0; bj < 2; ++bj)
#pragma unroll
                            for (int n = 0; n < 2; ++n) v[bj][n] = v[bj][n] * rs * w4[bj][n];
                    }
                    if (!lat && type >= 4) {
                        float* ob = (type == 4) ? outk : outv;
                        const int b = row >> 8, t = row & 255;
                        size_t off;
                        if (!odd) off = ((size_t)(b * 2 + j) * 256 + t) * 128 + (size_t)(unit - (type == 4 ? 48 : 50)) * 64;
                        else off = ((size_t)(b * 2 + j) * 256 + t) * 1024 + (size_t)(unit - (type == 4 ? 16 : 32)) * 64;
#pragma unroll
                        for (int bj = 0; bj < 2; ++bj)
#pragma unroll
                            for (int n = 0; n < 2; ++n) *(f32x4*)(ob + off + 32 * bj + 16 * n + 4 * fq) = v[bj][n];
                    }
                    if (lat && type != 5) {
                        const int t = (row - 4096) & 1023; const int rp = t >> 6, cp = t & 63;
#pragma unroll
                        for (int bj = 0; bj < 2; ++bj)
#pragma unroll
                            for (int n = 0; n < 2; ++n) { const f32x4 cs = *(const f32x4*)(rope + ((bj ? cp : rp) * 16 + 8 * n + 2 * fq) * 2);
                                const f32x4 xv = v[bj][n]; f32x4 o;
                                o[0] = xv[0] * cs[0] - xv[1] * cs[1]; o[1] = xv[0] * cs[1] + xv[1] * cs[0];
                                o[2] = xv[2] * cs[2] - xv[3] * cs[3]; o[3] = xv[2] * cs[3] + xv[3] * cs[2]; v[bj][n] = o; }
                    }
                    if (type == 5) {
                        const int t = lat ? ((row - 4096) & 1023) : (row & 255); const int L = lat ? 1024 : 256; const int C = odd ? 1024 : 128;
                        const int a = fr & 3;
                        unsigned short* vp = (unsigned short*)(ws + 310u * 1048576u) + (size_t)C * (row - t) + (size_t)((unit - (odd ? 32 : 50)) * 64 + 4 * fq + a) * L + (t - a);
#pragma unroll
                        for (int bj = 0; bj < 2; ++bj)
#pragma unroll
                            for (int n = 0; n < 2; ++n) { float x0 = v[bj][n][0], x1 = v[bj][n][1], x2 = v[bj][n][2], x3 = v[bj][n][3];
                                quad_transpose(x0, x1, x2, x3, a);
                                u32x2 w; w.x = cvt_pk_bf16(x0, x1); w.y = cvt_pk_bf16(x2, x3);
                                *(u32x2*)(vp + (size_t)(32 * bj + 16 * n) * L) = w; }
                    } else {
                    bf16_t* pp = proj + (size_t)row * ldp + pu * 64 + 4 * fq;
#pragma unroll
                    for (int bj = 0; bj < 2; ++bj)
#pragma unroll
                        for (int n = 0; n < 2; ++n) { u32x2 w; w.x = cvt_pk_bf16(v[bj][n][0], v[bj][n][1]); w.y = cvt_pk_bf16(v[bj][n][2], v[bj][n][3]); *(u32x2*)(pp + 32 * bj + 16 * n) = w; }
                    }
                }
            }
    }
};

template <class Epi, class Sched, bool ALIGN_EPI = false, bool SP2 = false>
__device__ __forceinline__ void gemm_phase(PG8_LAS unsigned char* lds, const Gemm g, const Sched& S, const Epi& E) {
    const int tid = tid_l(), wid = __builtin_amdgcn_readfirstlane(tid >> 6), lane = tid & 63, wr = wid >> 2, wc = wid & 3, fr = lane & 15, fq = lane >> 4;
    const int K = g.ld, nt = g.K / BK;
    unsigned voffA[2], voffB[2];
#pragma unroll
    for (int i = 0; i < 2; ++i) { int R, C; stage_rc(tid * 16 + i * 8192, R, C); const int Rb = Epi::PERM ? ((R & ~31) + perm32(R & 31)) : R;
        voffA[i] = (unsigned)(R * K + C) * 2u; voffB[i] = (unsigned)(Rb * K + C) * 2u; }
    const size_t kstep = (size_t)(BK * 2);
    const size_t hstep = (size_t)HALF * K * 2;
    const size_t tstep = 2 * hstep;
    const unsigned ldsw = (unsigned)wid * 1024u;
    const int aoff = lds_byte(wr * 64 + fr, fq * 8), boff = lds_byte(wc * 32 + fr, fq * 8);
#define PG8_SA(b, h) (((b) * 2 + (h)) * HTB)
#define PG8_SB(b, h) ((4 + (b) * 2 + (h)) * HTB)
#define PG8_STAGE(bufoff, gbase, voff) do { _Pragma("unroll") for (int _i = 0; _i < 2; ++_i) \
        __builtin_amdgcn_global_load_lds((const unsigned*)((const char*)(gbase) + (voff)[_i]), (PG8_LAS unsigned*)(lds + (bufoff) + ldsw + _i * 8192), 16, 0, 0); } while (0)
#define PG8_LDA(dst, b, h) do { _Pragma("unroll") for (int m = 0; m < 4; ++m) _Pragma("unroll") for (int k = 0; k < 2; ++k) dst[m][k] = *(const PG8_LAS bf16x8*)(lds + PG8_SA(b, h) + aoff + m * 2048 + k * 1024); } while (0)
#define PG8_LDB(dst, b, h) do { _Pragma("unroll") for (int n = 0; n < 2; ++n) _Pragma("unroll") for (int k = 0; k < 2; ++k) dst[n][k] = *(const PG8_LAS bf16x8*)(lds + PG8_SB(b, h) + boff + n * 2048 + k * 1024); } while (0)
#define PG8_MMA(ai, bj, At, Bt) do { __builtin_amdgcn_s_setprio(1); _Pragma("unroll") for (int m = 0; m < 4; ++m) _Pragma("unroll") for (int n = 0; n < 2; ++n) _Pragma("unroll") for (int k = 0; k < 2; ++k) \
        acc[ai][bj][m][n] = __builtin_amdgcn_mfma_f32_16x16x32_bf16(Bt[n][k], At[m][k], acc[ai][bj][m][n], 0, 0, 0); __builtin_amdgcn_s_setprio(0); } while (0)
#define PG8_WAIT_V(n) asm volatile("s_waitcnt vmcnt(" #n ")" ::: "memory")
#define PG8_WAIT_L(n) asm volatile("s_waitcnt lgkmcnt(" #n ")" ::: "memory")
#define PG8_BAR __builtin_amdgcn_s_barrier()
#define PG8_SCHED __builtin_amdgcn_sched_barrier(0)
    Unit cur, nxt; int ui = 0;
    if (!S.next(0, cur)) return;
    f32x4 acc[2][2][4][2];
#pragma unroll
    for (int a = 0; a < 2; ++a)
#pragma unroll
        for (int b = 0; b < 2; ++b)
#pragma unroll
            for (int m = 0; m < 4; ++m)
#pragma unroll
                for (int n = 0; n < 2; ++n) acc[a][b][m][n] = (f32x4){0.f, 0.f, 0.f, 0.f};
    bf16x8 At[4][2], B0[2][2], B1[2][2];
    const char* cA = (const char*)g.A + (size_t)cur.pm * tstep + (size_t)cur.ks * g.K * 2; const char* cB = (const char*)g.Bt + (size_t)cur.pn * tstep + (size_t)cur.ks * g.K * 2;
    S.a_ready(cur);
    if constexpr (SP2) {
        PG8_STAGE(PG8_SB(0, 0), cB, voffB); PG8_STAGE(PG8_SB(0, 1), cB + hstep, voffB); PG8_STAGE(PG8_SA(0, 0), cA, voffA); PG8_STAGE(PG8_SA(0, 1), cA + hstep, voffA);
        if (wr == 1) PG8_BAR;
        PG8_WAIT_V(2); PG8_BAR;
        PG8_STAGE(PG8_SB(1, 0), cB + kstep, voffB); PG8_STAGE(PG8_SA(1, 0), cA + kstep, voffA); PG8_STAGE(PG8_SB(1, 1), cB + hstep + kstep, voffB);
        PG8_WAIT_V(6); PG8_BAR;
    } else {
        PG8_STAGE(PG8_SB(0, 0), cB, voffB); PG8_STAGE(PG8_SA(0, 0), cA, voffA); PG8_STAGE(PG8_SB(0, 1), cB + hstep, voffB); PG8_STAGE(PG8_SA(0, 1), cA + hstep, voffA);
        if (wr == 1) PG8_BAR;
        PG8_WAIT_V(4); PG8_BAR;
        PG8_STAGE(PG8_SB(1, 0), cB + kstep, voffB); PG8_STAGE(PG8_SA(1, 0), cA + kstep, voffA); PG8_STAGE(PG8_SB(1, 1), cB + hstep + kstep, voffB);
        PG8_WAIT_V(6); PG8_BAR;
    }
    for (;;) {
        const bool has_next = S.next(ui + 1, nxt);
        const char* nA = has_next ? (const char*)g.A + (size_t)nxt.pm * tstep + (size_t)nxt.ks * g.K * 2 : cA; const char* nB = has_next ? (const char*)g.Bt + (size_t)nxt.pn * tstep + (size_t)nxt.ks * g.K * 2 : cB;
        for (int t = 0; t < nt; t += 2) {
            const bool last = (t == nt - 2);
            const char* a1 = cA + (size_t)(t + 1) * kstep;
            const char* a2 = last ? nA : cA + (size_t)(t + 2) * kstep; const char* b2 = last ? nB : cB + (size_t)(t + 2) * kstep;
            const char* a3 = a2 + kstep; const char* b3 = b2 + kstep;
            if (last && has_next) S.a_ready(nxt);
            if constexpr (SP2) {
            PG8_LDB(B0, 0, 0); PG8_LDB(B1, 0, 1); PG8_SCHED; PG8_LDA(At, 0, 0); PG8_STAGE(PG8_SA(1, 1), a1 + hstep, voffA);
            PG8_WAIT_V(8); PG8_WAIT_L(0); PG8_BAR; PG8_MMA(0, 0, At, B0); PG8_MMA(0, 1, At, B1); PG8_BAR; PG8_SCHED;
            PG8_LDA(At, 0, 1); PG8_STAGE(PG8_SB(0, 0), b2, voffB); PG8_STAGE(PG8_SB(0, 1), b2 + hstep, voffB); PG8_STAGE(PG8_SA(0, 0), a2, voffA);
            PG8_WAIT_V(8); PG8_WAIT_L(0); PG8_BAR; PG8_MMA(1, 0, At, B0); PG8_MMA(1, 1, At, B1); PG8_BAR; PG8_SCHED;
            PG8_LDB(B0, 1, 0); PG8_LDB(B1, 1, 1); PG8_SCHED; PG8_LDA(At, 1, 0); PG8_STAGE(PG8_SA(0, 1), a2 + hstep, voffA);
            PG8_WAIT_V(8); PG8_WAIT_L(0); PG8_BAR; PG8_MMA(0, 0, At, B0); PG8_MMA(0, 1, At, B1); PG8_BAR; PG8_SCHED;
            PG8_LDA(At, 1, 1); PG8_STAGE(PG8_SB(1, 0), b3, voffB); PG8_STAGE(PG8_SB(1, 1), b3 + hstep, voffB); PG8_STAGE(PG8_SA(1, 0), a3, voffA);
            PG8_WAIT_V(8); PG8_WAIT_L(0); PG8_BAR; PG8_MMA(1, 0, At, B0); PG8_MMA(1, 1, At, B1); PG8_BAR; PG8_SCHED;
            } else {
            PG8_LDB(B0, 0, 0); PG8_SCHED; PG8_LDA(At, 0, 0); PG8_STAGE(PG8_SA(1, 1), a1 + hstep, voffA);
            PG8_WAIT_L(8); PG8_BAR; PG8_WAIT_L(0); PG8_MMA(0, 0, At, B0); PG8_BAR; PG8_SCHED;
            PG8_LDB(B1, 0, 1); PG8_STAGE(PG8_SB(0, 0), b2, voffB);
            PG8_BAR; PG8_WAIT_L(0); PG8_MMA(0, 1, At, B1); PG8_BAR;
            PG8_LDA(At, 0, 1); PG8_STAGE(PG8_SA(0, 0), a2, voffA);
            PG8_BAR; PG8_WAIT_L(0); PG8_MMA(1, 0, At, B0); PG8_BAR; PG8_SCHED;
            PG8_STAGE(PG8_SB(0, 1), b2 + hstep, voffB);
            PG8_WAIT_V(6); PG8_BAR; PG8_MMA(1, 1, At, B1); PG8_BAR;
            PG8_LDB(B0, 1, 0); PG8_SCHED; PG8_LDA(At, 1, 0); PG8_STAGE(PG8_SA(0, 1), a2 + hstep, voffA);
            PG8_WAIT_L(8); PG8_BAR; PG8_WAIT_L(0); PG8_MMA(0, 0, At, B0); PG8_BAR; PG8_SCHED;
            PG8_LDB(B1, 1, 1); PG8_STAGE(PG8_SB(1, 0), b3, voffB);
            PG8_BAR; PG8_WAIT_L(0); PG8_MMA(0, 1, At, B1); PG8_BAR;
            PG8_LDA(At, 1, 1); PG8_STAGE(PG8_SA(1, 0), a3, voffA);
            PG8_BAR; PG8_WAIT_L(0); PG8_MMA(1, 0, At, B0); PG8_BAR; PG8_SCHED;
            PG8_STAGE(PG8_SB(1, 1), b3 + hstep, voffB);
            PG8_WAIT_V(6); PG8_BAR; PG8_MMA(1, 1, At, B1); PG8_BAR;
            }
        }
        if constexpr (ALIGN_EPI) { if (wr == 0) PG8_BAR; }
        if constexpr (!Epi::AFTER_DRAIN) { E(acc, cur, wr, wc, fr, fq); S.done(cur); }
        if (!has_next) break;
#pragma unroll
        for (int a = 0; a < 2; ++a)
#pragma unroll
            for (int b = 0; b < 2; ++b)
#pragma unroll
                for (int m = 0; m < 4; ++m)
#pragma unroll
                    for (int n = 0; n < 2; ++n) acc[a][b][m][n] = (f32x4){0.f, 0.f, 0.f, 0.f};
        cur = nxt; cA = nA; cB = nB; ++ui;
        if constexpr (ALIGN_EPI) { if (wr == 1) PG8_BAR; }
    }
    PG8_WAIT_V(0);
    if constexpr (!ALIGN_EPI) { if (wr == 0) PG8_BAR; }
    PG8_BAR;
    if constexpr (Epi::AFTER_DRAIN) { E.fused(acc, cur, wr, wc, fr, fq, lds, wid, lane); S.done(cur); }
#undef PG8_SA
#undef PG8_SB
#undef PG8_STAGE
#undef PG8_LDA
#undef PG8_LDB
#undef PG8_MMA
#undef PG8_WAIT_V
#undef PG8_WAIT_L
#undef PG8_BAR
#undef PG8_SCHED
}
}
#define LAS __attribute__((address_space(3)))
typedef unsigned short bf16_t;
typedef short bf16x8 __attribute__((ext_vector_type(8)));
typedef float f32x4 __attribute__((ext_vector_type(4)));
typedef float f32x2 __attribute__((ext_vector_type(2)));
typedef unsigned u32x4 __attribute__((ext_vector_type(4)));
typedef unsigned u32x2 __attribute__((ext_vector_type(2)));
using pg8::cvt_pk_bf16;

constexpr int NTOK = 8192, DM = 1024, NEV = 3328, NOD = 3072, FF = 4096;
constexpr int LDS_BYTES = 147456;
constexpr size_t MiB = 1u << 20;
constexpr size_t WS_MODS = 0;
constexpr size_t WS_BAR = 492 * 1024;
constexpr size_t WS_TAB = 512 * 1024;
constexpr size_t WS_WINE = 2 * MiB, WS_WOUTE = 16 * MiB, WS_WINO = 20 * MiB, WS_WOUTO = 32 * MiB, WS_W1 = 36 * MiB, WS_W2 = 68 * MiB;
constexpr size_t WS_XN = 100 * MiB, WS_MIX = 116 * MiB;
constexpr size_t WS_CKS = 132 * MiB, WS_CVS = 133 * MiB, WS_CKD = 134 * MiB, WS_CVD = 142 * MiB;
constexpr size_t WS_P0 = 150 * MiB, WS_P1 = 278 * MiB;
constexpr size_t WS_PROJ = 150 * MiB, WS_HG = 198 * MiB, WS_OF = 278 * MiB, WS_OB = 294 * MiB, WS_H = 198 * MiB, WS_VT = 310 * MiB, WS_END = 326 * MiB;
constexpr size_t OUT_KS = 8388608, OUT_VS = 9437184, OUT_ST = 10485760, OUT_KD = 14680064, OUT_VD = 23068672;

struct Params { const float* in[27]; float* out; unsigned char* ws; int ph_lo, ph_hi; };
constexpr int PB_OFF = 143360;
struct PB {
    LAS unsigned char* l;
    __device__ __forceinline__ unsigned long long q(int i) const { const LAS unsigned* w = (const LAS unsigned*)(l + PB_OFF) + 2 * i; const unsigned lo = __builtin_amdgcn_readfirstlane(w[0]), hi = __builtin_amdgcn_readfirstlane(w[1]); return ((unsigned long long)hi << 32) | lo; }
    __device__ __forceinline__ const float* in(int i) const { return (const float*)q(i); }
    __device__ __forceinline__ float* out() const { return (float*)q(27); }
    __device__ __forceinline__ unsigned char* ws() const { return (unsigned char*)q(28); }
};

__device__ __forceinline__ float wave_sum(float v) {
#pragma unroll
    for (int o = 1; o < 64; o <<= 1) v += __shfl_xor(v, o);
    return v;
}

__device__ __forceinline__ void p0_transpose_item(const float* W, int K, int N, bf16_t* WT, bool hperm, LAS float* scr, int item, int lane) {
    const int nblk = N / 64, kb = item / nblk, nb = item % nblk, k0 = 64 * kb, n0 = 64 * nb;
    const float* wp = W + (size_t)(k0 + (lane >> 4)) * N + n0 + (lane & 15) * 4;
    f32x4 t4[16];
#pragma unroll
    for (int i = 0; i < 16; ++i) t4[i] = __builtin_nontemporal_load((const f32x4*)(wp + (size_t)(4 * i) * N));
#pragma unroll
    for (int i = 0; i < 16; ++i) { LAS float* d = scr + (4 * i + (lane >> 4)) * 65 + (lane & 15) * 4; d[0] = t4[i][0]; d[1] = t4[i][1]; d[2] = t4[i][2]; d[3] = t4[i][3]; }
    asm volatile("s_waitcnt lgkmcnt(0)" ::: "memory");
    const int c = lane & 7;
#pragma unroll
    for (int jj = 0; jj < 8; ++jj) { const int n = (lane >> 3) + 8 * jj; const LAS float* s = scr + (8 * c) * 65 + n;
        u32x4 o; o.x = cvt_pk_bf16(s[0 * 65], s[1 * 65]); o.y = cvt_pk_bf16(s[2 * 65], s[3 * 65]); o.z = cvt_pk_bf16(s[4 * 65], s[5 * 65]); o.w = cvt_pk_bf16(s[6 * 65], s[7 * 65]);
        const int col = n0 + n; int drow = col;
        if (hperm) { const int cc = col & 255; drow = (col & ~255) + ((cc >> 5) & 1) * 128 + (cc >> 6) * 32 + (cc & 31); }
        *(u32x4*)(WT + (size_t)drow * K + k0 + 8 * c) = o; }
    asm volatile("s_waitcnt lgkmcnt(0)" ::: "memory");
}

__device__ __forceinline__ void convert_layer_a(const PB p, LAS unsigned char* lds, int L, int rank, int nw, int LW2) {
    const int tid = tid_l(), lane = tid & 63, wave = __builtin_amdgcn_readfirstlane(tid >> 6);
    unsigned char* ws = p.ws();
    LAS float* scr = (LAS float*)(lds + wave * 16640);
    const int odd = L & 1, j = L >> 1;
    const int I_IN = L < 0 ? 0 : (odd ? 16 * (NOD / 64) : 16 * (NEV / 64)), I_SQ = L < 0 ? 0 : 256, I_W = L < 0 ? 0 : 1024;
    const int nitems = I_IN + I_SQ + I_W + (LW2 >= 0 ? 1024 : 0);
    for (int it = rank; it < nitems; it += nw) {
        int r = it, jj, K = DM, N = DM, srci; size_t dof; bool hp = false;
        if (r >= I_IN + I_SQ + I_W) { r -= I_IN + I_SQ + I_W; srci = 26; K = FF; jj = LW2; dof = WS_W2 + (size_t)LW2 * DM * FF * 2; }
        else if (r < I_IN) { srci = odd ? 19 : 12; N = odd ? NOD : NEV; hp = true; jj = j; dof = (odd ? WS_WINO : WS_WINE) + (size_t)j * N * DM * 2; }
        else if ((r -= I_IN) < I_SQ) { srci = odd ? 20 : 13; jj = j; dof = (odd ? WS_WOUTO : WS_WOUTE) + (size_t)j * DM * DM * 2; }
        else { r -= I_SQ; srci = 25; N = FF; jj = L; dof = WS_W1 + (size_t)L * FF * DM * 2; }
        p0_transpose_item(p.in(srci) + (size_t)jj * K * N, K, N, (bf16_t*)(ws + dof), hp, scr, r, lane);
    }
}
__device__ __forceinline__ void phase0(const PB p, LAS unsigned char* lds) {
    const int tid = tid_l(), lane = tid & 63, wave = __builtin_amdgcn_readfirstlane(tid >> 6);
    const int G = gridDim.x, bid = blockIdx.x;
    unsigned char* ws = p.ws();
    {
        LAS float* scr = (LAS float*)(lds + wave * 16640);
        const int gw = bid * 8 + wave, NGW = G * 8;
        constexpr int I_INE = 16 * (NEV / 64), I_SQ = 16 * 16, I_INO = 16 * (NOD / 64), I_W1 = 16 * (FF / 64), I_W2 = 64 * 16;
        constexpr int I_CVD = 8 * 16, I_CVS = 8 * 2;
        constexpr int NITEMS = I_INE + I_SQ + I_W1 + 1 * I_W2 + 8 * I_CVD + 8 * I_CVS;
        for (int it = gw; it < NITEMS; it += NGW) {
            int r = it, jj = 0, K = DM, N = DM, srci = 26; size_t dof; bool hp = false;
            if (r < I_INE) { srci = 12; N = NEV; hp = true; dof = WS_WINE; }
            else if ((r -= I_INE) < I_SQ) { srci = 13; dof = WS_WOUTE; }
            else if ((r -= I_SQ) < I_W1) { srci = 25; N = FF; dof = WS_W1; }
            else if ((r -= I_W1) < 1 * I_W2) { srci = 26; K = FF; dof = WS_W2; }
            else if ((r -= 1 * I_W2) < 8 * I_CVD) { jj = r / I_CVD; r -= jj * I_CVD; srci = 6; K = 512; N = 1024; dof = WS_CVD + (size_t)jj * 1024 * 512 * 2; }
            else { r -= 8 * I_CVD; jj = r / I_CVS; r -= jj * I_CVS; srci = 3; K = 512; N = 128; dof = WS_CVS + (size_t)jj * 128 * 512 * 2; }
            p0_transpose_item(p.in(srci) + (size_t)jj * K * N, K, N, (bf16_t*)(ws + dof), hp, scr, r, lane);
        }
    }
    {
        float* mods = (float*)(ws + WS_MODS);
        LAS float* s = (LAS float*)lds; LAS float* red = (LAS float*)(lds + 20480);
        for (int u = bid; u < 192; u += G) {
            const int li = u / 48, nc = u % 48;
            __syncthreads();
            for (int e = tid; e < 5120; e += 512) { const int cnd = e >> 10, k = e & 1023; const float cv = (cnd == 0) ? p.in(8)[k] : p.in(7)[(cnd - 1) * 1024 + k]; s[e] = cv / (1.f + __expf(-cv)); }
            __syncthreads();
            const int kg = tid >> 5, cq = tid & 31;
            const float* w = p.in(10) + ((size_t)li * 1024 + kg * 64) * 6144 + nc * 128 + cq * 4;
            const LAS float* sk = s + kg * 64;
            f32x4 a0 = {0.f, 0.f, 0.f, 0.f}, a1 = a0, a2 = a0, a3 = a0, a4 = a0;
#pragma unroll
            for (int kb = 0; kb < 4; ++kb) { f32x4 wv[16];
#pragma unroll
                for (int k = 0; k < 16; ++k) wv[k] = __builtin_nontemporal_load((const f32x4*)(w + (size_t)(16 * kb + k) * 6144));
#pragma unroll
                for (int k = 0; k < 16; ++k) { const int kk = 16 * kb + k; a0 += wv[k] * sk[kk]; a1 += wv[k] * sk[1024 + kk]; a2 += wv[k] * sk[2048 + kk]; a3 += wv[k] * sk[3072 + kk]; a4 += wv[k] * sk[4096 + kk]; } }
            *(LAS f32x4*)(red + (kg * 5 + 0) * 128 + cq * 4) = a0; *(LAS f32x4*)(red + (kg * 5 + 1) * 128 + cq * 4) = a1; *(LAS f32x4*)(red + (kg * 5 + 2) * 128 + cq * 4) = a2;
            *(LAS f32x4*)(red + (kg * 5 + 3) * 128 + cq * 4) = a3; *(LAS f32x4*)(red + (kg * 5 + 4) * 128 + cq * 4) = a4;
            __syncthreads();
            for (int e = tid; e < 640; e += 512) { const int c = e >> 7, cl = e & 127; float sum = 0.f;
#pragma unroll
                for (int g2 = 0; g2 < 16; ++g2) sum += red[(g2 * 5 + c) * 128 + cl];
                mods[(size_t)(li * 5 + c) * 6144 + nc * 128 + cl] = sum + p.in(11)[li * 6144 + nc * 128 + cl]; }
        }
    }
    if (bid == G - 1) {
        float* tab = (float*)(ws + WS_TAB);
        for (int e = tid; e < 1024; e += 512) { const float l0 = p.in(14)[e], l1 = p.in(14)[1024 + e]; tab[e] = 0.f; tab[1024 + e] = 1.f / (1.f + __expf(l0 - l1)); }
        if (tid < 2) { const int jj = tid; const float* lp = p.in(23) + jj * 256; float d1 = 0.f, d2 = 0.f;
            for (int i = 0; i < 64; ++i) { d1 += lp[i] * lp[64 + i]; d2 += lp[128 + i] * lp[192 + i]; }
            const float li_ = (float)(2 * jj + 1); const float lam_init = 0.8f - 0.6f * expf(-0.3f * li_);
            tab[2048 + jj] = expf(d1) - expf(d2) + lam_init; tab[2050 + jj] = lam_init; }
        for (int e = tid; e < 1024; e += 512) { const int pos = e >> 4, f = e & 15;
            const float inv = exp2f(-(float)(2 * f) * (13.287712379549449f / 32.0f));
            const float a = (float)pos * inv;
            const float kk = rintf(a * 0.15915494309189535f); float rr = fmaf(-kk, 6.2831854820251465f, a); rr = fmaf(-kk, -1.7484555e-7f, rr);
            tab[4096 + e * 2] = __cosf(rr); tab[4096 + e * 2 + 1] = __sinf(rr); }
    }
    {
        const size_t gt = (size_t)bid * 512 + tid, GT = (size_t)G * 512;
#define CVT_ARR(SRC, DST, N4) for (size_t i = gt; i < (size_t)(N4); i += GT) { const f32x4 v = ((const f32x4*)(SRC))[i]; u32x2 w; w.x = cvt_pk_bf16(v[0], v[1]); w.y = cvt_pk_bf16(v[2], v[3]); ((u32x2*)(DST))[i] = w; }
        CVT_ARR(p.in(2), ws + WS_CKS, 131072) CVT_ARR(p.in(5), ws + WS_CKD, 1048576)
#undef CVT_ARR
    }
}

__device__ __forceinline__ f32x4 bf4(u32x2 w) { f32x4 r; r[0] = __builtin_bit_cast(float, w.x << 16); r[1] = __builtin_bit_cast(float, w.x & 0xffff0000u); r[2] = __builtin_bit_cast(float, w.y << 16); r[3] = __builtin_bit_cast(float, w.y & 0xffff0000u); return r; }
__device__ __forceinline__ void norm_phase(const PB p, int mode, int li, int which, int gate_off) {
    const int tid = tid_l(), lane = tid & 63, wave = tid >> 6;
    const int gw = blockIdx.x * 8 + wave, NGW = gridDim.x * 8;
    unsigned char* ws = p.ws();
    const float* mods = (const float*)(ws + WS_MODS);
    const bf16_t* P0 = (const bf16_t*)(ws + WS_P0); const bf16_t* P1 = (const bf16_t*)(ws + WS_P1);
    bf16_t* XN = (bf16_t*)(ws + WS_XN);
    float* xo = p.out();
    const float* nw = p.in(9) + (li * 2 + which) * 1024;
    const float* x0 = p.in(0); const float* x1 = p.in(1);
    for (int grp = gw; grp < NTOK / 4; grp += NGW) {
        const int row0 = grp * 4; const int cond = row0 < 4096 ? 0 : 1 + ((row0 - 4096) >> 10);
        const float* md = mods + (size_t)(li * 5 + cond) * 6144 + which * 3072;
        f32x4 g4[4], w4[4], sh4[4], sc4[4];
#pragma unroll
        for (int jj = 0; jj < 4; ++jj) { const int c = 4 * lane + 256 * jj;
            if (mode != 0) g4[jj] = *(const f32x4*)(mods + gate_off + cond * 6144 + c);
            if (mode != 2) { w4[jj] = *(const f32x4*)(nw + c); sh4[jj] = *(const f32x4*)(md + c); sc4[jj] = *(const f32x4*)(md + 1024 + c); } }
#pragma unroll
        for (int hh = 0; hh < 2; ++hh) {
            f32x4 x[2][4]; u32x2 a0[2][4], a1[2][4];
#pragma unroll
            for (int rr = 0; rr < 2; ++rr) { const int row = row0 + 2 * hh + rr;
                const float* xr = mode == 0 ? (row < 4096 ? x0 + (size_t)row * 1024 : x1 + (size_t)(row - 4096) * 1024) : xo + (size_t)row * 1024;
#pragma unroll
                for (int jj = 0; jj < 4; ++jj) { const int c = 4 * lane + 256 * jj; x[rr][jj] = __builtin_nontemporal_load((const f32x4*)(xr + c));
                    if (mode != 0) { a0[rr][jj] = __builtin_nontemporal_load((const u32x2*)(P0 + (size_t)row * 1024 + c)); a1[rr][jj] = __builtin_nontemporal_load((const u32x2*)(P1 + (size_t)row * 1024 + c)); } } }
#pragma unroll
            for (int rr = 0; rr < 2; ++rr) { const int row = row0 + 2 * hh + rr; float ss = 0.f;
#pragma unroll
                for (int jj = 0; jj < 4; ++jj) { const int c = 4 * lane + 256 * jj;
                    if (mode != 0) x[rr][jj] = x[rr][jj] + g4[jj] * (bf4(a0[rr][jj]) + bf4(a1[rr][jj]));
                    ss += (x[rr][jj][0] * x[rr][jj][0] + x[rr][jj][1] * x[rr][jj][1]) + (x[rr][jj][2] * x[rr][jj][2] + x[rr][jj][3] * x[rr][jj][3]);
                    __builtin_nontemporal_store(x[rr][jj], (f32x4*)(xo + (size_t)row * 1024 + c)); }
                if (mode != 2) {
                    const float rstd = rsqrtf(wave_sum(ss) * (1.f / 1024.f) + 1e-6f);
#pragma unroll
                    for (int jj = 0; jj < 4; ++jj) { const int c = 4 * lane + 256 * jj;
                        const f32x4 o = x[rr][jj] * rstd * w4[jj] * (1.f + sc4[jj]) + sh4[jj];
                        u32x2 pk; pk.x = cvt_pk_bf16(o[0], o[1]); pk.y = cvt_pk_bf16(o[2], o[3]);
                        *(u32x2*)(XN + (size_t)row * 1024 + c) = pk; } } }
        }
    }
}

constexpr int HC_QP = 0, HC_QPP = 17408, HC_KP = 34816, HC_KT = 52224, HC_VT = 70656, HC_ST = 89088, HC_P = 123904, HC_SC = 133120;
__device__ __forceinline__ float exp_c(float x) { return __builtin_amdgcn_exp2f(fminf(x, 115.f)); }
__device__ __forceinline__ unsigned short bf16r(float x) { return (unsigned short)(cvt_pk_bf16(x, 0.f) & 0xffffu); }
template <int BWD, int DIR> __device__ __forceinline__ void hc_load(float (&rq)[16], float (&rf)[16], float (&rv)[16], const GAS float* base) {
    constexpr int st = DIR ? -2560 : 2560, fo = 512 + DIR * 512;
    asm volatile("" : "+v"(base));
#pragma unroll
    for (int i = 0; i < 16; ++i) { const GAS float* rp = base + (BWD ? -i : i) * st; rq[i] = rp[0]; rf[i] = rp[fo]; rv[i] = rp[1536]; }
}
template <int BWD> __device__ __forceinline__ void hc_pass2(const float (&rq)[16], const float (&rf)[16], const float (&rv)[16], const float (&rel)[16], float off, float ecm, int ch, int anchor,
        LAS unsigned short* QP, LAS unsigned short* QPP, LAS unsigned short* KP, LAS unsigned short* KT, LAS unsigned short* VT, bool vmine) {
    LAS unsigned short* qp_ = QP + anchor * 136 + ch; LAS unsigned short* qpp_ = QPP + anchor * 136 + ch; LAS unsigned short* kp_ = KP + anchor * 136 + ch;
    unsigned kk[16];
#pragma unroll
    for (int i = 0; i < 16; ++i) { const int d = BWD ? -i : i; const float r = rel[i] + off;
        const float qp = rq[i] * exp_c(r); const float kp = (1.f - rf[i]) * exp_c(-r);
        qp_[d * 136] = bf16r(qp); qpp_[d * 136] = bf16r(qp * ecm); const unsigned short k16 = bf16r(kp); kp_[d * 136] = k16; kk[BWD ? 15 - i : i] = k16; }
    const int t0 = BWD ? anchor - 15 : anchor;
    u32x4 w0, w1, v0, v1;
    w0.x = kk[0] | (kk[1] << 16); w0.y = kk[2] | (kk[3] << 16); w0.z = kk[4] | (kk[5] << 16); w0.w = kk[6] | (kk[7] << 16);
    w1.x = kk[8] | (kk[9] << 16); w1.y = kk[10] | (kk[11] << 16); w1.z = kk[12] | (kk[13] << 16); w1.w = kk[14] | (kk[15] << 16);
#define RV(e_) rv[BWD ? 15 - (e_) : (e_)]
    v0.x = cvt_pk_bf16(RV(0), RV(1)); v0.y = cvt_pk_bf16(RV(2), RV(3)); v0.z = cvt_pk_bf16(RV(4), RV(5)); v0.w = cvt_pk_bf16(RV(6), RV(7));
    v1.x = cvt_pk_bf16(RV(8), RV(9)); v1.y = cvt_pk_bf16(RV(10), RV(11)); v1.z = cvt_pk_bf16(RV(12), RV(13)); v1.w = cvt_pk_bf16(RV(14), RV(15));
#undef RV
    *(LAS u32x4*)(KT + ch * 72 + t0) = w0; *(LAS u32x4*)(KT + ch * 72 + t0 + 8) = w1;
    if (vmine) { *(LAS u32x4*)(VT + (ch & 63) * 72 + t0) = v0; *(LAS u32x4*)(VT + (ch & 63) * 72 + t0 + 8) = v1; }
}
template <int DIR>
__device__ __forceinline__ void hgrn_chunked_item(const PB p, LAS unsigned char* lds, int j, int s, int h, int vh) {
    constexpr int dir = DIR;
    const int tid = tid_l(), lane = tid & 63, fr = lane & 15, fq = lane >> 4; const int w = __builtin_amdgcn_readfirstlane(tid >> 6);
    const int L = s < 16 ? 256 : 1024, R0 = s < 16 ? s * 256 : 4096 + (s - 16) * 1024;
    const GAS float* hg = (const GAS float*)(p.ws() + WS_HG);
    GAS float* og = (GAS float*)(p.ws() + (dir ? WS_OB : WS_OF));
    LAS unsigned short* QP = (LAS unsigned short*)(lds + HC_QP); LAS unsigned short* QPP = (LAS unsigned short*)(lds + HC_QPP); LAS unsigned short* KP = (LAS unsigned short*)(lds + HC_KP);
    LAS unsigned short* KT = (LAS unsigned short*)(lds + HC_KT); LAS unsigned short* VT = (LAS unsigned short*)(lds + HC_VT); LAS unsigned short* ST = (LAS unsigned short*)(lds + HC_ST);
    LAS unsigned short* PM = (LAS unsigned short*)(lds + HC_P); LAS float* scal = (LAS float*)(lds + HC_SC);
    const int vb = w & 3, kh = w >> 2;
    f32x4 S[4];
    if (s >= 16) { const GAS float* st = (const GAS float*)p.in(4) + ((((size_t)(s - 16) * 2 + j) * 2 + dir) * 4 + h) * 16384;
#pragma unroll
        for (int kb = 0; kb < 4; ++kb) S[kb] = *(const GAS f32x4*)(st + (size_t)(16 * (4 * kh + kb) + fr) * 128 + 64 * vh + 16 * vb + 4 * fq); }
    else {
#pragma unroll
        for (int kb = 0; kb < 4; ++kb) S[kb] = (f32x4){0.f, 0.f, 0.f, 0.f}; }
    const int quarter = __builtin_amdgcn_readfirstlane(tid >> 7); const bool bwd = quarter < 2; const int ch = tid & 127;
    const int anchor = quarter == 0 ? 15 : quarter == 1 ? 31 : quarter == 2 ? 32 : 48;
    constexpr int st = dir ? -2560 : 2560;
    const GAS float* row0 = hg + (size_t)(R0 + (dir ? L - 1 : 0)) * 2560 + h * 128;
    float rq[16], rf[16], rv[16];
    float nq[16], nf[16], nv[16];
#define HC_LOAD(cc_, Q_, F_, V_) do { const GAS float* rc_ = row0 + ((long)(cc_) * 64 + anchor) * st + ch; if (bwd) hc_load<1, DIR>(Q_, F_, V_, rc_); else hc_load<0, DIR>(Q_, F_, V_, rc_); } while (0)
    HC_LOAD(0, rq, rf, rv);
    LDS_BARRIER();
#pragma unroll
    for (int kb = 0; kb < 4; ++kb)
#pragma unroll
        for (int r = 0; r < 4; ++r) ST[(16 * vb + 4 * fq + r) * 136 + 16 * (4 * kh + kb) + fr] = bf16r(S[kb][r]);
    const int nchunk = L >> 6;
    for (int c = 0; c < nchunk; ++c) {
        float rel[16];
        if (c + 1 < nchunk) HC_LOAD(c + 1, nq, nf, nv);
        { float cc = 0.f;
#pragma unroll
            for (int i = 0; i < 16; ++i) { const float g = __builtin_amdgcn_logf(rf[i]);   if (!bwd) { cc += g; rel[i] = cc; } else { rel[i] = -cc; cc += g; } }
            scal[quarter * 128 + ch] = cc; }
        LDS_BARRIER();
        { const float t0 = scal[ch], t1 = scal[128 + ch], t2 = scal[256 + ch], t3 = scal[384 + ch];
            const float off = quarter == 0 ? -t1 : quarter == 3 ? t2 : 0.f; const float cm = t0 + t1;
            if (quarter == 1) scal[512 + ch] = cm; if (quarter == 2) scal[640 + ch] = t2 + t3;
            const float ecm = exp_c(cm);
            const bool vmine = (ch >> 6) == vh;
            if (bwd) hc_pass2<1>(rq, rf, rv, rel, off, ecm, ch, anchor, QP, QPP, KP, KT, VT, vmine); else hc_pass2<0>(rq, rf, rv, rel, off, ecm, ch, anchor, QP, QPP, KP, KT, VT, vmine); }
        LDS_BARRIER();
        { const int tb = w & 3, sh = w >> 2; const int t = 16 * tb + fr;
#pragma unroll
            for (int sbi = 0; sbi < 2; ++sbi) { const int sb = 2 * sh + sbi; f32x4 a = {0.f, 0.f, 0.f, 0.f};
                if (sb <= tb) {
#pragma unroll
                    for (int ks = 0; ks < 4; ++ks) { const bf16x8 A = *(const LAS bf16x8*)(KP + (16 * sb + fr) * 136 + 32 * ks + 8 * fq); const bf16x8 B = *(const LAS bf16x8*)(QP + (16 * tb + fr) * 136 + 32 * ks + 8 * fq);
                        a = __builtin_amdgcn_mfma_f32_16x16x32_bf16(A, B, a, 0, 0, 0); } }
#pragma unroll
                for (int r = 0; r < 4; ++r) if (16 * sb + 4 * fq + r > t) a[r] = 0.f;
                u32x2 wv; wv.x = cvt_pk_bf16(a[0], a[1]); wv.y = cvt_pk_bf16(a[2], a[3]);
                *(LAS u32x2*)(PM + t * 72 + 16 * sb + 4 * fq) = wv; } }
        LDS_BARRIER();
        { bf16x8 vt[2], stf[4];
#pragma unroll
            for (int sl = 0; sl < 2; ++sl) vt[sl] = *(const LAS bf16x8*)(VT + (16 * vb + fr) * 72 + 32 * sl + 8 * fq);
#pragma unroll
            for (int ks = 0; ks < 4; ++ks) stf[ks] = *(const LAS bf16x8*)(ST + (16 * vb + fr) * 136 + 32 * ks + 8 * fq);
            GAS float* ob = og + (size_t)(R0 + (dir ? L - 1 : 0)) * 512 + (long)c * 64 * (dir ? -512 : 512) + h * 128 + 64 * vh + 16 * vb + 4 * fq;
#pragma unroll
            for (int tbi = 0; tbi < 2; ++tbi) { const int tb = 2 * kh + tbi; f32x4 o = {0.f, 0.f, 0.f, 0.f};
#pragma unroll
                for (int sl = 0; sl < 2; ++sl) if (32 * sl <= 16 * tb + 15) { const bf16x8 B = *(const LAS bf16x8*)(PM + (16 * tb + fr) * 72 + 32 * sl + 8 * fq); o = __builtin_amdgcn_mfma_f32_16x16x32_bf16(vt[sl], B, o, 0, 0, 0); }
#pragma unroll
                for (int ks = 0; ks < 4; ++ks) { const bf16x8 B = *(const LAS bf16x8*)(QPP + (16 * tb + fr) * 136 + 32 * ks + 8 * fq); o = __builtin_amdgcn_mfma_f32_16x16x32_bf16(stf[ks], B, o, 0, 0, 0); }
                *(GAS f32x4*)(ob + (long)(16 * tb + fr) * (dir ? -512 : 512)) = o; }
#pragma unroll
            for (int kbi = 0; kbi < 4; ++kbi) { const int kb = 4 * kh + kbi; const float cmv = scal[512 + 16 * kb + fr], r63 = scal[640 + 16 * kb + fr]; const float dec = exp_c(cmv + r63), e63 = exp_c(r63);
                f32x4 tt = {0.f, 0.f, 0.f, 0.f};
#pragma unroll
                for (int sl = 0; sl < 2; ++sl) { const bf16x8 B = *(const LAS bf16x8*)(KT + (16 * kb + fr) * 72 + 32 * sl + 8 * fq); tt = __builtin_amdgcn_mfma_f32_16x16x32_bf16(vt[sl], B, tt, 0, 0, 0); }
                S[kbi] = S[kbi] * dec + tt * e63; } }
        LDS_BARRIER();
#pragma unroll
        for (int kb = 0; kb < 4; ++kb)
#pragma unroll
            for (int r = 0; r < 4; ++r) ST[(16 * vb + 4 * fq + r) * 136 + 16 * (4 * kh + kb) + fr] = bf16r(S[kb][r]);
#pragma unroll
        for (int i = 0; i < 16; ++i) { rq[i] = nq[i]; rf[i] = nf[i]; rv[i] = nv[i]; }
    }
#undef HC_LOAD
    if (s < 16) { GAS float* so = (GAS float*)p.out() + OUT_ST + ((((size_t)s * 2 + j) * 2 + dir) * 4 + h) * 16384;
#pragma unroll
        for (int kb = 0; kb < 4; ++kb) *(GAS f32x4*)(so + (size_t)(16 * (4 * kh + kb) + fr) * 128 + 64 * vh + 16 * vb + 4 * fq) = S[kb]; }
}
__device__ __forceinline__ void hgrn_chunked_dispatch(const PB p, LAS unsigned char* lds, int j, int it) {
    const int s = it >> 4, h = (it >> 2) & 3, vh = it & 1;
    if (it & 2) hgrn_chunked_item<1>(p, lds, j, s, h, vh); else hgrn_chunked_item<0>(p, lds, j, s, h, vh);
}
__device__ __forceinline__ void hgrn_readout(const PB p, int j) {
    const int tid = tid_l(), lane = tid & 63, wave = tid >> 6;
    const int gw = blockIdx.x * 8 + wave, NGW = gridDim.x * 8;
    const float* of = (const float*)(p.ws() + WS_OF); const float* ob = (const float*)(p.ws() + WS_OB); const float* hg = (const float*)(p.ws() + WS_HG);
    bf16_t* MIX = (bf16_t*)(p.ws() + WS_MIX);
    const int col = (lane >> 4) * 128 + (lane & 15) * 8;
    const float* nw = p.in(15) + j * 128 + (lane & 15) * 8;
    const f32x4 w0 = *(const f32x4*)nw, w1 = *(const f32x4*)(nw + 4);
    for (int row = gw; row < NTOK; row += NGW) {
        const f32x4 a0 = *(const f32x4*)(of + (size_t)row * 512 + col) + *(const f32x4*)(ob + (size_t)row * 512 + col);
        const f32x4 a1 = *(const f32x4*)(of + (size_t)row * 512 + col + 4) + *(const f32x4*)(ob + (size_t)row * 512 + col + 4);
        const f32x4 g0 = *(const f32x4*)(hg + (size_t)row * 2560 + 2048 + col), g1 = *(const f32x4*)(hg + (size_t)row * 2560 + 2048 + col + 4);
        float ss = (a0[0] * a0[0] + a0[1] * a0[1]) + (a0[2] * a0[2] + a0[3] * a0[3]) + (a1[0] * a1[0] + a1[1] * a1[1]) + (a1[2] * a1[2] + a1[3] * a1[3]);
        ss += __shfl_xor(ss, 1); ss += __shfl_xor(ss, 2); ss += __shfl_xor(ss, 4); ss += __shfl_xor(ss, 8);
        const float rs = rsqrtf(ss * (1.f / 128.f) + 1e-6f);
        f32x4 o0, o1;
#pragma unroll
        for (int i = 0; i < 4; ++i) { o0[i] = a0[i] * rs * w0[i] * g0[i] * __builtin_amdgcn_rcpf(1.f + __expf(-g0[i])); o1[i] = a1[i] * rs * w1[i] * g1[i] * __builtin_amdgcn_rcpf(1.f + __expf(-g1[i])); }
        u32x4 w; w.x = cvt_pk_bf16(o0[0], o0[1]); w.y = cvt_pk_bf16(o0[2], o0[3]); w.z = cvt_pk_bf16(o1[0], o1[1]); w.w = cvt_pk_bf16(o1[2], o1[3]);
        *(u32x4*)(MIX + (size_t)row * 1024 + col) = w;
    }
}

struct ASeg { const GAS bf16_t* K; const GAS bf16_t* V; int ldk, ldv, kpos0, ntiles, masked; };
template <int DV>
__device__ __forceinline__ void attn_tile(const LAS unsigned char* Ks, const LAS unsigned char* VT, bool msk, int kp0, int qpos, float c2, const bf16x8 qf0, const bf16x8 qf1, int fr, int fq, f32x4 (&o)[DV / 16], float& m, float& l) {
    f32x4 sc[4];
#pragma unroll
    for (int b = 0; b < 4; ++b) {
        const bf16x8 k0 = *(const LAS bf16x8*)(Ks + (16 * b + fr) * 144 + fq * 16), k1 = *(const LAS bf16x8*)(Ks + (16 * b + fr) * 144 + 64 + fq * 16);
        f32x4 a = {0.f, 0.f, 0.f, 0.f};
        a = __builtin_amdgcn_mfma_f32_16x16x32_bf16(k0, qf0, a, 0, 0, 0);
        a = __builtin_amdgcn_mfma_f32_16x16x32_bf16(k1, qf1, a, 0, 0, 0);
        sc[b] = a;
    }
    float mx = -1e30f; unsigned vmask = 0xffffu;
#pragma unroll
    for (int b = 0; b < 4; ++b)
#pragma unroll
        for (int r = 0; r < 4; ++r) { float v = sc[b][r];
            if (msk) { const int d = qpos - (kp0 + 32 * (b >> 1) + 4 * (b & 1) + r); if (d > 128 || d < -128) { v = -1e30f; vmask &= ~(1u << (b * 4 + r)); } }
            sc[b][r] = v; mx = fmaxf(mx, v); }
    mx *= c2;
    { auto r16 = __builtin_amdgcn_permlane16_swap(__float_as_uint(mx), __float_as_uint(mx), false, false); mx = fmaxf(__uint_as_float(r16[0]), __uint_as_float(r16[1]));
      auto r32 = __builtin_amdgcn_permlane32_swap(__float_as_uint(mx), __float_as_uint(mx), false, false); mx = fmaxf(__uint_as_float(r32[0]), __uint_as_float(r32[1])); }
    const float mn = fmaxf(m, mx); const float alpha = __builtin_amdgcn_exp2f(m - mn); m = mn;
    l *= alpha;
#pragma unroll
    for (int db = 0; db < DV / 16; ++db) o[db] = o[db] * alpha;
    float ls = 0.f;
#pragma unroll
    for (int b = 0; b < 4; ++b)
#pragma unroll
        for (int r = 0; r < 4; ++r) { float pr = __builtin_amdgcn_exp2f(fmaf(sc[b][r], c2, -mn)); if (msk && !((vmask >> (b * 4 + r)) & 1u)) pr = 0.f; sc[b][r] = pr; ls += pr; }
    l += ls;
    bf16x8 pf[2];
#pragma unroll
    for (int ks = 0; ks < 2; ++ks) { u32x4 w; w.x = cvt_pk_bf16(sc[2 * ks][0], sc[2 * ks][1]); w.y = cvt_pk_bf16(sc[2 * ks][2], sc[2 * ks][3]); w.z = cvt_pk_bf16(sc[2 * ks + 1][0], sc[2 * ks + 1][1]); w.w = cvt_pk_bf16(sc[2 * ks + 1][2], sc[2 * ks + 1][3]); pf[ks] = __builtin_bit_cast(bf16x8, w); }
#pragma unroll
    for (int db = 0; db < DV / 16; ++db)
#pragma unroll
        for (int ks = 0; ks < 2; ++ks) { const bf16x8 vv = *(const LAS bf16x8*)(VT + (16 * db + fr) * 144 + ks * 64 + fq * 16);
            o[db] = __builtin_amdgcn_mfma_f32_16x16x32_bf16(vv, pf[ks], o[db], 0, 0, 0); }
}
template <int DV>
__device__ __forceinline__ void attn_run(LAS unsigned char* lds, const GAS bf16_t* Qw, int qpos, const ASeg A, const ASeg B, float c2, f32x4 (&o)[DV / 16], float& m, float& l) {
    constexpr int BUF = 9216 + DV * 144;
    const int tid = tid_l(), lane = tid & 63, fr = lane & 15, fq = lane >> 4;
    const bf16x8 qf0 = *(const GAS bf16x8*)(Qw + fq * 8), qf1 = *(const GAS bf16x8*)(Qw + 32 + fq * 8);
    const int nt = A.ntiles + B.ntiles;
    const int kkey = tid >> 3, kch = tid & 7;
    const int krow = 32 * (kkey >> 5) + 16 * ((kkey >> 2) & 1) + 4 * ((kkey >> 3) & 3) + (kkey & 3);
    u32x4 kreg, vreg[DV / 64];
#define AT_LOAD(i_) do { const bool inA_ = (i_) < A.ntiles; const int ti_ = inA_ ? (i_) : (i_) - A.ntiles; const GAS bf16_t* kp_ = inA_ ? A.K : B.K; const GAS bf16_t* vp_ = inA_ ? A.V : B.V; const int ldk_ = inA_ ? A.ldk : B.ldk, ldv_ = inA_ ? A.ldv : B.ldv; \
        kreg = *(const GAS u32x4*)(kp_ + (size_t)(ti_ * 64 + kkey) * ldk_ + kch * 8); \
        _Pragma("unroll") for (int pp_ = 0; pp_ < DV / 64; ++pp_) vreg[pp_] = *(const GAS u32x4*)(vp_ + (size_t)(kkey + 64 * pp_) * ldv_ + ti_ * 64 + kch * 8); } while (0)
#define AT_STORE(b_) do { LAS unsigned char* kb_ = lds + (b_) * BUF; *(LAS u32x4*)(kb_ + krow * 144 + kch * 16) = kreg; \
        _Pragma("unroll") for (int pp_ = 0; pp_ < DV / 64; ++pp_) *(LAS u32x4*)(kb_ + 9216 + (kkey + 64 * pp_) * 144 + kch * 16) = vreg[pp_]; } while (0)
    AT_LOAD(0);
    LDS_BARRIER();
    AT_STORE(0);
    if (nt > 1) AT_LOAD(1);
    LDS_BARRIER();
    for (int it = 0; it < nt; ++it) {
        const LAS unsigned char* Ks = lds + (it & 1) * BUF;
        attn_tile<DV>(Ks, Ks + 9216, (it < A.ntiles) && A.masked, A.kpos0 + it * 64 + 8 * fq, qpos, c2, qf0, qf1, fr, fq, o, m, l);
        if (it + 1 < nt) { AT_STORE((it + 1) & 1); if (it + 2 < nt) AT_LOAD(it + 2); }
        LDS_BARRIER();
    }
#undef AT_LOAD
#undef AT_STORE
}
__device__ __forceinline__ void diff_attn_run(LAS unsigned char* lds, const GAS bf16_t* Qw, int nA, int nB, const GAS bf16_t* KA, int ldkA, const GAS bf16_t* VA, int ldvA, const GAS bf16_t* KB, int ldkB, const GAS bf16_t* VB, int ldvB,
        float c2, f32x4 (&o0)[8], f32x4 (&o1)[8], float& m0, float& l0, float& m1, float& l1) {
    constexpr int BUF = 36864;
    const int tid = tid_l(), lane = tid & 63, fr = lane & 15, fq = lane >> 4;
    const bf16x8 q00 = *(const GAS bf16x8*)(Qw + fq * 8), q01 = *(const GAS bf16x8*)(Qw + 32 + fq * 8), q10 = *(const GAS bf16x8*)(Qw + 64 + fq * 8), q11 = *(const GAS bf16x8*)(Qw + 96 + fq * 8);
    const int nt = nA + nB;
    const int kkey = tid >> 3, kch = tid & 7;
    const int krow = 32 * (kkey >> 5) + 16 * ((kkey >> 2) & 1) + 4 * ((kkey >> 3) & 3) + (kkey & 3);
    u32x4 k0r, k1r, vreg[2];
#define DA_LOAD(i_) do { const bool inA_ = (i_) < nA; const int ti_ = inA_ ? (i_) : (i_) - nA; const GAS bf16_t* kp_ = (inA_ ? KA : KB) + (size_t)(ti_ * 64 + kkey) * (inA_ ? ldkA : ldkB) + kch * 8; const GAS bf16_t* vp_ = inA_ ? VA : VB; const int ldv_ = inA_ ? ldvA : ldvB; \
        k0r = *(const GAS u32x4*)kp_; k1r = *(const GAS u32x4*)(kp_ + 64); \
        _Pragma("unroll") for (int pp_ = 0; pp_ < 2; ++pp_) vreg[pp_] = *(const GAS u32x4*)(vp_ + (size_t)(kkey + 64 * pp_) * ldv_ + ti_ * 64 + kch * 8); } while (0)
#define DA_STORE(b_) do { LAS unsigned char* kb_ = lds + (b_) * BUF; *(LAS u32x4*)(kb_ + krow * 144 + kch * 16) = k0r; *(LAS u32x4*)(kb_ + 9216 + krow * 144 + kch * 16) = k1r; \
        _Pragma("unroll") for (int pp_ = 0; pp_ < 2; ++pp_) *(LAS u32x4*)(kb_ + 18432 + (kkey + 64 * pp_) * 144 + kch * 16) = vreg[pp_]; } while (0)
    DA_LOAD(0);
    LDS_BARRIER();
    DA_STORE(0);
    if (nt > 1) DA_LOAD(1);
    LDS_BARRIER();
    for (int it = 0; it < nt; ++it) {
        const LAS unsigned char* Ks = lds + (it & 1) * BUF;
        attn_tile<128>(Ks, Ks + 18432, false, 0, 0, c2, q00, q01, fr, fq, o0, m0, l0);
        attn_tile<128>(Ks + 9216, Ks + 18432, false, 0, 0, c2, q10, q11, fr, fq, o1, m1, l1);
        if (it + 1 < nt) { DA_STORE((it + 1) & 1); if (it + 2 < nt) DA_LOAD(it + 2); }
        LDS_BARRIER();
    }
#undef DA_LOAD
#undef DA_STORE
}

__device__ __forceinline__ void swa_unit(const PB p, LAS unsigned char* lds, int j, int s, int hq, int qb) {
    const int tid = tid_l(), lane = tid & 63, fr = lane & 15, fq = lane >> 4, wave = tid >> 6;
    const bool lat = s >= 16; const int R0 = lat ? 4096 + (s - 16) * 1024 : s * 256; const int kvh = hq >> 2;
    const GAS bf16_t* PR = (const GAS bf16_t*)(p.ws() + WS_PROJ);
    const int q0 = qb * 128, qrow = q0 + wave * 16 + fr;
    const GAS bf16_t* Qw = PR + (size_t)(R0 + qrow) * 768 + hq * 64;
    ASeg A, B;
    const GAS bf16_t* VTo = (const GAS bf16_t*)(p.ws() + WS_VT) + (size_t)128 * R0 + (size_t)(kvh * 64) * (lat ? 1024 : 256);
    A.ldk = 768; A.ldv = lat ? 1024 : 256; B.ldk = 128; B.ldv = 512; B.kpos0 = 0; B.masked = 0;
    if (lat) { const int t0 = q0 - 128 < 0 ? 0 : q0 - 128; const int t1 = q0 + 256 > 1024 ? 1024 : q0 + 256;
        A.kpos0 = t0; A.ntiles = (t1 - t0) >> 6; A.masked = 1;
        A.K = PR + (size_t)(R0 + t0) * 768 + 512 + kvh * 64; A.V = VTo + t0;
        B.ntiles = 8; B.K = (const GAS bf16_t*)(p.ws() + WS_CKS) + ((size_t)((s - 16) * 2 + j) * 512) * 128 + kvh * 64; B.V = (const GAS bf16_t*)(p.ws() + WS_CVS) + ((size_t)((s - 16) * 2 + j) * 128 + kvh * 64) * 512; }
    else { A.kpos0 = 0; A.ntiles = 4; A.masked = 0; A.K = PR + (size_t)R0 * 768 + 512 + kvh * 64; A.V = VTo; B.ntiles = 0; B.K = A.K; B.V = A.V; }
    f32x4 o[4]; float m = -1e30f, l = 0.f;
#pragma unroll
    for (int db = 0; db < 4; ++db) o[db] = (f32x4){0.f, 0.f, 0.f, 0.f};
    attn_run<64>(lds, Qw, qrow, A, B, 0.125f * 1.4426950408889634f, o, m, l);
    l += __shfl_xor(l, 16); l += __shfl_xor(l, 32);
    const float sk = p.in(18)[j * 8 + hq] * 1.4426950408889634f;
    const float mf = fmaxf(m, sk); const float a = __builtin_amdgcn_exp2f(m - mf); const float lt = l * a + __builtin_amdgcn_exp2f(sk - mf);
    const float sc = a / lt;
    GAS bf16_t* op = (GAS bf16_t*)(p.ws() + WS_MIX) + (size_t)(R0 + qrow) * 1024 + 512 + hq * 64 + 4 * fq;
#pragma unroll
    for (int db = 0; db < 4; ++db) { const f32x4 v = o[db] * sc; u32x2 w; w.x = cvt_pk_bf16(v[0], v[1]); w.y = cvt_pk_bf16(v[2], v[3]); *(GAS u32x2*)(op + 16 * db) = w; }
}
__device__ __forceinline__ void diff_unit(const PB p, LAS unsigned char* lds, int j, int s, int h, int qb) {
    const int tid = tid_l(), lane = tid & 63, fr = lane & 15, fq = lane >> 4, wave = tid >> 6;
    const bool lat = s >= 16; const int R0 = lat ? 4096 + (s - 16) * 1024 : s * 256;
    const GAS bf16_t* PR = (const GAS bf16_t*)(p.ws() + WS_PROJ);
    const int q0 = qb * 128, qrow = q0 + wave * 16 + fr;
    const float* tab = (const float*)(p.ws() + WS_TAB);
    const float lam = tab[2048 + j], lam_init = tab[2050 + j];
    const GAS bf16_t* Qw = PR + (size_t)(R0 + qrow) * 3072 + h * 128;
    const GAS bf16_t* KA = PR + (size_t)R0 * 3072 + 1024 + h * 128;
    const GAS bf16_t* VA = (const GAS bf16_t*)(p.ws() + WS_VT) + (size_t)1024 * R0 + (size_t)(h * 128) * (lat ? 1024 : 256);
    const GAS bf16_t* KB = lat ? (const GAS bf16_t*)(p.ws() + WS_CKD) + ((size_t)((s - 16) * 2 + j) * 512) * 1024 + h * 128 : KA;
    const GAS bf16_t* VB = lat ? (const GAS bf16_t*)(p.ws() + WS_CVD) + ((size_t)((s - 16) * 2 + j) * 1024 + h * 128) * 512 : VA;
    f32x4 o0[8], o1[8]; float m0 = -1e30f, l0 = 0.f, m1 = -1e30f, l1 = 0.f;
#pragma unroll
    for (int db = 0; db < 8; ++db) { o0[db] = (f32x4){0.f, 0.f, 0.f, 0.f}; o1[db] = (f32x4){0.f, 0.f, 0.f, 0.f}; }
    diff_attn_run(lds, Qw, lat ? 16 : 4, lat ? 8 : 0, KA, 3072, VA, lat ? 1024 : 256, KB, 1024, VB, 512, 0.125f * 1.4426950408889634f, o0, o1, m0, l0, m1, l1);
    l0 += __shfl_xor(l0, 16); l0 += __shfl_xor(l0, 32); l1 += __shfl_xor(l1, 16); l1 += __shfl_xor(l1, 32);
    const float i0 = 1.f / l0, i1 = lam / l1; float ss = 0.f;
#pragma unroll
    for (int db = 0; db < 8; ++db) { const f32x4 r = o0[db] * i0 - o1[db] * i1; o0[db] = r; ss += (r[0] * r[0] + r[1] * r[1]) + (r[2] * r[2] + r[3] * r[3]); }
    ss += __shfl_xor(ss, 16); ss += __shfl_xor(ss, 32);
    const float rs = rsqrtf(ss * (1.f / 128.f) + 1e-6f) * (1.f - lam_init);
    const float* sw = p.in(24) + j * 128 + 4 * fq;
    GAS bf16_t* op = (GAS bf16_t*)(p.ws() + WS_MIX) + (size_t)(R0 + qrow) * 1024 + h * 128 + 4 * fq;
#pragma unroll
    for (int db = 0; db < 8; ++db) { const f32x4 w4 = *(const f32x4*)(sw + 16 * db); const f32x4 v = o0[db] * rs * w4; u32x2 w; w.x = cvt_pk_bf16(v[0], v[1]); w.y = cvt_pk_bf16(v[2], v[3]); *(GAS u32x2*)(op + 16 * db) = w; }
}
__device__ __forceinline__ void unit_decode(int u, int& s, int& h, int& qb) {
    if (u < 256) { s = 16 + (u >> 6); h = (u >> 3) & 7; qb = u & 7; } else { const int c = u - 256; s = c >> 4; h = (c >> 1) & 7; qb = c & 1; }
}

typedef __attribute__((address_space(1))) unsigned gu32;
#define XB_TMO      128
#define XB_XCNT(j)  (256  + 64 * (j))
#define XB_XSUB(j)  (1280 + 64 * (j))
#define XB_XGEN(j)  (2304 + 64 * (j))
#define XB_TOP      3328
#define XB_TOPGEN   3392
#define XCD_BAR_WORDS 3456
#define XB_SPIN_CAP (1u << 18)

__device__ __forceinline__ unsigned xb_ld(unsigned* p)              { return __hip_atomic_load(p, __ATOMIC_RELAXED, __HIP_MEMORY_SCOPE_AGENT); }
__device__ __forceinline__ unsigned xb_add(unsigned* p, unsigned v) { return __hip_atomic_fetch_add(p, v, __ATOMIC_RELAXED, __HIP_MEMORY_SCOPE_AGENT); }
__device__ __forceinline__ unsigned xb_xcc_id() { return (unsigned)__builtin_amdgcn_s_getreg((3 << 11) | 20) & 0xFu; }
#define XB_SPIN(cond, bar) do { unsigned _sp = 0; while (cond) { __builtin_amdgcn_s_sleep(1); \
    if ((++_sp & 255u) == 0u) { if (xb_ld(&(bar)[XB_TMO])) break; if (_sp > XB_SPIN_CAP) { atomicAdd(&(bar)[XB_TMO], 1u); break; } } } } while (0)

struct XcdBarrier {
    unsigned* bar; unsigned x;
    volatile LAS unsigned* st;
};

__device__ __forceinline__ XcdBarrier xcd_barrier_post(unsigned* bar, volatile LAS unsigned* st) {
    XcdBarrier b; b.bar = bar; b.x = xb_xcc_id(); b.st = st;
    if (threadIdx.x == 0) (void)xb_add(&bar[XB_XCNT(b.x)], 1u);
    return b;
}
__device__ __forceinline__ void xcd_barrier_complete(unsigned* bar, unsigned x, unsigned& nloc, unsigned& nx) {
    const unsigned G = gridDim.x * gridDim.y * gridDim.z;
    unsigned sum, cnt, mine, sp = 0u;
    for (;;) {
        sum = 0u; cnt = 0u; mine = 0u;
#pragma unroll
        for (unsigned j = 0; j < 16; ++j) { const unsigned c = xb_ld(&bar[XB_XCNT(j)]); sum += c; cnt += (c > 0u) ? 1u : 0u; mine = (j == x) ? c : mine; }
        if (sum == G) break;
        __builtin_amdgcn_s_sleep(1);
        if ((++sp & 255u) == 0u) { if (xb_ld(&bar[XB_TMO])) break; if (sp > XB_SPIN_CAP) { atomicAdd(&bar[XB_TMO], 1u); break; } }
    }
    nloc = mine > 0u ? mine : 1u; nx = cnt > 0u ? cnt : 1u;
}

__device__ __forceinline__ void xcd_barrier(const XcdBarrier& b) {
    asm volatile("s_waitcnt vmcnt(0)" ::: "memory");
    __syncthreads();
    if (threadIdx.x == 0) {
        unsigned* bar = b.bar;
        __builtin_amdgcn_s_waitcnt(0);
        unsigned nloc = b.st[0], nx = b.st[1];
        if (nloc == 0u) { xcd_barrier_complete(bar, b.x, nloc, nx); b.st[0] = nloc; b.st[1] = nx; }
        const unsigned old = xb_add(&bar[XB_XSUB(b.x)], 1u);
        const unsigned gen = old / nloc;
        if (old + 1u == (gen + 1u) * nloc) {
            __builtin_amdgcn_fence(__ATOMIC_RELEASE, "agent");
            asm volatile("s_waitcnt vmcnt(0)" ::: "memory");
            const unsigned og = xb_add(&bar[XB_TOP], 1u);
            const unsigned tg = og / nx;
            if (og + 1u == (tg + 1u) * nx) xb_add(&bar[XB_TOPGEN], 1u);
            else XB_SPIN(xb_ld(&bar[XB_TOPGEN]) == tg, bar);
            __builtin_amdgcn_fence(__ATOMIC_ACQUIRE, "agent");
            xb_add(&bar[XB_XGEN(b.x)], 1u);
            asm volatile("s_waitcnt vmcnt(0)" ::: "memory");
        } else {
            XB_SPIN(xb_ld(&bar[XB_XGEN(b.x)]) == gen, bar);
            __builtin_amdgcn_fence(__ATOMIC_ACQUIRE, "agent");
            asm volatile("s_waitcnt vmcnt(0)" ::: "memory");
        }
    }
    __syncthreads();
}

__global__ void __launch_bounds__(512, 2) hybrid_fwd(Params ka) {
    extern __shared__ __attribute__((aligned(16))) unsigned char lds_raw[];
    LAS unsigned char* lds = (LAS unsigned char*)lds_raw;
    cg::grid_group grid = cg::this_grid();
    if (threadIdx.x == 0) {
#pragma unroll
        for (int i = 0; i < 27; ++i) *(LAS unsigned long long*)(lds + PB_OFF + 8 * i) = (unsigned long long)ka.in[i];
        *(LAS unsigned long long*)(lds + PB_OFF + 8 * 27) = (unsigned long long)ka.out; *(LAS unsigned long long*)(lds + PB_OFF + 8 * 28) = (unsigned long long)ka.ws; }
    if (threadIdx.x == 1) { *(LAS unsigned*)(lds + PB_OFF + 256) = 0u; *(LAS unsigned*)(lds + PB_OFF + 260) = 0u; }
    __syncthreads();
    const PB p{lds};
    const XcdBarrier xbar = xcd_barrier_post((unsigned*)(ka.ws + WS_BAR), (volatile LAS unsigned*)(lds + PB_OFF + 256));
    const int ph_hi = ka.ph_hi;
    int rep = 0;
    for (int ph = ka.ph_lo; ph < ph_hi; ) {
        const int G = gridDim.x, bid = blockIdx.x;
        unsigned char* ws = p.ws();
        if (ph == 0) {
#ifndef SK_P0
            phase0(p, lds);
#endif
        }
        else if (ph == 33) { norm_phase(p, 2, 3, 1, (3 * 5) * 6144 + 5 * 1024); }
        else {
            const int li = (ph - 1) >> 3, sub = (ph - 1) & 7, j = li >> 1, odd = li & 1;
            if (sub == 3 && odd) { ++ph; continue; }
            if (sub == 0) { norm_phase(p, li == 0 ? 0 : 1, li, 0, ((li - 1) * 5) * 6144 + 5 * 1024); }
            else if (sub == 5) { norm_phase(p, 1, li, 1, (li * 5) * 6144 + 2 * 1024); }
            else if (sub == 1) {
                pg8::Gemm g{(const bf16_t*)(ws + WS_XN), odd ? (const bf16_t*)(ws + WS_WINO) + (size_t)j * NOD * DM : (const bf16_t*)(ws + WS_WINE) + (size_t)j * NEV * DM, NTOK, odd ? NOD : NEV, DM, DM, 1};
                pg8::StaticOrder S; S.init(NTOK, g.N, G, bid);
                pg8::EpiIn E; E.odd = odd; E.j = j; E.pb = (const LAS unsigned*)(lds + PB_OFF);

#ifndef SK_IN
                pg8::gemm_phase<pg8::EpiIn, pg8::StaticOrder, true, true>(lds, g, S, E);
#endif
                {
                    const int nun = (NTOK / 256) * (g.N / 256);
                    const bool part = (nun > G && nun < 2 * G);
                    const int first = part ? nun - G : 0, cnt = part ? 2 * G - nun : G;
                    __syncthreads();
                    if (bid >= first) convert_layer_a(p, lds, li < 3 ? li + 1 : -1, (bid - first) * 8 + __builtin_amdgcn_readfirstlane(tid_l() >> 6), cnt * 8, li >= 1 ? li : -1);
                }

            }
            else if (sub == 2) {
#ifndef SK_MIX
                const int vb = (G % 8 == 0) ? (bid & 7) * (G >> 3) + (bid >> 3) : bid;
                if (!odd) {
                    { const bool fast = (G == 256); const int k = vb - 64;
                        const int nh = fast ? (vb >= 192 ? 2 : 1) : (vb < 320 ? (320 - vb + G - 1) / G : 0);
                        for (int q = 0; q < nh; ++q) { int it;
                            if (fast) it = vb < 64 ? 256 + vb : (q == 0 ? k : 192 + (k - 128)); else { const int r = vb + q * G; it = r < 64 ? 256 + r : r - 64; }
#ifdef PROBE_HG2
                            hgrn_chunked_dispatch(p, lds, j, it);
#endif
                            hgrn_chunked_dispatch(p, lds, j, it); }
                        const int nu = fast ? (vb < 64 ? 0 : (k < 64 ? 2 : (k < 128 ? 4 : 2))) : (vb < 512 ? (512 - vb + G - 1) / G : 0);
#ifdef PROBE_SWA2
                        for (int rp_ = 0; rp_ < 2; ++rp_)
#endif
                        for (int q = 0; q < nu; ++q) { int u;
                            if (!fast) u = vb + q * G;
                            else if (k < 64) u = q == 0 ? k : 64 + k;
                            else if (k < 128) u = q == 0 ? 128 + (k - 64) : 256 + (k - 64) * 3 + (q - 1);
                            else u = q == 0 ? 192 + (k - 128) : 256 + 192 + (k - 128);
                            int s, h, qb; unit_decode(u, s, h, qb); swa_unit(p, lds, j, s, h, qb); } }
                } else {
                    for (int u = vb; u < 512; u += G) { int s, h, qb; unit_decode(u, s, h, qb); diff_unit(p, lds, j, s, h, qb); }
                }
#endif
            }
            else if (sub == 3) { hgrn_readout(p, j); }
            else if (sub == 4 || sub == 7) {
                const bool mlp = sub == 7;
                pg8::Gemm g{mlp ? (const bf16_t*)(ws + WS_H) : (const bf16_t*)(ws + WS_MIX),
                            mlp ? (const bf16_t*)(ws + WS_W2) + (size_t)li * DM * FF : (odd ? (const bf16_t*)(ws + WS_WOUTO) : (const bf16_t*)(ws + WS_WOUTE)) + (size_t)j * DM * DM, NTOK, DM, mlp ? FF / 2 : DM / 2, mlp ? FF : DM, 2};
                pg8::StaticOrder S; S.init(NTOK, DM, G, bid, 2);
                pg8::EpiPart E{(bf16_t*)(ws + WS_P0), (bf16_t*)(ws + WS_P1)};

#ifndef SK_RES
                pg8::gemm_phase<pg8::EpiPart, pg8::StaticOrder, true, true>(lds, g, S, E);
#endif

            }
            else {
                pg8::Gemm g{(const bf16_t*)(ws + WS_XN), (const bf16_t*)(ws + WS_W1) + (size_t)li * FF * DM, NTOK, FF, DM, DM, 1};
                pg8::StaticOrder S; S.init(NTOK, FF, G, bid);
                pg8::EpiRelu2 E{(bf16_t*)(ws + WS_H), FF};

#ifndef SK_MLP1
                pg8::gemm_phase<pg8::EpiRelu2, pg8::StaticOrder, true, true>(lds, g, S, E);
#endif

            }
        }
        { const bool again = DUP_MASK != 0 && rep == 0 && ph > 0 && ((DUP_MASK >> (((ph - 1) & 7) + 8 * (((ph - 1) >> 3) & 1))) & 1); rep = again ? 1 : 0; if (!again) ++ph; }
        if (ph < ph_hi) { if (ph_hi > 1000) grid.sync(); else xcd_barrier(xbar); }
    }
}

#ifndef DUP_MASK
#define DUP_MASK 0
#endif
#ifndef MK_PER_PHASE
#define MK_PER_PHASE 0
#endif
extern "C" void kernel_launch(void* const* d_in, const int* in_sizes, int n_in, void* d_out, int out_size, void* d_ws, size_t ws_size, hipStream_t stream) {
    static int grid = 0;
    if (grid == 0) {
        if (n_in != 27 || ws_size < WS_END) { fprintf(stderr, "kernel_launch: unexpected n_in %d / ws_size %zu\n", n_in, ws_size); grid = -1; return; }
        int dev = 0, cus = 0, per_cu = 0;
        hipGetDevice(&dev); hipDeviceGetAttribute(&cus, hipDeviceAttributeMultiprocessorCount, dev);
        if (hipFuncSetAttribute((const void*)hybrid_fwd, hipFuncAttributeMaxDynamicSharedMemorySize, LDS_BYTES) != hipSuccess) { fprintf(stderr, "kernel_launch: hipFuncSetAttribute failed\n"); grid = -1; return; }
        if (hipOccupancyMaxActiveBlocksPerMultiprocessor(&per_cu, (const void*)hybrid_fwd, 512, LDS_BYTES) != hipSuccess || per_cu < 1) { fprintf(stderr, "kernel_launch: occupancy query says %d blocks per CU\n", per_cu); grid = -1; (void)hipGetLastError(); return; }
        grid = cus;
    }
    if (grid < 0) return;
    hipMemsetAsync((char*)d_ws + WS_MODS, 0, 512 * 1024, stream);
    Params p{};
    for (int i = 0; i < 27; ++i) p.in[i] = (const float*)d_in[i];
    p.out = (float*)d_out; p.ws = (unsigned char*)d_ws;
#if MK_PER_PHASE
    for (int ph = 0; ph < 34; ++ph) { p.ph_lo = ph; p.ph_hi = ph + 1; hipLaunchKernelGGL(hybrid_fwd, dim3(grid), dim3(512), LDS_BYTES, stream, p); }
#else
    p.ph_lo = 0; p.ph_hi = 34;
    void* args[] = {&p};
    hipError_t e = hipLaunchCooperativeKernel((const void*)hybrid_fwd, dim3(grid), dim3(512), args, LDS_BYTES, stream);
    if (e != hipSuccess) fprintf(stderr, "cooperative launch failed: %s (grid %d)\n", hipGetErrorString(e), grid);
#endif
}
```

```cpp
#include <hip/hip_runtime.h>
#include <hip/hip_cooperative_groups.h>
#include <cstdio>
#include <cstdint>
namespace cg = cooperative_groups;
#ifndef DUP_MASK
#define DUP_MASK 0
#endif
#define GAS __attribute__((address_space(1)))
#define LDS_BARRIER() do { asm volatile("s_waitcnt lgkmcnt(0)" ::: "memory"); __builtin_amdgcn_s_barrier(); asm volatile("" ::: "memory"); } while (0)
__device__ __forceinline__ int tid_l() { int t = threadIdx.x; asm volatile("" : "+v"(t)); return t; }
namespace pg8 {
#define PG8_LAS __attribute__((address_space(3)))
typedef unsigned short bf16_t;
typedef short bf16x8 __attribute__((ext_vector_type(8)));
typedef float f32x4 __attribute__((ext_vector_type(4)));
typedef unsigned u32x4 __attribute__((ext_vector_type(4)));
constexpr int BM = 256, BK = 64, HALF = 128, HTB = HALF * BK * 2  , STAGE_BYTES = 8 * HTB, NXCD = 8, WGM = 8;

__host__ __device__ __forceinline__ int lds_byte(int r, int c) { const int st = (r >> 4) * 2 + (c >> 5), rr = r & 15, cc = c & 31, ob = rr * 64 + cc * 2; return st * 1024 + (ob ^ (((ob >> 9) & 1) << 5)); }
__host__ __device__ __forceinline__ void stage_rc(int b, int& R, int& C) { const int st = b / 1024, sb = b % 1024, swz = sb ^ (((sb >> 9) & 1) << 5); R = (st >> 1) * 16 + swz / 64; C = (st & 1) * 32 + (swz % 64) / 2; }
__host__ __device__ __forceinline__ int perm32(int rho) { const int n = rho >> 4, i = rho & 15; return 8 * (i >> 2) + 4 * n + (i & 3); }

struct Unit { int pm, pn, ks; };
struct Gemm { const bf16_t* A; const bf16_t* Bt; int M, N, K, ld, KS; };

struct StaticOrder {
    int nM, nN, nwg, G, c, nNr;
    __host__ __device__ void init(int M, int N, int G_, int c_, int KS = 1) { nM = M / BM; nNr = N / BM; nN = nNr * KS; nwg = nM * nN; G = G_; c = c_; }
    __host__ __device__ bool next(int i, Unit& u) const {
        const long L = (long)i * G + c; if (L >= nwg) return false;
        int wgid = (int)L; { const int q = nwg / NXCD, r = nwg % NXCD, xcd = wgid % NXCD, off = wgid / NXCD; wgid = (xcd < r ? xcd * (q + 1) : r * (q + 1) + (xcd - r) * q) + off; }
        const int nig = WGM * nN, gid = wgid / nig, fm = gid * WGM, gsz = (nM - fm) < WGM ? (nM - fm) : WGM;
        u.pm = fm + ((wgid % nig) % gsz); { const int pq = (wgid % nig) / gsz; u.pn = pq % nNr; u.ks = pq / nNr; } return true;
    }
    __device__ __forceinline__ void a_ready(const Unit&) const {}
    __device__ __forceinline__ void done(const Unit&) const {}
};

__device__ __forceinline__ unsigned cvt_pk_bf16(float lo, float hi) { unsigned r; asm volatile("v_cvt_pk_bf16_f32 %0, %1, %2" : "=v"(r) : "v"(lo), "v"(hi)); return r; }
typedef float f32x2 __attribute__((ext_vector_type(2)));
typedef unsigned u32x2 __attribute__((ext_vector_type(2)));

#define LDSP __attribute__((address_space(3)))
__device__ __forceinline__ unsigned long long ldq(const unsigned LDSP* pb, int i) { const unsigned lo = __builtin_amdgcn_readfirstlane(pb[2 * i]), hi = __builtin_amdgcn_readfirstlane(pb[2 * i + 1]); return ((unsigned long long)hi << 32) | lo; }
__device__ __forceinline__ float dpp_x1(float x) { return __builtin_bit_cast(float, __builtin_amdgcn_update_dpp(0, __builtin_bit_cast(int, x), 0xB1, 0xf, 0xf, true)); }
__device__ __forceinline__ float dpp_x2(float x) { return __builtin_bit_cast(float, __builtin_amdgcn_update_dpp(0, __builtin_bit_cast(int, x), 0x4E, 0xf, 0xf, true)); }
__device__ __forceinline__ void quad_transpose(float& v0, float& v1, float& v2, float& v3, int a) {
    { const bool hi = a & 1; const float r0 = dpp_x1(hi ? v0 : v1), r1 = dpp_x1(hi ? v2 : v3); if (hi) { v0 = r0; v2 = r1; } else { v1 = r0; v3 = r1; } }
    { const bool hi = a & 2; const float r0 = dpp_x2(hi ? v0 : v2), r1 = dpp_x2(hi ? v1 : v3); if (hi) { v0 = r0; v1 = r1; } else { v2 = r0; v3 = r1; } }
}
struct EpiRelu2 {
    static constexpr bool PERM = true, AFTER_DRAIN = false;
    bf16_t* O; int ldc;
    __device__ __forceinline__ void operator()(const f32x4 (&acc)[2][2][4][2], const Unit& u, int wr, int wc, int fr, int fq) const {
        const int row0 = u.pm * BM + wr * 64 + fr; const int col0 = u.pn * BM + wc * 32 + 8 * fq;
#pragma unroll
        for (int ai = 0; ai < 2; ++ai)
#pragma unroll
            for (int m = 0; m < 4; ++m) { bf16_t* rowp = O + (size_t)(row0 + ai * HALF + m * 16) * ldc + col0;
#pragma unroll
                for (int bj = 0; bj < 2; ++bj) { f32x4 v0 = acc[ai][bj][m][0], v1 = acc[ai][bj][m][1];
#pragma unroll
                    for (int i = 0; i < 4; ++i) { float a = fmaxf(v0[i], 0.f), b = fmaxf(v1[i], 0.f); v0[i] = a * a; v1[i] = b * b; }
                    u32x4 w; w.x = cvt_pk_bf16(v0[0], v0[1]); w.y = cvt_pk_bf16(v0[2], v0[3]); w.z = cvt_pk_bf16(v1[0], v1[1]); w.w = cvt_pk_bf16(v1[2], v1[3]);
                    *(u32x4*)(rowp + bj * HALF) = w; } }
    }
};
struct EpiPart {
    static constexpr bool PERM = true, AFTER_DRAIN = false;
    bf16_t* P0; bf16_t* P1;
    __device__ __forceinline__ void operator()(const f32x4 (&acc)[2][2][4][2], const Unit& u, int wr, int wc, int fr, int fq) const {
        bf16_t* P = u.ks ? P1 : P0;
        const int col0 = u.pn * BM + wc * 32 + 8 * fq;
#pragma unroll
        for (int ai = 0; ai < 2; ++ai)
#pragma unroll
            for (int m = 0; m < 4; ++m) { bf16_t* rowp = P + (size_t)(u.pm * BM + ai * HALF + wr * 64 + m * 16 + fr) * 1024 + col0;
#pragma unroll
                for (int bj = 0; bj < 2; ++bj) { const f32x4 v0 = acc[ai][bj][m][0], v1 = acc[ai][bj][m][1];
                    u32x4 w; w.x = cvt_pk_bf16(v0[0], v0[1]); w.y = cvt_pk_bf16(v0[2], v0[3]); w.z = cvt_pk_bf16(v1[0], v1[1]); w.w = cvt_pk_bf16(v1[2], v1[3]);
                    *(u32x4*)(rowp + bj * HALF) = w; } }
    }
};
struct EpiIn {
    static constexpr bool PERM = false, AFTER_DRAIN = false;
    int odd, j; const unsigned LDSP* pb;
    __device__ __forceinline__ void operator()(const f32x4 (&acc)[2][2][4][2], const Unit& u, int wr, int wc, int fr, int fq) const {
        unsigned char* ws = (unsigned char*)ldq(pb, 28); float* outp = (float*)ldq(pb, 27);
        bf16_t* proj = (bf16_t*)(ws + 150u * 1048576u); const int ldp = odd ? 3072 : 768; float* hg = (float*)(ws + 198u * 1048576u);
        const float* lbs = (const float*)(ws + 524288) + j * 1024; const float* rope = (const float*)(ws + 524288) + 4096;
        const float* qnw = (const float*)ldq(pb, odd ? 21 : 16) + j * 64; const float* knw = (const float*)ldq(pb, odd ? 22 : 17) + j * 64;
        float* outk = outp + (odd ? 14680064 : 8388608); float* outv = outp + (odd ? 23068672 : 9437184);
        const int unit = u.pn * 4 + wc;
        int type;
        if (!odd) type = unit < 8 ? 0 : unit < 24 ? 1 : unit < 40 ? 2 : unit < 48 ? 3 : unit < 50 ? 4 : 5;
        else type = unit < 16 ? 3 : unit < 32 ? 4 : 5;
        const int pu = odd ? unit : unit - 40;
        const bool lat = u.pm >= 16;
        f32x4 w4[2][2];
        if (type == 3 || type == 4) { const float* nw = (type == 3) ? qnw : knw;
#pragma unroll
            for (int bj = 0; bj < 2; ++bj)
#pragma unroll
                for (int n = 0; n < 2; ++n) w4[bj][n] = *(const f32x4*)(nw + 32 * bj + 16 * n + 4 * fq); }
        else if (type == 1) { const float* lb = lbs + ((unit - 8) >> 3) * 512 + ((unit - 8) & 7) * 64;
#pragma unroll
            for (int bj = 0; bj < 2; ++bj)
#pragma unroll
                for (int n = 0; n < 2; ++n) w4[bj][n] = *(const f32x4*)(lb + 32 * bj + 16 * n + 4 * fq); }
        else {
#pragma unroll
            for (int bj = 0; bj < 2; ++bj)
#pragma unroll
                for (int n = 0; n < 2; ++n) w4[bj][n] = (f32x4){0.f, 0.f, 0.f, 0.f}; }
#pragma unroll
        for (int ai = 0; ai < 2; ++ai)
#pragma unroll
            for (int m = 0; m < 4; ++m) {
                const int row = u.pm * BM + ai * HALF + wr * 64 + m * 16 + fr;
                f32x4 v[2][2];
#pragma unroll
                for (int bj = 0; bj < 2; ++bj)
#pragma unroll
                    for (int n = 0; n < 2; ++n) v[bj][n] = acc[ai][bj][m][n];
                if (type <= 2) {
                    float* hp = hg + (size_t)row * 2560 + unit * 64 + 4 * fq;
#pragma unroll
                    for (int bj = 0; bj < 2; ++bj)
#pragma unroll
                        for (int n = 0; n < 2; ++n) { f32x4 xv = v[bj][n];
                            if (type == 0) {
#pragma unroll
                                for (int i = 0; i < 4; ++i) xv[i] = xv[i] * __builtin_amdgcn_rcpf(1.f + __expf(-xv[i])) * 0.08838834764831845f; }
                            else if (type == 1) {
#pragma unroll
                                for (int i = 0; i < 4; ++i) { const float sg = __builtin_amdgcn_rcpf(1.f + __expf(-xv[i])); const float lb = w4[bj][n][i]; xv[i] = lb + (1.f - lb) * sg; } }
                            *(f32x4*)(hp + 32 * bj + 16 * n) = xv; }
                } else {
                    if (type != 5) {
                        float ss = 0.f;
#pragma unroll
                        for (int bj = 0; bj < 2; ++bj)
#pragma unroll
                            for (int n = 0; n < 2; ++n) { const f32x4 xv = v[bj][n]; ss += (xv[0] * xv[0] + xv[1] * xv[1]) + (xv[2] * xv[2] + xv[3] * xv[3]); }
                        ss += __shfl_xor(ss, 16); ss += __shfl_xor(ss, 32);
                        const float rs = rsqrtf(ss * (1.f / 64.f) + 1e-6f);
#pragma unroll
                        for (int bj = 0; bj < 2; ++bj)
#pragma unroll
                            for (int n = 0; n < 2; ++n) v[bj][n] = v[bj][n] * rs * w4[bj][n];
                    }
                    if (!lat && type >= 4) {
                        float* ob = (type == 4) ? outk : outv;
                        const int b = row >> 8, t = row & 255;
                        size_t off;
                        if (!odd) off = ((size_t)(b * 2 + j) * 256 + t) * 128 + (size_t)(unit - (type == 4 ? 48 : 50)) * 64;
                        else off = ((size_t)(b * 2 + j) * 256 + t) * 1024 + (size_t)(unit - (type == 4 ? 16 : 32)) * 64;
#pragma unroll
                        for (int bj = 0; bj < 2; ++bj)
#pragma unroll
                            for (int n = 0; n < 2; ++n) *(f32x4*)(ob + off + 32 * bj + 16 * n + 4 * fq) = v[bj][n];
                    }
                    if (lat && type != 5) {
                        const int t = (row - 4096) & 1023; const int rp = t >> 6, cp = t & 63;
#pragma unroll
                        for (int bj = 0; bj < 2; ++bj)
#pragma unroll
                            for (int n = 0; n < 2; ++n) { const f32x4 cs = *(const f32x4*)(rope + ((bj ? cp : rp) * 16 + 8 * n + 2 * fq) * 2);
                                const f32x4 xv = v[bj][n]; f32x4 o;
                                o[0] = xv[0] * cs[0] - xv[1] * cs[1]; o[1] = xv[0] * cs[1] + xv[1] * cs[0];
                                o[2] = xv[2] * cs[2] - xv[3] * cs[3]; o[3] = xv[2] * cs[3] + xv[3] * cs[2]; v[bj][n] = o; }
                    }
                    if (type == 5) {
                        const int t = lat ? ((row - 4096) & 1023) : (row & 255); const int L = lat ? 1024 : 256; const int C = odd ? 1024 : 128;
                        const int a = fr & 3;
                        unsigned short* vp = (unsigned short*)(ws + 310u * 1048576u) + (size_t)C * (row - t) + (size_t)((unit - (odd ? 32 : 50)) * 64 + 4 * fq + a) * L + (t - a);
#pragma unroll
                        for (int bj = 0; bj < 2; ++bj)
#pragma unroll
                            for (int n = 0; n < 2; ++n) { float x0 = v[bj][n][0], x1 = v[bj][n][1], x2 = v[bj][n][2], x3 = v[bj][n][3];
                                quad_transpose(x0, x1, x2, x3, a);
                                u32x2 w; w.x = cvt_pk_bf16(x0, x1); w.y = cvt_pk_bf16(x2, x3);
                                *(u32x2*)(vp + (size_t)(32 * bj + 16 * n) * L) = w; }
                    } else {
                    bf16_t* pp = proj + (size_t)row * ldp + pu * 64 + 4 * fq;
#pragma unroll
                    for (int bj = 0; bj < 2; ++bj)
#pragma unroll
                        for (int n = 0; n < 2; ++n) { u32x2 w; w.x = cvt_pk_bf16(v[bj][n][0], v[bj][n][1]); w.y = cvt_pk_bf16(v[bj][n][2], v[bj][n][3]); *(u32x2*)(pp + 32 * bj + 16 * n) = w; }
                    }
                }
            }
    }
};

template <class Epi, class Sched, bool ALIGN_EPI = false, bool SP2 = false>
__device__ __forceinline__ void gemm_phase(PG8_LAS unsigned char* lds, const Gemm g, const Sched& S, const Epi& E) {
    const int tid = tid_l(), wid = __builtin_amdgcn_readfirstlane(tid >> 6), lane = tid & 63, wr = wid >> 2, wc = wid & 3, fr = lane & 15, fq = lane >> 4;
    const int K = g.ld, nt = g.K / BK;
    unsigned voffA[2], voffB[2];
#pragma unroll
    for (int i = 0; i < 2; ++i) { int R, C; stage_rc(tid * 16 + i * 8192, R, C); const int Rb = Epi::PERM ? ((R & ~31) + perm32(R & 31)) : R;
        voffA[i] = (unsigned)(R * K + C) * 2u; voffB[i] = (unsigned)(Rb * K + C) * 2u; }
    const size_t kstep = (size_t)(BK * 2);
    const size_t hstep = (size_t)HALF * K * 2;
    const size_t tstep = 2 * hstep;
    const unsigned ldsw = (unsigned)wid * 1024u;
    const int aoff = lds_byte(wr * 64 + fr, fq * 8), boff = lds_byte(wc * 32 + fr, fq * 8);
#define PG8_SA(b, h) (((b) * 2 + (h)) * HTB)
#define PG8_SB(b, h) ((4 + (b) * 2 + (h)) * HTB)
#define PG8_STAGE(bufoff, gbase, voff) do { _Pragma("unroll") for (int _i = 0; _i < 2; ++_i) \
        __builtin_amdgcn_global_load_lds((const unsigned*)((const char*)(gbase) + (voff)[_i]), (PG8_LAS unsigned*)(lds + (bufoff) + ldsw + _i * 8192), 16, 0, 0); } while (0)
#define PG8_LDA(dst, b, h) do { _Pragma("unroll") for (int m = 0; m < 4; ++m) _Pragma("unroll") for (int k = 0; k < 2; ++k) dst[m][k] = *(const PG8_LAS bf16x8*)(lds + PG8_SA(b, h) + aoff + m * 2048 + k * 1024); } while (0)
#define PG8_LDB(dst, b, h) do { _Pragma("unroll") for (int n = 0; n < 2; ++n) _Pragma("unroll") for (int k = 0; k < 2; ++k) dst[n][k] = *(const PG8_LAS bf16x8*)(lds + PG8_SB(b, h) + boff + n * 2048 + k * 1024); } while (0)
#define PG8_MMA(ai, bj, At, Bt) do { __builtin_amdgcn_s_setprio(1); _Pragma("unroll") for (int m = 0; m < 4; ++m) _Pragma("unroll") for (int n = 0; n < 2; ++n) _Pragma("unroll") for (int k = 0; k < 2; ++k) \
        acc[ai][bj][m][n] = __builtin_amdgcn_mfma_f32_16x16x32_bf16(Bt[n][k], At[m][k], acc[ai][bj][m][n], 0, 0, 0); __builtin_amdgcn_s_setprio(0); } while (0)
#define PG8_WAIT_V(n) asm volatile("s_waitcnt vmcnt(" #n ")" ::: "memory")
#define PG8_WAIT_L(n) asm volatile("s_waitcnt lgkmcnt(" #n ")" ::: "memory")
#define PG8_BAR __builtin_amdgcn_s_barrier()
#define PG8_SCHED __builtin_amdgcn_sched_barrier(0)
    Unit cur, nxt; int ui = 0;
    if (!S.next(0, cur)) return;
    f32x4 acc[2][2][4][2];
#pragma unroll
    for (int a = 0; a < 2; ++a)
#pragma unroll
        for (int b = 0; b < 2; ++b)
#pragma unroll
            for (int m = 0; m < 4; ++m)
#pragma unroll
                for (int n = 0; n < 2; ++n) acc[a][b][m][n] = (f32x4){0.f, 0.f, 0.f, 0.f};
    bf16x8 At[4][2], B0[2][2], B1[2][2];
    const char* cA = (const char*)g.A + (size_t)cur.pm * tstep + (size_t)cur.ks * g.K * 2; const char* cB = (const char*)g.Bt + (size_t)cur.pn * tstep + (size_t)cur.ks * g.K * 2;
    S.a_ready(cur);
    if constexpr (SP2) {
        PG8_STAGE(PG8_SB(0, 0), cB, voffB); PG8_STAGE(PG8_SB(0, 1), cB + hstep, voffB); PG8_STAGE(PG8_SA(0, 0), cA, voffA); PG8_STAGE(PG8_SA(0, 1), cA + hstep, voffA);
        if (wr == 1) PG8_BAR;
        PG8_WAIT_V(2); PG8_BAR;
        PG8_STAGE(PG8_SB(1, 0), cB + kstep, voffB); PG8_STAGE(PG8_SA(1, 0), cA + kstep, voffA); PG8_STAGE(PG8_SB(1, 1), cB + hstep + kstep, voffB);
        PG8_WAIT_V(6); PG8_BAR;
    } else {
        PG8_STAGE(PG8_SB(0, 0), cB, voffB); PG8_STAGE(PG8_SA(0, 0), cA, voffA); PG8_STAGE(PG8_SB(0, 1), cB + hstep, voffB); PG8_STAGE(PG8_SA(0, 1), cA + hstep, voffA);
        if (wr == 1) PG8_BAR;
        PG8_WAIT_V(4); PG8_BAR;
        PG8_STAGE(PG8_SB(1, 0), cB + kstep, voffB); PG8_STAGE(PG8_SA(1, 0), cA + kstep, voffA); PG8_STAGE(PG8_SB(1, 1), cB + hstep + kstep, voffB);
        PG8_WAIT_V(6); PG8_BAR;
    }
    for (;;) {
        const bool has_next = S.next(ui + 1, nxt);
        const char* nA = has_next ? (const char*)g.A + (size_t)nxt.pm * tstep + (size_t)nxt.ks * g.K * 2 : cA; const char* nB = has_next ? (const char*)g.Bt + (size_t)nxt.pn * tstep + (size_t)nxt.ks * g.K * 2 : cB;
        for (int t = 0; t < nt; t += 2) {
            const bool last = (t == nt - 2);
            const char* a1 = cA + (size_t)(t + 1) * kstep;
            const char* a2 = last ? nA : cA + (size_t)(t + 2) * kstep; const char* b2 = last ? nB : cB + (size_t)(t + 2) * kstep;
            const char* a3 = a2 + kstep; const char* b3 = b2 + kstep;
            if (last && has_next) S.a_ready(nxt);
            if constexpr (SP2) {
            PG8_LDB(B0, 0, 0); PG8_LDB(B1, 0, 1); PG8_SCHED; PG8_LDA(At, 0, 0); PG8_STAGE(PG8_SA(1, 1), a1 + hstep, voffA);
            PG8_WAIT_V(8); PG8_WAIT_L(0); PG8_BAR; PG8_MMA(0, 0, At, B0); PG8_MMA(0, 1, At, B1); PG8_BAR; PG8_SCHED;
            PG8_LDA(At, 0, 1); PG8_STAGE(PG8_SB(0, 0), b2, voffB); PG8_STAGE(PG8_SB(0, 1), b2 + hstep, voffB); PG8_STAGE(PG8_SA(0, 0), a2, voffA);
            PG8_WAIT_V(8); PG8_WAIT_L(0); PG8_BAR; PG8_MMA(1, 0, At, B0); PG8_MMA(1, 1, At, B1); PG8_BAR; PG8_SCHED;
            PG8_LDB(B0, 1, 0); PG8_LDB(B1, 1, 1); PG8_SCHED; PG8_LDA(At, 1, 0); PG8_STAGE(PG8_SA(0, 1), a2 + hstep, voffA);
            PG8_WAIT_V(8); PG8_WAIT_L(0); PG8_BAR; PG8_MMA(0, 0, At, B0); PG8_MMA(0, 1, At, B1); PG8_BAR; PG8_SCHED;
            PG8_LDA(At, 1, 1); PG8_STAGE(PG8_SB(1, 0), b3, voffB); PG8_STAGE(PG8_SB(1, 1), b3 + hstep, voffB); PG8_STAGE(PG8_SA(1, 0), a3, voffA);
            PG8_WAIT_V(8); PG8_WAIT_L(0); PG8_BAR; PG8_MMA(1, 0, At, B0); PG8_MMA(1, 1, At, B1); PG8_BAR; PG8_SCHED;
            } else {
            PG8_LDB(B0, 0, 0); PG8_SCHED; PG8_LDA(At, 0, 0); PG8_STAGE(PG8_SA(1, 1), a1 + hstep, voffA);
            PG8_WAIT_L(8); PG8_BAR; PG8_WAIT_L(0); PG8_MMA(0, 0, At, B0); PG8_BAR; PG8_SCHED;
            PG8_LDB(B1, 0, 1); PG8_STAGE(PG8_SB(0, 0), b2, voffB);
            PG8_BAR; PG8_WAIT_L(0); PG8_MMA(0, 1, At, B1); PG8_BAR;
            PG8_LDA(At, 0, 1); PG8_STAGE(PG8_SA(0, 0), a2, voffA);
            PG8_BAR; PG8_WAIT_L(0); PG8_MMA(1, 0, At, B0); PG8_BAR; PG8_SCHED;
            PG8_STAGE(PG8_SB(0, 1), b2 + hstep, voffB);
            PG8_WAIT_V(6); PG8_BAR; PG8_MMA(1, 1, At, B1); PG8_BAR;
            PG8_LDB(B0, 1, 0); PG8_SCHED; PG8_LDA(At, 1, 0); PG8_STAGE(PG8_SA(0, 1), a2 + hstep, voffA);
            PG8_WAIT_L(8); PG8_BAR; PG8_WAIT_L(0); PG8_MMA(0, 0, At, B0); PG8_BAR; PG8_SCHED;
            PG8_LDB(B1, 1, 1); PG8_STAGE(PG8_SB(1, 0), b3, voffB);
            PG8_BAR; PG8_WAIT_L(0); PG8_MMA(0, 1, At, B1); PG8_BAR;
            PG8_LDA(At, 1, 1); PG8_STAGE(PG8_SA(1, 0), a3, voffA);
            PG8_BAR; PG8_WAIT_L(0); PG8_MMA(1, 0, At, B0); PG8_BAR; PG8_SCHED;
            PG8_STAGE(PG8_SB(1, 1), b3 + hstep, voffB);
            PG8_WAIT_V(6); PG8_BAR; PG8_MMA(1, 1, At, B1); PG8_BAR;
            }
        }
        if constexpr (ALIGN_EPI) { if (wr == 0) PG8_BAR; }
        if constexpr (!Epi::AFTER_DRAIN) { E(acc, cur, wr, wc, fr, fq); S.done(cur); }
        if (!has_next) break;
#pragma unroll
        for (int a = 0; a < 2; ++a)
#pragma unroll
            for (int b = 0; b < 2; ++b)
#pragma unroll
                for (int m = 0; m < 4; ++m)
#pragma unroll
                    for (int n = 0; n < 2; ++n) acc[a][b][m][n] = (f32x4){0.f, 0.f, 0.f, 0.f};
        cur = nxt; cA = nA; cB = nB; ++ui;
        if constexpr (ALIGN_EPI) { if (wr == 1) PG8_BAR; }
    }
    PG8_WAIT_V(0);
    if constexpr (!ALIGN_EPI) { if (wr == 0) PG8_BAR; }
    PG8_BAR;
    if constexpr (Epi::AFTER_DRAIN) { E.fused(acc, cur, wr, wc, fr, fq, lds, wid, lane); S.done(cur); }
#undef PG8_SA
#undef PG8_SB
#undef PG8_STAGE
#undef PG8_LDA
#undef PG8_LDB
#undef PG8_MMA
#undef PG8_WAIT_V
#undef PG8_WAIT_L
#undef PG8_BAR
#undef PG8_SCHED
}
}
#define LAS __attribute__((address_space(3)))
typedef unsigned short bf16_t;
typedef short bf16x8 __attribute__((ext_vector_type(8)));
typedef float f32x4 __attribute__((ext_vector_type(4)));
typedef float f32x2 __attribute__((ext_vector_type(2)));
typedef unsigned u32x4 __attribute__((ext_vector_type(4)));
typedef unsigned u32x2 __attribute__((ext_vector_type(2)));
using pg8::cvt_pk_bf16;

constexpr int NTOK = 8192, DM = 1024, NEV = 3328, NOD = 3072, FF = 4096;
constexpr int LDS_BYTES = 147456;
constexpr size_t MiB = 1u << 20;
constexpr size_t WS_MODS = 0;
constexpr size_t WS_BAR = 492 * 1024;
constexpr size_t WS_TAB = 512 * 1024;
constexpr size_t WS_WINE = 2 * MiB, WS_WOUTE = 16 * MiB, WS_WINO = 20 * MiB, WS_WOUTO = 32 * MiB, WS_W1 = 36 * MiB, WS_W2 = 68 * MiB;
constexpr size_t WS_XN = 100 * MiB, WS_MIX = 116 * MiB;
constexpr size_t WS_CKS = 132 * MiB, WS_CVS = 133 * MiB, WS_CKD = 134 * MiB, WS_CVD = 142 * MiB;
constexpr size_t WS_P0 = 150 * MiB, WS_P1 = 278 * MiB;
constexpr size_t WS_PROJ = 150 * MiB, WS_HG = 198 * MiB, WS_OF = 278 * MiB, WS_OB = 294 * MiB, WS_H = 198 * MiB, WS_VT = 310 * MiB, WS_END = 326 * MiB;
constexpr size_t OUT_KS = 8388608, OUT_VS = 9437184, OUT_ST = 10485760, OUT_KD = 14680064, OUT_VD = 23068672;

struct Params { const float* in[27]; float* out; unsigned char* ws; int ph_lo, ph_hi; };
constexpr int PB_OFF = 143360;
struct PB {
    LAS unsigned char* l;
    __device__ __forceinline__ unsigned long long q(int i) const { const LAS unsigned* w = (const LAS unsigned*)(l + PB_OFF) + 2 * i; const unsigned lo = __builtin_amdgcn_readfirstlane(w[0]), hi = __builtin_amdgcn_readfirstlane(w[1]); return ((unsigned long long)hi << 32) | lo; }
    __device__ __forceinline__ const float* in(int i) const { return (const float*)q(i); }
    __device__ __forceinline__ float* out() const { return (float*)q(27); }
    __device__ __forceinline__ unsigned char* ws() const { return (unsigned char*)q(28); }
};

__device__ __forceinline__ float wave_sum(float v) {
#pragma unroll
    for (int o = 1; o < 64; o <<= 1) v += __shfl_xor(v, o);
    return v;
}

__device__ __forceinline__ void p0_transpose_item(const float* W, int K, int N, bf16_t* WT, bool hperm, LAS float* scr, int item, int lane) {
    const int nblk = N / 64, kb = item / nblk, nb = item % nblk, k0 = 64 * kb, n0 = 64 * nb;
    const float* wp = W + (size_t)(k0 + (lane >> 4)) * N + n0 + (lane & 15) * 4;
    f32x4 t4[16];
#pragma unroll
    for (int i = 0; i < 16; ++i) t4[i] = __builtin_nontemporal_load((const f32x4*)(wp + (size_t)(4 * i) * N));
#pragma unroll
    for (int i = 0; i < 16; ++i) { LAS float* d = scr + (4 * i + (lane >> 4)) * 65 + (lane & 15) * 4; d[0] = t4[i][0]; d[1] = t4[i][1]; d[2] = t4[i][2]; d[3] = t4[i][3]; }
    asm volatile("s_waitcnt lgkmcnt(0)" ::: "memory");
    const int c = lane & 7;
#pragma unroll
    for (int jj = 0; jj < 8; ++jj) { const int n = (lane >> 3) + 8 * jj; const LAS float* s = scr + (8 * c) * 65 + n;
        u32x4 o; o.x = cvt_pk_bf16(s[0 * 65], s[1 * 65]); o.y = cvt_pk_bf16(s[2 * 65], s[3 * 65]); o.z = cvt_pk_bf16(s[4 * 65], s[5 * 65]); o.w = cvt_pk_bf16(s[6 * 65], s[7 * 65]);
        const int col = n0 + n; int drow = col;
        if (hperm) { const int cc = col & 255; drow = (col & ~255) + ((cc >> 5) & 1) * 128 + (cc >> 6) * 32 + (cc & 31); }
        *(u32x4*)(WT + (size_t)drow * K + k0 + 8 * c) = o; }
    asm volatile("s_waitcnt lgkmcnt(0)" ::: "memory");
}

__device__ __forceinline__ void convert_layer_a(const PB p, LAS unsigned char* lds, int L, int rank, int nw, int LW2) {
    const int tid = tid_l(), lane = tid & 63, wave = __builtin_amdgcn_readfirstlane(tid >> 6);
    unsigned char* ws = p.ws();
    LAS float* scr = (LAS float*)(lds + wave * 16640);
    const int odd = L & 1, j = L >> 1;
    const int I_IN = L < 0 ? 0 : (odd ? 16 * (NOD / 64) : 16 * (NEV / 64)), I_SQ = L < 0 ? 0 : 256, I_W = L < 0 ? 0 : 1024;
    const int nitems = I_IN + I_SQ + I_W + (LW2 >= 0 ? 1024 : 0);
    for (int it = rank; it < nitems; it += nw) {
        int r = it, jj, K = DM, N = DM, srci; size_t dof; bool hp = false;
        if (r >= I_IN + I_SQ + I_W) { r -= I_IN + I_SQ + I_W; srci = 26; K = FF; jj = LW2; dof = WS_W2 + (size_t)LW2 * DM * FF * 2; }
        else if (r < I_IN) { srci = odd ? 19 : 12; N = odd ? NOD : NEV; hp = true; jj = j; dof = (odd ? WS_WINO : WS_WINE) + (size_t)j * N * DM * 2; }
        else if ((r -= I_IN) < I_SQ) { srci = odd ? 20 : 13; jj = j; dof = (odd ? WS_WOUTO : WS_WOUTE) + (size_t)j * DM * DM * 2; }
        else { r -= I_SQ; srci = 25; N = FF; jj = L; dof = WS_W1 + (size_t)L * FF * DM * 2; }
        p0_transpose_item(p.in(srci) + (size_t)jj * K * N, K, N, (bf16_t*)(ws + dof), hp, scr, r, lane);
    }
}
__device__ __forceinline__ void phase0(const PB p, LAS unsigned char* lds) {
    const int tid = tid_l(), lane = tid & 63, wave = __builtin_amdgcn_readfirstlane(tid >> 6);
    const int G = gridDim.x, bid = blockIdx.x;
    unsigned char* ws = p.ws();
    {
        LAS float* scr = (LAS float*)(lds + wave * 16640);
        const int gw = bid * 8 + wave, NGW = G * 8;
        constexpr int I_INE = 16 * (NEV / 64), I_SQ = 16 * 16, I_INO = 16 * (NOD / 64), I_W1 = 16 * (FF / 64), I_W2 = 64 * 16;
        constexpr int I_CVD = 8 * 16, I_CVS = 8 * 2;
        const int n_w2 = (G == 256) ? 0 : I_W2;
        const int NITEMS = I_INE + I_SQ + I_W1 + n_w2 + 8 * I_CVD + 8 * I_CVS;
        for (int it = gw; it < NITEMS; it += NGW) {
            int r = it, jj = 0, K = DM, N = DM, srci = 26; size_t dof; bool hp = false;
            if (r < I_INE) { srci = 12; N = NEV; hp = true; dof = WS_WINE; }
            else if ((r -= I_INE) < I_SQ) { srci = 13; dof = WS_WOUTE; }
            else if ((r -= I_SQ) < I_W1) { srci = 25; N = FF; dof = WS_W1; }
            else if ((r -= I_W1) < n_w2) { srci = 26; K = FF; dof = WS_W2; }
            else if ((r -= n_w2) < 8 * I_CVD) { jj = r / I_CVD; r -= jj * I_CVD; srci = 6; K = 512; N = 1024; dof = WS_CVD + (size_t)jj * 1024 * 512 * 2; }
            else { r -= 8 * I_CVD; jj = r / I_CVS; r -= jj * I_CVS; srci = 3; K = 512; N = 128; dof = WS_CVS + (size_t)jj * 128 * 512 * 2; }
            p0_transpose_item(p.in(srci) + (size_t)jj * K * N, K, N, (bf16_t*)(ws + dof), hp, scr, r, lane);
        }
    }
    {
        float* mods = (float*)(ws + WS_MODS);
        LAS float* s = (LAS float*)lds; LAS float* red = (LAS float*)(lds + 20480);
        for (int u = bid; u < 192; u += G) {
            const int li = u / 48, nc = u % 48;
            __syncthreads();
            for (int e = tid; e < 5120; e += 512) { const int cnd = e >> 10, k = e & 1023; const float cv = (cnd == 0) ? p.in(8)[k] : p.in(7)[(cnd - 1) * 1024 + k]; s[e] = cv / (1.f + __expf(-cv)); }
            __syncthreads();
            const int kg = tid >> 5, cq = tid & 31;
            const float* w = p.in(10) + ((size_t)li * 1024 + kg * 64) * 6144 + nc * 128 + cq * 4;
            const LAS float* sk = s + kg * 64;
            f32x4 a0 = {0.f, 0.f, 0.f, 0.f}, a1 = a0, a2 = a0, a3 = a0, a4 = a0;
#pragma unroll
            for (int kb = 0; kb < 4; ++kb) { f32x4 wv[16];
#pragma unroll
                for (int k = 0; k < 16; ++k) wv[k] = __builtin_nontemporal_load((const f32x4*)(w + (size_t)(16 * kb + k) * 6144));
#pragma unroll
                for (int k = 0; k < 16; ++k) { const int kk = 16 * kb + k; a0 += wv[k] * sk[kk]; a1 += wv[k] * sk[1024 + kk]; a2 += wv[k] * sk[2048 + kk]; a3 += wv[k] * sk[3072 + kk]; a4 += wv[k] * sk[4096 + kk]; } }
            *(LAS f32x4*)(red + (kg * 5 + 0) * 128 + cq * 4) = a0; *(LAS f32x4*)(red + (kg * 5 + 1) * 128 + cq * 4) = a1; *(LAS f32x4*)(red + (kg * 5 + 2) * 128 + cq * 4) = a2;
            *(LAS f32x4*)(red + (kg * 5 + 3) * 128 + cq * 4) = a3; *(LAS f32x4*)(red + (kg * 5 + 4) * 128 + cq * 4) = a4;
            __syncthreads();
            for (int e = tid; e < 640; e += 512) { const int c = e >> 7, cl = e & 127; float sum = 0.f;
#pragma unroll
                for (int g2 = 0; g2 < 16; ++g2) sum += red[(g2 * 5 + c) * 128 + cl];
                mods[(size_t)(li * 5 + c) * 6144 + nc * 128 + cl] = sum + p.in(11)[li * 6144 + nc * 128 + cl]; }
        }
    }
    if (bid == G - 1) {
        float* tab = (float*)(ws + WS_TAB);
        for (int e = tid; e < 1024; e += 512) { const float l0 = p.in(14)[e], l1 = p.in(14)[1024 + e]; tab[e] = 0.f; tab[1024 + e] = 1.f / (1.f + __expf(l0 - l1)); }
        if (tid < 2) { const int jj = tid; const float* lp = p.in(23) + jj * 256; float d1 = 0.f, d2 = 0.f;
            for (int i = 0; i < 64; ++i) { d1 += lp[i] * lp[64 + i]; d2 += lp[128 + i] * lp[192 + i]; }
            const float li_ = (float)(2 * jj + 1); const float lam_init = 0.8f - 0.6f * expf(-0.3f * li_);
            tab[2048 + jj] = expf(d1) - expf(d2) + lam_init; tab[2050 + jj] = lam_init; }
        for (int e = tid; e < 1024; e += 512) { const int pos = e >> 4, f = e & 15;
            const float inv = exp2f(-(float)(2 * f) * (13.287712379549449f / 32.0f));
            const float a = (float)pos * inv;
            const float kk = rintf(a * 0.15915494309189535f); float rr = fmaf(-kk, 6.2831854820251465f, a); rr = fmaf(-kk, -1.7484555e-7f, rr);
            tab[4096 + e * 2] = __cosf(rr); tab[4096 + e * 2 + 1] = __sinf(rr); }
    }
    {
        const size_t gt = (size_t)bid * 512 + tid, GT = (size_t)G * 512;
#define CVT_ARR(SRC, DST, N4) for (size_t i = gt; i < (size_t)(N4); i += GT) { const f32x4 v = ((const f32x4*)(SRC))[i]; u32x2 w; w.x = cvt_pk_bf16(v[0], v[1]); w.y = cvt_pk_bf16(v[2], v[3]); ((u32x2*)(DST))[i] = w; }
        CVT_ARR(p.in(2), ws + WS_CKS, 131072) CVT_ARR(p.in(5), ws + WS_CKD, 1048576)
#undef CVT_ARR
    }
}

__device__ __forceinline__ f32x4 bf4(u32x2 w) { f32x4 r; r[0] = __builtin_bit_cast(float, w.x << 16); r[1] = __builtin_bit_cast(float, w.x & 0xffff0000u); r[2] = __builtin_bit_cast(float, w.y << 16); r[3] = __builtin_bit_cast(float, w.y & 0xffff0000u); return r; }
__device__ __forceinline__ void norm_phase(const PB p, int mode, int li, int which, int gate_off) {
    const int tid = tid_l(), lane = tid & 63, wave = tid >> 6;
    const int gw = blockIdx.x * 8 + wave, NGW = gridDim.x * 8;
    unsigned char* ws = p.ws();
    const float* mods = (const float*)(ws + WS_MODS);
    const bf16_t* P0 = (const bf16_t*)(ws + WS_P0); const bf16_t* P1 = (const bf16_t*)(ws + WS_P1);
    bf16_t* XN = (bf16_t*)(ws + WS_XN);
    float* xo = p.out();
    const float* nw = p.in(9) + (li * 2 + which) * 1024;
    const float* x0 = p.in(0); const float* x1 = p.in(1);
    for (int grp = gw; grp < NTOK / 4; grp += NGW) {
        const int row0 = grp * 4; const int cond = row0 < 4096 ? 0 : 1 + ((row0 - 4096) >> 10);
        const float* md = mods + (size_t)(li * 5 + cond) * 6144 + which * 3072;
        f32x4 g4[4], w4[4], sh4[4], sc4[4];
#pragma unroll
        for (int jj = 0; jj < 4; ++jj) { const int c = 4 * lane + 256 * jj;
            if (mode != 0) g4[jj] = *(const f32x4*)(mods + gate_off + cond * 6144 + c);
            if (mode != 2) { w4[jj] = *(const f32x4*)(nw + c); sh4[jj] = *(const f32x4*)(md + c); sc4[jj] = *(const f32x4*)(md + 1024 + c); } }
#pragma unroll
        for (int hh = 0; hh < 2; ++hh) {
            f32x4 x[2][4]; u32x2 a0[2][4], a1[2][4];
#pragma unroll
            for (int rr = 0; rr < 2; ++rr) { const int row = row0 + 2 * hh + rr;
                const float* xr = mode == 0 ? (row < 4096 ? x0 + (size_t)row * 1024 : x1 + (size_t)(row - 4096) * 1024) : xo + (size_t)row * 1024;
#pragma unroll
                for (int jj = 0; jj < 4; ++jj) { const int c = 4 * lane + 256 * jj; x[rr][jj] = __builtin_nontemporal_load((const f32x4*)(xr + c));
                    if (mode != 0) { a0[rr][jj] = __builtin_nontemporal_load((const u32x2*)(P0 + (size_t)row * 1024 + c)); a1[rr][jj] = __builtin_nontemporal_load((const u32x2*)(P1 + (size_t)row * 1024 + c)); } } }
#pragma unroll
            for (int rr = 0; rr < 2; ++rr) { const int row = row0 + 2 * hh + rr; float ss = 0.f;
#pragma unroll
                for (int jj = 0; jj < 4; ++jj) { const int c = 4 * lane + 256 * jj;
                    if (mode != 0) x[rr][jj] = x[rr][jj] + g4[jj] * (bf4(a0[rr][jj]) + bf4(a1[rr][jj]));
                    ss += (x[rr][jj][0] * x[rr][jj][0] + x[rr][jj][1] * x[rr][jj][1]) + (x[rr][jj][2] * x[rr][jj][2] + x[rr][jj][3] * x[rr][jj][3]);
                    __builtin_nontemporal_store(x[rr][jj], (f32x4*)(xo + (size_t)row * 1024 + c)); }
                if (mode != 2) {
                    const float rstd = rsqrtf(wave_sum(ss) * (1.f / 1024.f) + 1e-6f);
#pragma unroll
                    for (int jj = 0; jj < 4; ++jj) { const int c = 4 * lane + 256 * jj;
                        const f32x4 o = x[rr][jj] * rstd * w4[jj] * (1.f + sc4[jj]) + sh4[jj];
                        u32x2 pk; pk.x = cvt_pk_bf16(o[0], o[1]); pk.y = cvt_pk_bf16(o[2], o[3]);
                        *(u32x2*)(XN + (size_t)row * 1024 + c) = pk; } } }
        }
    }
}

constexpr int HC_QP = 0, HC_QPP = 17408, HC_KP = 34816, HC_KT = 52224, HC_VT = 70656, HC_ST = 89088, HC_P = 123904, HC_SC = 133120;
__device__ __forceinline__ float exp_c(float x) { return __builtin_amdgcn_exp2f(fminf(x, 115.f)); }
__device__ __forceinline__ unsigned short bf16r(float x) { return (unsigned short)(cvt_pk_bf16(x, 0.f) & 0xffffu); }
template <int BWD, int DIR> __device__ __forceinline__ void hc_load(float (&rq)[16], float (&rf)[16], float (&rv)[16], const GAS float* base) {
    constexpr int st = DIR ? -2560 : 2560, fo = 512 + DIR * 512;
    asm volatile("" : "+v"(base));
#pragma unroll
    for (int i = 0; i < 16; ++i) { const GAS float* rp = base + (BWD ? -i : i) * st; rq[i] = rp[0]; rf[i] = rp[fo]; rv[i] = rp[1536]; }
}
template <int BWD> __device__ __forceinline__ void hc_pass2(const float (&rq)[16], const float (&rf)[16], const float (&rv)[16], const float (&rel)[16], float off, float ecm, int ch, int anchor,
        LAS unsigned short* QP, LAS unsigned short* QPP, LAS unsigned short* KP, LAS unsigned short* KT, LAS unsigned short* VT, bool vmine) {
    LAS unsigned short* qp_ = QP + anchor * 136 + ch; LAS unsigned short* qpp_ = QPP + anchor * 136 + ch; LAS unsigned short* kp_ = KP + anchor * 136 + ch;
    unsigned kk[16];
#pragma unroll
    for (int i = 0; i < 16; ++i) { const int d = BWD ? -i : i; const float r = rel[i] + off;
        const float qp = rq[i] * exp_c(r); const float kp = (1.f - rf[i]) * exp_c(-r);
        qp_[d * 136] = bf16r(qp); qpp_[d * 136] = bf16r(qp * ecm); const unsigned short k16 = bf16r(kp); kp_[d * 136] = k16; kk[BWD ? 15 - i : i] = k16; }
    const int t0 = BWD ? anchor - 15 : anchor;
    u32x4 w0, w1, v0, v1;
    w0.x = kk[0] | (kk[1] << 16); w0.y = kk[2] | (kk[3] << 16); w0.z = kk[4] | (kk[5] << 16); w0.w = kk[6] | (kk[7] << 16);
    w1.x = kk[8] | (kk[9] << 16); w1.y = kk[10] | (kk[11] << 16); w1.z = kk[12] | (kk[13] << 16); w1.w = kk[14] | (kk[15] << 16);
#define RV(e_) rv[BWD ? 15 - (e_) : (e_)]
    v0.x = cvt_pk_bf16(RV(0), RV(1)); v0.y = cvt_pk_bf16(RV(2), RV(3)); v0.z = cvt_pk_bf16(RV(4), RV(5)); v0.w = cvt_pk_bf16(RV(6), RV(7));
    v1.x = cvt_pk_bf16(RV(8), RV(9)); v1.y = cvt_pk_bf16(RV(10), RV(11)); v1.z = cvt_pk_bf16(RV(12), RV(13)); v1.w = cvt_pk_bf16(RV(14), RV(15));
#undef RV
    *(LAS u32x4*)(KT + ch * 72 + t0) = w0; *(LAS u32x4*)(KT + ch * 72 + t0 + 8) = w1;
    if (vmine) { *(LAS u32x4*)(VT + (ch & 63) * 72 + t0) = v0; *(LAS u32x4*)(VT + (ch & 63) * 72 + t0 + 8) = v1; }
}
template <int DIR>
__device__ __forceinline__ void hgrn_chunked_item(const PB p, LAS unsigned char* lds, int j, int s, int h, int vh) {
    constexpr int dir = DIR;
    const int tid = tid_l(), lane = tid & 63, fr = lane & 15, fq = lane >> 4; const int w = __builtin_amdgcn_readfirstlane(tid >> 6);
    const int L = s < 16 ? 256 : 1024, R0 = s < 16 ? s * 256 : 4096 + (s - 16) * 1024;
    const GAS float* hg = (const GAS float*)(p.ws() + WS_HG);
    GAS float* og = (GAS float*)(p.ws() + (dir ? WS_OB : WS_OF));
    LAS unsigned short* QP = (LAS unsigned short*)(lds + HC_QP); LAS unsigned short* QPP = (LAS unsigned short*)(lds + HC_QPP); LAS unsigned short* KP = (LAS unsigned short*)(lds + HC_KP);
    LAS unsigned short* KT = (LAS unsigned short*)(lds + HC_KT); LAS unsigned short* VT = (LAS unsigned short*)(lds + HC_VT); LAS unsigned short* ST = (LAS unsigned short*)(lds + HC_ST);
    LAS unsigned short* PM = (LAS unsigned short*)(lds + HC_P); LAS float* scal = (LAS float*)(lds + HC_SC);
    const int vb = w & 3, kh = w >> 2;
    f32x4 S[4];
    if (s >= 16) { const GAS float* st = (const GAS float*)p.in(4) + ((((size_t)(s - 16) * 2 + j) * 2 + dir) * 4 + h) * 16384;
#pragma unroll
        for (int kb = 0; kb < 4; ++kb) S[kb] = *(const GAS f32x4*)(st + (size_t)(16 * (4 * kh + kb) + fr) * 128 + 64 * vh + 16 * vb + 4 * fq); }
    else {
#pragma unroll
        for (int kb = 0; kb < 4; ++kb) S[kb] = (f32x4){0.f, 0.f, 0.f, 0.f}; }
    const int quarter = __builtin_amdgcn_readfirstlane(tid >> 7); const bool bwd = quarter < 2; const int ch = tid & 127;
    const int anchor = quarter == 0 ? 15 : quarter == 1 ? 31 : quarter == 2 ? 32 : 48;
    constexpr int st = dir ? -2560 : 2560;
    const GAS float* row0 = hg + (size_t)(R0 + (dir ? L - 1 : 0)) * 2560 + h * 128;
    float rq[16], rf[16], rv[16];
    float nq[16], nf[16], nv[16];
#define HC_LOAD(cc_, Q_, F_, V_) do { const GAS float* rc_ = row0 + ((long)(cc_) * 64 + anchor) * st + ch; if (bwd) hc_load<1, DIR>(Q_, F_, V_, rc_); else hc_load<0, DIR>(Q_, F_, V_, rc_); } while (0)
    HC_LOAD(0, rq, rf, rv);
    LDS_BARRIER();
#pragma unroll
    for (int kb = 0; kb < 4; ++kb)
#pragma unroll
        for (int r = 0; r < 4; ++r) ST[(16 * vb + 4 * fq + r) * 136 + 16 * (4 * kh + kb) + fr] = bf16r(S[kb][r]);
    const int nchunk = L >> 6;
    for (int c = 0; c < nchunk; ++c) {
        float rel[16];
        if (c + 1 < nchunk) HC_LOAD(c + 1, nq, nf, nv);
        { float cc = 0.f;
#pragma unroll
            for (int i = 0; i < 16; ++i) { const float g = __builtin_amdgcn_logf(rf[i]);   if (!bwd) { cc += g; rel[i] = cc; } else { rel[i] = -cc; cc += g; } }
            scal[quarter * 128 + ch] = cc; }
        LDS_BARRIER();
        { const float t0 = scal[ch], t1 = scal[128 + ch], t2 = scal[256 + ch], t3 = scal[384 + ch];
            const float off = quarter == 0 ? -t1 : quarter == 3 ? t2 : 0.f; const float cm = t0 + t1;
            if (quarter == 1) scal[512 + ch] = cm; if (quarter == 2) scal[640 + ch] = t2 + t3;
            const float ecm = exp_c(cm);
            const bool vmine = (ch >> 6) == vh;
            if (bwd) hc_pass2<1>(rq, rf, rv, rel, off, ecm, ch, anchor, QP, QPP, KP, KT, VT, vmine); else hc_pass2<0>(rq, rf, rv, rel, off, ecm, ch, anchor, QP, QPP, KP, KT, VT, vmine); }
        LDS_BARRIER();
        { const int tb = w & 3, sh = w >> 2; const int t = 16 * tb + fr;
#pragma unroll
            for (int sbi = 0; sbi < 2; ++sbi) { const int sb = 2 * sh + sbi; f32x4 a = {0.f, 0.f, 0.f, 0.f};
                if (sb <= tb) {
#pragma unroll
                    for (int ks = 0; ks < 4; ++ks) { const bf16x8 A = *(const LAS bf16x8*)(KP + (16 * sb + fr) * 136 + 32 * ks + 8 * fq); const bf16x8 B = *(const LAS bf16x8*)(QP + (16 * tb + fr) * 136 + 32 * ks + 8 * fq);
                        a = __builtin_amdgcn_mfma_f32_16x16x32_bf16(A, B, a, 0, 0, 0); } }
#pragma unroll
                for (int r = 0; r < 4; ++r) if (16 * sb + 4 * fq + r > t) a[r] = 0.f;
                u32x2 wv; wv.x = cvt_pk_bf16(a[0], a[1]); wv.y = cvt_pk_bf16(a[2], a[3]);
                *(LAS u32x2*)(PM + t * 72 + 16 * sb + 4 * fq) = wv; } }
        LDS_BARRIER();
        { bf16x8 vt[2], stf[4];
#pragma unroll
            for (int sl = 0; sl < 2; ++sl) vt[sl] = *(const LAS bf16x8*)(VT + (16 * vb + fr) * 72 + 32 * sl + 8 * fq);
#pragma unroll
            for (int ks = 0; ks < 4; ++ks) stf[ks] = *(const LAS bf16x8*)(ST + (16 * vb + fr) * 136 + 32 * ks + 8 * fq);
            GAS float* ob = og + (size_t)(R0 + (dir ? L - 1 : 0)) * 512 + (long)c * 64 * (dir ? -512 : 512) + h * 128 + 64 * vh + 16 * vb + 4 * fq;
#pragma unroll
            for (int tbi = 0; tbi < 2; ++tbi) { const int tb = 2 * kh + tbi; f32x4 o = {0.f, 0.f, 0.f, 0.f};
#pragma unroll
                for (int sl = 0; sl < 2; ++sl) if (32 * sl <= 16 * tb + 15) { const bf16x8 B = *(const LAS bf16x8*)(PM + (16 * tb + fr) * 72 + 32 * sl + 8 * fq); o = __builtin_amdgcn_mfma_f32_16x16x32_bf16(vt[sl], B, o, 0, 0, 0); }
#pragma unroll
                for (int ks = 0; ks < 4; ++ks) { const bf16x8 B = *(const LAS bf16x8*)(QPP + (16 * tb + fr) * 136 + 32 * ks + 8 * fq); o = __builtin_amdgcn_mfma_f32_16x16x32_bf16(stf[ks], B, o, 0, 0, 0); }
                *(GAS f32x4*)(ob + (long)(16 * tb + fr) * (dir ? -512 : 512)) = o; }
#pragma unroll
            for (int kbi = 0; kbi < 4; ++kbi) { const int kb = 4 * kh + kbi; const float cmv = scal[512 + 16 * kb + fr], r63 = scal[640 + 16 * kb + fr]; const float dec = exp_c(cmv + r63), e63 = exp_c(r63);
                f32x4 tt = {0.f, 0.f, 0.f, 0.f};
#pragma unroll
                for (int sl = 0; sl < 2; ++sl) { const bf16x8 B = *(const LAS bf16x8*)(KT + (16 * kb + fr) * 72 + 32 * sl + 8 * fq); tt = __builtin_amdgcn_mfma_f32_16x16x32_bf16(vt[sl], B, tt, 0, 0, 0); }
                S[kbi] = S[kbi] * dec + tt * e63; } }
        LDS_BARRIER();
#pragma unroll
        for (int kb = 0; kb < 4; ++kb)
#pragma unroll
            for (int r = 0; r < 4; ++r) ST[(16 * vb + 4 * fq + r) * 136 + 16 * (4 * kh + kb) + fr] = bf16r(S[kb][r]);
#pragma unroll
        for (int i = 0; i < 16; ++i) { rq[i] = nq[i]; rf[i] = nf[i]; rv[i] = nv[i]; }
    }
#undef HC_LOAD
    if (s < 16) { GAS float* so = (GAS float*)p.out() + OUT_ST + ((((size_t)s * 2 + j) * 2 + dir) * 4 + h) * 16384;
#pragma unroll
        for (int kb = 0; kb < 4; ++kb) *(GAS f32x4*)(so + (size_t)(16 * (4 * kh + kb) + fr) * 128 + 64 * vh + 16 * vb + 4 * fq) = S[kb]; }
}
__device__ __forceinline__ void hgrn_chunked_dispatch(const PB p, LAS unsigned char* lds, int j, int it) {
    const int s = it >> 4, h = (it >> 2) & 3, vh = it & 1;
    if (it & 2) hgrn_chunked_item<1>(p, lds, j, s, h, vh); else hgrn_chunked_item<0>(p, lds, j, s, h, vh);
}
__device__ __forceinline__ void hgrn_readout(const PB p, int j) {
    const int tid = tid_l(), lane = tid & 63, wave = tid >> 6;
    const int gw = blockIdx.x * 8 + wave, NGW = gridDim.x * 8;
    const float* of = (const float*)(p.ws() + WS_OF); const float* ob = (const float*)(p.ws() + WS_OB); const float* hg = (const float*)(p.ws() + WS_HG);
    bf16_t* MIX = (bf16_t*)(p.ws() + WS_MIX);
    const int col = (lane >> 4) * 128 + (lane & 15) * 8;
    const float* nw = p.in(15) + j * 128 + (lane & 15) * 8;
    const f32x4 w0 = *(const f32x4*)nw, w1 = *(const f32x4*)(nw + 4);
    for (int row = gw; row < NTOK; row += NGW) {
        const f32x4 a0 = *(const f32x4*)(of + (size_t)row * 512 + col) + *(const f32x4*)(ob + (size_t)row * 512 + col);
        const f32x4 a1 = *(const f32x4*)(of + (size_t)row * 512 + col + 4) + *(const f32x4*)(ob + (size_t)row * 512 + col + 4);
        const f32x4 g0 = *(const f32x4*)(hg + (size_t)row * 2560 + 2048 + col), g1 = *(const f32x4*)(hg + (size_t)row * 2560 + 2048 + col + 4);
        float ss = (a0[0] * a0[0] + a0[1] * a0[1]) + (a0[2] * a0[2] + a0[3] * a0[3]) + (a1[0] * a1[0] + a1[1] * a1[1]) + (a1[2] * a1[2] + a1[3] * a1[3]);
        ss += __shfl_xor(ss, 1); ss += __shfl_xor(ss, 2); ss += __shfl_xor(ss, 4); ss += __shfl_xor(ss, 8);
        const float rs = rsqrtf(ss * (1.f / 128.f) + 1e-6f);
        f32x4 o0, o1;
#pragma unroll
        for (int i = 0; i < 4; ++i) { o0[i] = a0[i] * rs * w0[i] * g0[i] * __builtin_amdgcn_rcpf(1.f + __expf(-g0[i])); o1[i] = a1[i] * rs * w1[i] * g1[i] * __builtin_amdgcn_rcpf(1.f + __expf(-g1[i])); }
        u32x4 w; w.x = cvt_pk_bf16(o0[0], o0[1]); w.y = cvt_pk_bf16(o0[2], o0[3]); w.z = cvt_pk_bf16(o1[0], o1[1]); w.w = cvt_pk_bf16(o1[2], o1[3]);
        *(u32x4*)(MIX + (size_t)row * 1024 + col) = w;
    }
}

struct ASeg { const GAS bf16_t* K; const GAS bf16_t* V; int ldk, ldv, kpos0, ntiles, masked; };
template <int DV>
__device__ __forceinline__ void attn_tile(const LAS unsigned char* Ks, const LAS unsigned char* VT, bool msk, int kp0, int qpos, float c2, const bf16x8 qf0, const bf16x8 qf1, int fr, int fq, f32x4 (&o)[DV / 16], float& m, float& l) {
    f32x4 sc[4];
#pragma unroll
    for (int b = 0; b < 4; ++b) {
        const bf16x8 k0 = *(const LAS bf16x8*)(Ks + (16 * b + fr) * 144 + fq * 16), k1 = *(const LAS bf16x8*)(Ks + (16 * b + fr) * 144 + 64 + fq * 16);
        f32x4 a = {0.f, 0.f, 0.f, 0.f};
        a = __builtin_amdgcn_mfma_f32_16x16x32_bf16(k0, qf0, a, 0, 0, 0);
        a = __builtin_amdgcn_mfma_f32_16x16x32_bf16(k1, qf1, a, 0, 0, 0);
        sc[b] = a;
    }
    float mx = -1e30f; unsigned vmask = 0xffffu;
#pragma unroll
    for (int b = 0; b < 4; ++b)
#pragma unroll
        for (int r = 0; r < 4; ++r) { float v = sc[b][r];
            if (msk) { const int d = qpos - (kp0 + 32 * (b >> 1) + 4 * (b & 1) + r); if (d > 128 || d < -128) { v = -1e30f; vmask &= ~(1u << (b * 4 + r)); } }
            sc[b][r] = v; mx = fmaxf(mx, v); }
    mx *= c2;
    { auto r16 = __builtin_amdgcn_permlane16_swap(__float_as_uint(mx), __float_as_uint(mx), false, false); mx = fmaxf(__uint_as_float(r16[0]), __uint_as_float(r16[1]));
      auto r32 = __builtin_amdgcn_permlane32_swap(__float_as_uint(mx), __float_as_uint(mx), false, false); mx = fmaxf(__uint_as_float(r32[0]), __uint_as_float(r32[1])); }
    const float mn = fmaxf(m, mx); const float alpha = __builtin_amdgcn_exp2f(m - mn); m = mn;
    l *= alpha;
#pragma unroll
    for (int db = 0; db < DV / 16; ++db) o[db] = o[db] * alpha;
    float ls = 0.f;
#pragma unroll
    for (int b = 0; b < 4; ++b)
#pragma unroll
        for (int r = 0; r < 4; ++r) { float pr = __builtin_amdgcn_exp2f(fmaf(sc[b][r], c2, -mn)); if (msk && !((vmask >> (b * 4 + r)) & 1u)) pr = 0.f; sc[b][r] = pr; ls += pr; }
    l += ls;
    bf16x8 pf[2];
#pragma unroll
    for (int ks = 0; ks < 2; ++ks) { u32x4 w; w.x = cvt_pk_bf16(sc[2 * ks][0], sc[2 * ks][1]); w.y = cvt_pk_bf16(sc[2 * ks][2], sc[2 * ks][3]); w.z = cvt_pk_bf16(sc[2 * ks + 1][0], sc[2 * ks + 1][1]); w.w = cvt_pk_bf16(sc[2 * ks + 1][2], sc[2 * ks + 1][3]); pf[ks] = __builtin_bit_cast(bf16x8, w); }
#pragma unroll
    for (int db = 0; db < DV / 16; ++db)
#pragma unroll
        for (int ks = 0; ks < 2; ++ks) { const bf16x8 vv = *(const LAS bf16x8*)(VT + (16 * db + fr) * 144 + ks * 64 + fq * 16);
            o[db] = __builtin_amdgcn_mfma_f32_16x16x32_bf16(vv, pf[ks], o[db], 0, 0, 0); }
}
template <int DV>
__device__ __forceinline__ void attn_run(LAS unsigned char* lds, const GAS bf16_t* Qw, int qpos, const ASeg A, const ASeg B, float c2, f32x4 (&o)[DV / 16], float& m, float& l) {
    constexpr int BUF = 9216 + DV * 144;
    const int tid = tid_l(), lane = tid & 63, fr = lane & 15, fq = lane >> 4;
    const bf16x8 qf0 = *(const GAS bf16x8*)(Qw + fq * 8), qf1 = *(const GAS bf16x8*)(Qw + 32 + fq * 8);
    const int nt = A.ntiles + B.ntiles;
    const int kkey = tid >> 3, kch = tid & 7;
    const int krow = 32 * (kkey >> 5) + 16 * ((kkey >> 2) & 1) + 4 * ((kkey >> 3) & 3) + (kkey & 3);
    u32x4 kreg, vreg[DV / 64];
#define AT_LOAD(i_) do { const bool inA_ = (i_) < A.ntiles; const int ti_ = inA_ ? (i_) : (i_) - A.ntiles; const GAS bf16_t* kp_ = inA_ ? A.K : B.K; const GAS bf16_t* vp_ = inA_ ? A.V : B.V; const int ldk_ = inA_ ? A.ldk : B.ldk, ldv_ = inA_ ? A.ldv : B.ldv; \
        kreg = *(const GAS u32x4*)(kp_ + (size_t)(ti_ * 64 + kkey) * ldk_ + kch * 8); \
        _Pragma("unroll") for (int pp_ = 0; pp_ < DV / 64; ++pp_) vreg[pp_] = *(const GAS u32x4*)(vp_ + (size_t)(kkey + 64 * pp_) * ldv_ + ti_ * 64 + kch * 8); } while (0)
#define AT_STORE(b_) do { LAS unsigned char* kb_ = lds + (b_) * BUF; *(LAS u32x4*)(kb_ + krow * 144 + kch * 16) = kreg; \
        _Pragma("unroll") for (int pp_ = 0; pp_ < DV / 64; ++pp_) *(LAS u32x4*)(kb_ + 9216 + (kkey + 64 * pp_) * 144 + kch * 16) = vreg[pp_]; } while (0)
    AT_LOAD(0);
    LDS_BARRIER();
    AT_STORE(0);
    if (nt > 1) AT_LOAD(1);
    LDS_BARRIER();
    for (int it = 0; it < nt; ++it) {
        const LAS unsigned char* Ks = lds + (it & 1) * BUF;
        attn_tile<DV>(Ks, Ks + 9216, (it < A.ntiles) && A.masked, A.kpos0 + it * 64 + 8 * fq, qpos, c2, qf0, qf1, fr, fq, o, m, l);
        if (it + 1 < nt) { AT_STORE((it + 1) & 1); if (it + 2 < nt) AT_LOAD(it + 2); }
        LDS_BARRIER();
    }
#undef AT_LOAD
#undef AT_STORE
}
__device__ __forceinline__ void diff_attn_run(LAS unsigned char* lds, const GAS bf16_t* Qw, int nA, int nB, const GAS bf16_t* KA, int ldkA, const GAS bf16_t* VA, int ldvA, const GAS bf16_t* KB, int ldkB, const GAS bf16_t* VB, int ldvB,
        float c2, f32x4 (&o0)[8], f32x4 (&o1)[8], float& m0, float& l0, float& m1, float& l1) {
    constexpr int BUF = 36864;
    const int tid = tid_l(), lane = tid & 63, fr = lane & 15, fq = lane >> 4;
    const bf16x8 q00 = *(const GAS bf16x8*)(Qw + fq * 8), q01 = *(const GAS bf16x8*)(Qw + 32 + fq * 8), q10 = *(const GAS bf16x8*)(Qw + 64 + fq * 8), q11 = *(const GAS bf16x8*)(Qw + 96 + fq * 8);
    const int nt = nA + nB;
    const int kkey = tid >> 3, kch = tid & 7;
    const int krow = 32 * (kkey >> 5) + 16 * ((kkey >> 2) & 1) + 4 * ((kkey >> 3) & 3) + (kkey & 3);
    u32x4 k0r, k1r, vreg[2];
#define DA_LOAD(i_) do { const bool inA_ = (i_) < nA; const int ti_ = inA_ ? (i_) : (i_) - nA; const GAS bf16_t* kp_ = (inA_ ? KA : KB) + (size_t)(ti_ * 64 + kkey) * (inA_ ? ldkA : ldkB) + kch * 8; const GAS bf16_t* vp_ = inA_ ? VA : VB; const int ldv_ = inA_ ? ldvA : ldvB; \
        k0r = *(const GAS u32x4*)kp_; k1r = *(const GAS u32x4*)(kp_ + 64); \
        _Pragma("unroll") for (int pp_ = 0; pp_ < 2; ++pp_) vreg[pp_] = *(const GAS u32x4*)(vp_ + (size_t)(kkey + 64 * pp_) * ldv_ + ti_ * 64 + kch * 8); } while (0)
#define DA_STORE(b_) do { LAS unsigned char* kb_ = lds + (b_) * BUF; *(LAS u32x4*)(kb_ + krow * 144 + kch * 16) = k0r; *(LAS u32x4*)(kb_ + 9216 + krow * 144 + kch * 16) = k1r; \
        _Pragma("unroll") for (int pp_ = 0; pp_ < 2; ++pp_) *(LAS u32x4*)(kb_ + 18432 + (kkey + 64 * pp_) * 144 + kch * 16) = vreg[pp_]; } while (0)
    DA_LOAD(0);
    LDS_BARRIER();
    DA_STORE(0);
    if (nt > 1) DA_LOAD(1);
    LDS_BARRIER();
    for (int it = 0; it < nt; ++it) {
        const LAS unsigned char* Ks = lds + (it & 1) * BUF;
        attn_tile<128>(Ks, Ks + 18432, false, 0, 0, c2, q00, q01, fr, fq, o0, m0, l0);
        attn_tile<128>(Ks + 9216, Ks + 18432, false, 0, 0, c2, q10, q11, fr, fq, o1, m1, l1);
        if (it + 1 < nt) { DA_STORE((it + 1) & 1); if (it + 2 < nt) DA_LOAD(it + 2); }
        LDS_BARRIER();
    }
#undef DA_LOAD
#undef DA_STORE
}

__device__ __forceinline__ void swa_unit(const PB p, LAS unsigned char* lds, int j, int s, int hq, int qb) {
    const int tid = tid_l(), lane = tid & 63, fr = lane & 15, fq = lane >> 4, wave = tid >> 6;
    const bool lat = s >= 16; const int R0 = lat ? 4096 + (s - 16) * 1024 : s * 256; const int kvh = hq >> 2;
    const GAS bf16_t* PR = (const GAS bf16_t*)(p.ws() + WS_PROJ);
    const int q0 = qb * 128, qrow = q0 + wave * 16 + fr;
    const GAS bf16_t* Qw = PR + (size_t)(R0 + qrow) * 768 + hq * 64;
    ASeg A, B;
    const GAS bf16_t* VTo = (const GAS bf16_t*)(p.ws() + WS_VT) + (size_t)128 * R0 + (size_t)(kvh * 64) * (lat ? 1024 : 256);
    A.ldk = 768; A.ldv = lat ? 1024 : 256; B.ldk = 128; B.ldv = 512; B.kpos0 = 0; B.masked = 0;
    if (lat) { const int t0 = q0 - 128 < 0 ? 0 : q0 - 128; const int t1 = q0 + 256 > 1024 ? 1024 : q0 + 256;
        A.kpos0 = t0; A.ntiles = (t1 - t0) >> 6; A.masked = 1;
        A.K = PR + (size_t)(R0 + t0) * 768 + 512 + kvh * 64; A.V = VTo + t0;
        B.ntiles = 8; B.K = (const GAS bf16_t*)(p.ws() + WS_CKS) + ((size_t)((s - 16) * 2 + j) * 512) * 128 + kvh * 64; B.V = (const GAS bf16_t*)(p.ws() + WS_CVS) + ((size_t)((s - 16) * 2 + j) * 128 + kvh * 64) * 512; }
    else { A.kpos0 = 0; A.ntiles = 4; A.masked = 0; A.K = PR + (size_t)R0 * 768 + 512 + kvh * 64; A.V = VTo; B.ntiles = 0; B.K = A.K; B.V = A.V; }
    f32x4 o[4]; float m = -1e30f, l = 0.f;
#pragma unroll
    for (int db = 0; db < 4; ++db) o[db] = (f32x4){0.f, 0.f, 0.f, 0.f};
    attn_run<64>(lds, Qw, qrow, A, B, 0.125f * 1.4426950408889634f, o, m, l);
    l += __shfl_xor(l, 16); l += __shfl_xor(l, 32);
    const float sk = p.in(18)[j * 8 + hq] * 1.4426950408889634f;
    const float mf = fmaxf(m, sk); const float a = __builtin_amdgcn_exp2f(m - mf); const float lt = l * a + __builtin_amdgcn_exp2f(sk - mf);
    const float sc = a / lt;
    GAS bf16_t* op = (GAS bf16_t*)(p.ws() + WS_MIX) + (size_t)(R0 + qrow) * 1024 + 512 + hq * 64 + 4 * fq;
#pragma unroll
    for (int db = 0; db < 4; ++db) { const f32x4 v = o[db] * sc; u32x2 w; w.x = cvt_pk_bf16(v[0], v[1]); w.y = cvt_pk_bf16(v[2], v[3]); *(GAS u32x2*)(op + 16 * db) = w; }
}
__device__ __forceinline__ void diff_unit(const PB p, LAS unsigned char* lds, int j, int s, int h, int qb) {
    const int tid = tid_l(), lane = tid & 63, fr = lane & 15, fq = lane >> 4, wave = tid >> 6;
    const bool lat = s >= 16; const int R0 = lat ? 4096 + (s - 16) * 1024 : s * 256;
    const GAS bf16_t* PR = (const GAS bf16_t*)(p.ws() + WS_PROJ);
    const int q0 = qb * 128, qrow = q0 + wave * 16 + fr;
    const float* tab = (const float*)(p.ws() + WS_TAB);
    const float lam = tab[2048 + j], lam_init = tab[2050 + j];
    const GAS bf16_t* Qw = PR + (size_t)(R0 + qrow) * 3072 + h * 128;
    const GAS bf16_t* KA = PR + (size_t)R0 * 3072 + 1024 + h * 128;
    const GAS bf16_t* VA = (const GAS bf16_t*)(p.ws() + WS_VT) + (size_t)1024 * R0 + (size_t)(h * 128) * (lat ? 1024 : 256);
    const GAS bf16_t* KB = lat ? (const GAS bf16_t*)(p.ws() + WS_CKD) + ((size_t)((s - 16) * 2 + j) * 512) * 1024 + h * 128 : KA;
    const GAS bf16_t* VB = lat ? (const GAS bf16_t*)(p.ws() + WS_CVD) + ((size_t)((s - 16) * 2 + j) * 1024 + h * 128) * 512 : VA;
    f32x4 o0[8], o1[8]; float m0 = -1e30f, l0 = 0.f, m1 = -1e30f, l1 = 0.f;
#pragma unroll
    for (int db = 0; db < 8; ++db) { o0[db] = (f32x4){0.f, 0.f, 0.f, 0.f}; o1[db] = (f32x4){0.f, 0.f, 0.f, 0.f}; }
    diff_attn_run(lds, Qw, lat ? 16 : 4, lat ? 8 : 0, KA, 3072, VA, lat ? 1024 : 256, KB, 1024, VB, 512, 0.125f * 1.4426950408889634f, o0, o1, m0, l0, m1, l1);
    l0 += __shfl_xor(l0, 16); l0 += __shfl_xor(l0, 32); l1 += __shfl_xor(l1, 16); l1 += __shfl_xor(l1, 32);
    const float i0 = 1.f / l0, i1 = lam / l1; float ss = 0.f;
#pragma unroll
    for (int db = 0; db < 8; ++db) { const f32x4 r = o0[db] * i0 - o1[db] * i1; o0[db] = r; ss += (r[0] * r[0] + r[1] * r[1]) + (r[2] * r[2] + r[3] * r[3]); }
    ss += __shfl_xor(ss, 16); ss += __shfl_xor(ss, 32);
    const float rs = rsqrtf(ss * (1.f / 128.f) + 1e-6f) * (1.f - lam_init);
    const float* sw = p.in(24) + j * 128 + 4 * fq;
    GAS bf16_t* op = (GAS bf16_t*)(p.ws() + WS_MIX) + (size_t)(R0 + qrow) * 1024 + h * 128 + 4 * fq;
#pragma unroll
    for (int db = 0; db < 8; ++db) { const f32x4 w4 = *(const f32x4*)(sw + 16 * db); const f32x4 v = o0[db] * rs * w4; u32x2 w; w.x = cvt_pk_bf16(v[0], v[1]); w.y = cvt_pk_bf16(v[2], v[3]); *(GAS u32x2*)(op + 16 * db) = w; }
}
__device__ __forceinline__ void unit_decode(int u, int& s, int& h, int& qb) {
    if (u < 256) { s = 16 + (u >> 6); h = (u >> 3) & 7; qb = u & 7; } else { const int c = u - 256; s = c >> 4; h = (c >> 1) & 7; qb = c & 1; }
}

typedef __attribute__((address_space(1))) unsigned gu32;
#define XB_TMO      128
#define XB_XCNT(j)  (256  + 64 * (j))
#define XB_XSUB(j)  (1280 + 64 * (j))
#define XB_XGEN(j)  (2304 + 64 * (j))
#define XB_TOP      3328
#define XB_TOPGEN   3392
#define XCD_BAR_WORDS 3456
#define XB_SPIN_CAP (1u << 18)

__device__ __forceinline__ unsigned xb_ld(unsigned* p)              { return __hip_atomic_load(p, __ATOMIC_RELAXED, __HIP_MEMORY_SCOPE_AGENT); }
__device__ __forceinline__ unsigned xb_add(unsigned* p, unsigned v) { return __hip_atomic_fetch_add(p, v, __ATOMIC_RELAXED, __HIP_MEMORY_SCOPE_AGENT); }
__device__ __forceinline__ unsigned xb_xcc_id() { return (unsigned)__builtin_amdgcn_s_getreg((3 << 11) | 20) & 0xFu; }
#define XB_SPIN(cond, bar) do { unsigned _sp = 0; while (cond) { __builtin_amdgcn_s_sleep(1); \
    if ((++_sp & 255u) == 0u) { if (xb_ld(&(bar)[XB_TMO])) break; if (_sp > XB_SPIN_CAP) { atomicAdd(&(bar)[XB_TMO], 1u); break; } } } } while (0)

struct XcdBarrier {
    unsigned* bar; unsigned x;
    volatile LAS unsigned* st;
};

__device__ __forceinline__ XcdBarrier xcd_barrier_post(unsigned* bar, volatile LAS unsigned* st) {
    XcdBarrier b; b.bar = bar; b.x = xb_xcc_id(); b.st = st;
    if (threadIdx.x == 0) (void)xb_add(&bar[XB_XCNT(b.x)], 1u);
    return b;
}
__device__ __forceinline__ void xcd_barrier_complete(unsigned* bar, unsigned x, unsigned& nloc, unsigned& nx) {
    const unsigned G = gridDim.x * gridDim.y * gridDim.z;
    unsigned sum, cnt, mine, sp = 0u;
    for (;;) {
        sum = 0u; cnt = 0u; mine = 0u;
#pragma unroll
        for (unsigned j = 0; j < 16; ++j) { const unsigned c = xb_ld(&bar[XB_XCNT(j)]); sum += c; cnt += (c > 0u) ? 1u : 0u; mine = (j == x) ? c : mine; }
        if (sum == G) break;
        __builtin_amdgcn_s_sleep(1);
        if ((++sp & 255u) == 0u) { if (xb_ld(&bar[XB_TMO])) break; if (sp > XB_SPIN_CAP) { atomicAdd(&bar[XB_TMO], 1u); break; } }
    }
    nloc = mine > 0u ? mine : 1u; nx = cnt > 0u ? cnt : 1u;
}

__device__ __forceinline__ void xcd_barrier(const XcdBarrier& b) {
    asm volatile("s_waitcnt vmcnt(0)" ::: "memory");
    __syncthreads();
    if (threadIdx.x == 0) {
        unsigned* bar = b.bar;
        __builtin_amdgcn_s_waitcnt(0);
        unsigned nloc = b.st[0], nx = b.st[1];
        if (nloc == 0u) { xcd_barrier_complete(bar, b.x, nloc, nx); b.st[0] = nloc; b.st[1] = nx; }
        const unsigned old = xb_add(&bar[XB_XSUB(b.x)], 1u);
        const unsigned gen = old / nloc;
        if (old + 1u == (gen + 1u) * nloc) {
            __builtin_amdgcn_fence(__ATOMIC_RELEASE, "agent");
            asm volatile("s_waitcnt vmcnt(0)" ::: "memory");
            const unsigned og = xb_add(&bar[XB_TOP], 1u);
            const unsigned tg = og / nx;
            if (og + 1u == (tg + 1u) * nx) xb_add(&bar[XB_TOPGEN], 1u);
            else XB_SPIN(xb_ld(&bar[XB_TOPGEN]) == tg, bar);
            __builtin_amdgcn_fence(__ATOMIC_ACQUIRE, "agent");
            xb_add(&bar[XB_XGEN(b.x)], 1u);
            asm volatile("s_waitcnt vmcnt(0)" ::: "memory");
        } else {
            XB_SPIN(xb_ld(&bar[XB_XGEN(b.x)]) == gen, bar);
            __builtin_amdgcn_fence(__ATOMIC_ACQUIRE, "agent");
            asm volatile("s_waitcnt vmcnt(0)" ::: "memory");
        }
    }
    __syncthreads();
}

__global__ void __launch_bounds__(512, 2) hybrid_fwd(Params ka) {
    extern __shared__ __attribute__((aligned(16))) unsigned char lds_raw[];
    LAS unsigned char* lds = (LAS unsigned char*)lds_raw;
    cg::grid_group grid = cg::this_grid();
    if (threadIdx.x == 0) {
#pragma unroll
        for (int i = 0; i < 27; ++i) *(LAS unsigned long long*)(lds + PB_OFF + 8 * i) = (unsigned long long)ka.in[i];
        *(LAS unsigned long long*)(lds + PB_OFF + 8 * 27) = (unsigned long long)ka.out; *(LAS unsigned long long*)(lds + PB_OFF + 8 * 28) = (unsigned long long)ka.ws; }
    if (threadIdx.x == 1) { *(LAS unsigned*)(lds + PB_OFF + 256) = 0u; *(LAS unsigned*)(lds + PB_OFF + 260) = 0u; }
    __syncthreads();
    const PB p{lds};
    const XcdBarrier xbar = xcd_barrier_post((unsigned*)(ka.ws + WS_BAR), (volatile LAS unsigned*)(lds + PB_OFF + 256));
    const int ph_hi = ka.ph_hi;
    int rep = 0;
    for (int ph = ka.ph_lo; ph < ph_hi; ) {
        const int G = gridDim.x, bid = blockIdx.x;
        unsigned char* ws = p.ws();
        if (ph == 0) {
#ifndef SK_P0
            phase0(p, lds);
#endif
        }
        else if (ph == 33) { norm_phase(p, 2, 3, 1, (3 * 5) * 6144 + 5 * 1024); }
        else {
            const int li = (ph - 1) >> 3, sub = (ph - 1) & 7, j = li >> 1, odd = li & 1;
            if (sub == 3 && odd) { ++ph; continue; }
            if (sub == 0) { norm_phase(p, li == 0 ? 0 : 1, li, 0, ((li - 1) * 5) * 6144 + 5 * 1024); }
            else if (sub == 5) { norm_phase(p, 1, li, 1, (li * 5) * 6144 + 2 * 1024); }
            else if (sub == 1) {
                pg8::Gemm g{(const bf16_t*)(ws + WS_XN), odd ? (const bf16_t*)(ws + WS_WINO) + (size_t)j * NOD * DM : (const bf16_t*)(ws + WS_WINE) + (size_t)j * NEV * DM, NTOK, odd ? NOD : NEV, DM, DM, 1};
                pg8::StaticOrder S; S.init(NTOK, g.N, G, bid);
                pg8::EpiIn E; E.odd = odd; E.j = j; E.pb = (const LAS unsigned*)(lds + PB_OFF);

#ifndef SK_IN
                pg8::gemm_phase<pg8::EpiIn, pg8::StaticOrder, true, true>(lds, g, S, E);
#endif
                {
                    const int nun = (NTOK / 256) * (g.N / 256);
                    const bool part = (nun > G && nun < 2 * G);
                    const int first = part ? nun - G : 0, cnt = part ? 2 * G - nun : G;
                    __syncthreads();
                    if (bid >= first) convert_layer_a(p, lds, li < 3 ? li + 1 : -1, (bid - first) * 8 + __builtin_amdgcn_readfirstlane(tid_l() >> 6), cnt * 8, li >= 1 ? li : (G == 256 ? 0 : -1));
                }

            }
            else if (sub == 2) {
#ifndef SK_MIX
                const int vb = (G % 8 == 0) ? (bid & 7) * (G >> 3) + (bid >> 3) : bid;
                if (!odd) {
                    { const bool fast = (G == 256); const int k = vb - 64;
                        const int nh = fast ? (vb >= 192 ? 2 : 1) : (vb < 320 ? (320 - vb + G - 1) / G : 0);
                        for (int q = 0; q < nh; ++q) { int it;
                            if (fast) it = vb < 64 ? 256 + vb : (q == 0 ? k : 192 + (k - 128)); else { const int r = vb + q * G; it = r < 64 ? 256 + r : r - 64; }
#ifdef PROBE_HG2
                            hgrn_chunked_dispatch(p, lds, j, it);
#endif
                            hgrn_chunked_dispatch(p, lds, j, it); }
                        const int nu = fast ? (vb < 64 ? 0 : (k < 64 ? 2 : (k < 128 ? 4 : 2))) : (vb < 512 ? (512 - vb + G - 1) / G : 0);
#ifdef PROBE_SWA2
                        for (int rp_ = 0; rp_ < 2; ++rp_)
#endif
                        for (int q = 0; q < nu; ++q) { int u;
                            if (!fast) u = vb + q * G;
                            else if (k < 64) u = q == 0 ? k : 64 + k;
                            else if (k < 128) u = q == 0 ? 128 + (k - 64) : 256 + (k - 64) * 3 + (q - 1);
                            else u = q == 0 ? 192 + (k - 128) : 256 + 192 + (k - 128);
                            int s, h, qb; unit_decode(u, s, h, qb); swa_unit(p, lds, j, s, h, qb); } }
                } else {
                    for (int u = vb; u < 512; u += G) { int s, h, qb; unit_decode(u, s, h, qb); diff_unit(p, lds, j, s, h, qb); }
                }
#endif
            }
            else if (sub == 3) { hgrn_readout(p, j); }
            else if (sub == 4 || sub == 7) {
                const bool mlp = sub == 7;
                pg8::Gemm g{mlp ? (const bf16_t*)(ws + WS_H) : (const bf16_t*)(ws + WS_MIX),
                            mlp ? (const bf16_t*)(ws + WS_W2) + (size_t)li * DM * FF : (odd ? (const bf16_t*)(ws + WS_WOUTO) : (const bf16_t*)(ws + WS_WOUTE)) + (size_t)j * DM * DM, NTOK, DM, mlp ? FF / 2 : DM / 2, mlp ? FF : DM, 2};
                pg8::StaticOrder S; S.init(NTOK, DM, G, bid, 2);
                pg8::EpiPart E{(bf16_t*)(ws + WS_P0), (bf16_t*)(ws + WS_P1)};

#ifndef SK_RES
                pg8::gemm_phase<pg8::EpiPart, pg8::StaticOrder, true, true>(lds, g, S, E);
#endif

            }
            else {
                pg8::Gemm g{(const bf16_t*)(ws + WS_XN), (const bf16_t*)(ws + WS_W1) + (size_t)li * FF * DM, NTOK, FF, DM, DM, 1};
                pg8::StaticOrder S; S.init(NTOK, FF, G, bid);
                pg8::EpiRelu2 E{(bf16_t*)(ws + WS_H), FF};

#ifndef SK_MLP1
                pg8::gemm_phase<pg8::EpiRelu2, pg8::StaticOrder, true, true>(lds, g, S, E);
#endif

            }
        }
        { const bool again = DUP_MASK != 0 && rep == 0 && ph > 0 && ((DUP_MASK >> (((ph - 1) & 7) + 8 * (((ph - 1) >> 3) & 1))) & 1); rep = again ? 1 : 0; if (!again) ++ph; }
        if (ph < ph_hi) { if (ph_hi > 1000) grid.sync(); else xcd_barrier(xbar); }
    }
}

#ifndef DUP_MASK
#define DUP_MASK 0
#endif
#ifndef MK_PER_PHASE
#define MK_PER_PHASE 0
#endif
extern "C" void kernel_launch(void* const* d_in, const int* in_sizes, int n_in, void* d_out, int out_size, void* d_ws, size_t ws_size, hipStream_t stream) {
    static int grid = 0;
    if (grid == 0) {
        if (n_in != 27 || ws_size < WS_END) { fprintf(stderr, "kernel_launch: unexpected n_in %d / ws_size %zu\n", n_in, ws_size); grid = -1; return; }
        int dev = 0, cus = 0, per_cu = 0;
        hipGetDevice(&dev); hipDeviceGetAttribute(&cus, hipDeviceAttributeMultiprocessorCount, dev);
        if (hipFuncSetAttribute((const void*)hybrid_fwd, hipFuncAttributeMaxDynamicSharedMemorySize, LDS_BYTES) != hipSuccess) { fprintf(stderr, "kernel_launch: hipFuncSetAttribute failed\n"); grid = -1; return; }
        if (hipOccupancyMaxActiveBlocksPerMultiprocessor(&per_cu, (const void*)hybrid_fwd, 512, LDS_BYTES) != hipSuccess || per_cu < 1) { fprintf(stderr, "kernel_launch: occupancy query says %d blocks per CU\n", per_cu); grid = -1; (void)hipGetLastError(); return; }
        grid = cus;
    }
    if (grid < 0) return;
    hipMemsetAsync((char*)d_ws + WS_MODS, 0, 512 * 1024, stream);
    Params p{};
    for (int i = 0; i < 27; ++i) p.in[i] = (const float*)d_in[i];
    p.out = (float*)d_out; p.ws = (unsigned char*)d_ws;
#if MK_PER_PHASE
    for (int ph = 0; ph < 34; ++ph) { p.ph_lo = ph; p.ph_hi = ph + 1; hipLaunchKernelGGL(hybrid_fwd, dim3(grid), dim3(512), LDS_BYTES, stream, p); }
#else
    p.ph_lo = 0; p.ph_hi = 34;
    void* args[] = {&p};
    hipError_t e = hipLaunchCooperativeKernel((const void*)hybrid_fwd, dim3(grid), dim3(512), args, LDS_BYTES, stream);
    if (e != hipSuccess) fprintf(stderr, "cooperative launch failed: %s (grid %d)\n", hipGetErrorString(e), grid);
#endif
}
```
